# Optimizing an MI355X kernel written in HIP

```python
import math
import jax, jax.numpy as jnp
from jax import lax
import numpy as np

D_MODEL = 1024
BATCH = 16
SEQ = 2048
DEPTH = 1

HEAD_DIM = 64
N_HEADS_FOX = 8
N_HEADS_SB = 8
D_FOX = N_HEADS_FOX * HEAD_DIM
D_SB = N_HEADS_SB * HEAD_DIM
D_FF = 4 * D_MODEL
D_PLE = 256
Q_BLOCK = 128
EPS = 1e-6
IN_SIZES = (D_FOX, D_FOX, D_FOX, N_HEADS_FOX, D_SB, D_SB, D_SB, D_MODEL, D_MODEL)
D_IN = 3 * D_FOX + N_HEADS_FOX + 3 * D_SB + 2 * D_MODEL

kernel_name = "fox_stickbreaking_gated_hybrid_block"


def _rmsnorm(x, g):
    xf = x.astype(jnp.float32)
    r = lax.rsqrt(jnp.mean(xf * xf, axis=-1, keepdims=True) + EPS)
    return (xf * r * g.astype(jnp.float32)).astype(x.dtype)


def _split_cols(u):
    offs = []
    o = 0
    for s in IN_SIZES[:-1]:
        o += s
        offs.append(o)
    return jnp.split(u, offs, axis=-1)


def _heads(u, n_heads):
    b, s, _ = u.shape
    return u.reshape(b, s, n_heads, HEAD_DIM).transpose(0, 2, 1, 3).astype(jnp.float32)


def _merge_heads(o, dtype):
    b, h, s, d = o.shape
    return o.transpose(0, 2, 1, 3).reshape(b, s, h * d).astype(dtype)


def _forgetting_attention(q, k, v, log_f):
    s_len = q.shape[2]
    scale = HEAD_DIM ** -0.5
    c = jnp.cumsum(log_f, axis=-1)
    outs = []
    for blk in range(s_len // Q_BLOCK):
        q0 = blk * Q_BLOCK
        k_end = q0 + Q_BLOCK
        qb = q[:, :, q0:k_end]
        kb = k[:, :, :k_end]
        vb = v[:, :, :k_end]
        logits = (jnp.einsum('bhqd,bhkd->bhqk', qb, kb) * scale
                  + c[:, :, q0:k_end, None] - c[:, :, None, :k_end])
        q_pos = q0 + jnp.arange(Q_BLOCK)
        k_pos = jnp.arange(k_end)
        causal = k_pos[None, :] <= q_pos[:, None]
        logits = jnp.where(causal, logits, -jnp.inf)
        probs = jax.nn.softmax(logits, axis=-1)
        outs.append(jnp.einsum('bhqk,bhkd->bhqd', probs, vb))
    return jnp.concatenate(outs, axis=2)


def _stick_breaking_attention(q, k, v):
    s_len = q.shape[2]
    scale = HEAD_DIM ** -0.5
    outs = []
    for blk in range(s_len // Q_BLOCK):
        q0 = blk * Q_BLOCK
        k_end = q0 + Q_BLOCK
        qb = q[:, :, q0:k_end]
        kb = k[:, :, :k_end]
        vb = v[:, :, :k_end]
        z = jnp.einsum('bhqd,bhkd->bhqk', qb, kb) * scale
        q_pos = q0 + jnp.arange(Q_BLOCK)
        k_pos = jnp.arange(k_end)
        strict = k_pos[None, :] < q_pos[:, None]
        log_1m_beta = jnp.where(strict, jax.nn.log_sigmoid(-z), 0.0)
        tail = lax.cumsum(log_1m_beta, axis=3, reverse=True) - log_1m_beta
        weights = jnp.where(strict, jnp.exp(jax.nn.log_sigmoid(z) + tail), 0.0)
        outs.append(jnp.einsum('bhqk,bhkd->bhqd', weights, vb))
    return jnp.concatenate(outs, axis=2)


def setup_inputs(seed: int = 0) -> dict:
    key = jax.random.key(seed)
    ks = jax.random.split(key, 16)
    f32 = jnp.float32

    def w(k, shape, fan_in, gain=1.0):
        return jax.random.normal(k, shape, f32) * (gain * fan_in ** -0.5)

    def gain(k, shape):
        return 1.0 + 0.02 * jax.random.normal(k, shape, f32)

    return {
        "x": jax.random.normal(ks[0], (BATCH, SEQ, D_MODEL), f32),
        "p": jax.random.normal(ks[1], (DEPTH, BATCH, SEQ, D_PLE), f32),
        "g_mix": gain(ks[2], (DEPTH, D_MODEL)),
        "w_in": w(ks[3], (DEPTH, D_MODEL, D_IN), D_MODEL),
        "b_forget": jax.random.uniform(ks[4], (DEPTH, N_HEADS_FOX), f32, 1.0, 4.0),
        "b_gate": 0.01 * jax.random.normal(ks[5], (DEPTH, 2, D_MODEL), f32),
        "w_branch_fox": w(ks[6], (DEPTH, D_FOX, D_MODEL), D_FOX),
        "w_branch_sb": w(ks[7], (DEPTH, D_SB, D_MODEL), D_SB),
        "w_out": w(ks[8], (DEPTH, D_MODEL, D_MODEL), D_MODEL),
        "g_mlp": gain(ks[9], (DEPTH, D_MODEL)),
        "w_up": w(ks[10], (DEPTH, D_MODEL, D_FF), D_MODEL),
        "w_down": w(ks[11], (DEPTH, D_FF, D_MODEL), D_FF, gain=0.5),
        "g_ple": gain(ks[12], (DEPTH, D_MODEL)),
        "w_ple_gate": w(ks[13], (DEPTH, D_MODEL, D_MODEL), D_MODEL),
        "w_ple": w(ks[14], (DEPTH, D_PLE, D_MODEL), D_PLE),
        "g_final": gain(ks[15], (D_MODEL,)),
    }


def reference(x, p, g_mix, w_in, b_forget, b_gate, w_branch_fox, w_branch_sb, w_out,
              g_mlp, w_up, w_down, g_ple, w_ple_gate, w_ple, g_final):
    b, s, _ = x.shape
    for i in range(DEPTH):
        h = _rmsnorm(x, g_mix[i])
        u = h @ w_in[i]
        q_a, k_a, v_a, f_a, q_b, k_b, v_b, gl_a, gl_b = _split_cols(u)
        log_f = jax.nn.log_sigmoid((f_a + b_forget[i]).astype(jnp.float32)).transpose(0, 2, 1)
        o_fox = _forgetting_attention(_heads(q_a, N_HEADS_FOX), _heads(k_a, N_HEADS_FOX),
                                      _heads(v_a, N_HEADS_FOX), log_f)
        o_sb = _stick_breaking_attention(_heads(q_b, N_HEADS_SB), _heads(k_b, N_HEADS_SB),
                                         _heads(v_b, N_HEADS_SB))
        o_fox = _merge_heads(o_fox, x.dtype) @ w_branch_fox[i]
        o_sb = _merge_heads(o_sb, x.dtype) @ w_branch_sb[i]
        merged = (jax.nn.sigmoid(gl_a + b_gate[i, 0]) * o_fox
                  + jax.nn.sigmoid(gl_b + b_gate[i, 1]) * o_sb)
        x = x + merged @ w_out[i]
        h = _rmsnorm(x, g_mlp[i])
        x = x + jnp.square(jax.nn.relu(h @ w_up[i])) @ w_down[i]
        h = _rmsnorm(x, g_ple[i])
        x = x + jax.nn.sigmoid(h @ w_ple_gate[i]) * (p[i] @ w_ple[i])
    return _rmsnorm(x, g_final)
```

```cpp
#include <hip/hip_runtime.h>
#include <hip/hip_cooperative_groups.h>
#include <cstdio>
#include <cstdint>
namespace cg = cooperative_groups;

#ifndef MK_N_LAUNCHES
#define MK_N_LAUNCHES 1
#endif
constexpr int N_PHASES = 9;

#define LAS __attribute__((address_space(3)))
typedef unsigned short bf16_t;
typedef short bf16x8 __attribute__((ext_vector_type(8)));
typedef short s16x4 __attribute__((ext_vector_type(4)));
typedef float f32x4 __attribute__((ext_vector_type(4)));
typedef float f32x2 __attribute__((ext_vector_type(2)));
typedef float f32x16 __attribute__((ext_vector_type(16)));
typedef unsigned u32x4 __attribute__((ext_vector_type(4)));
typedef unsigned u32x2 __attribute__((ext_vector_type(2)));
typedef __bf16 bf16x2_t __attribute__((ext_vector_type(2)));

constexpr int BATCH = 16, SEQ = 2048, DM = 1024, M = BATCH * SEQ, NH = 8, HD = 64, DFF = 4096, DPLE = 256;
constexpr int NIN_SRC = 5128, NQKV = 3072, NGATE = 2048, NIN = NQKV + NGATE;
constexpr float EPS = 1e-6f;
constexpr float LOG2E = 1.4426950408889634f;
constexpr float C2 = 0.125f * LOG2E;

constexpr size_t MiB = 1u << 20;
constexpr size_t WS_WIN = 2 * MiB, WS_WBF = 12 * MiB, WS_WBS = 13 * MiB, WS_WOUT = 14 * MiB, WS_WUP = 16 * MiB, WS_WDN = 24 * MiB, WS_WPG = 32 * MiB, WS_WPLE = 34 * MiB;
constexpr size_t WS_LOGF = 36 * MiB, WS_CC = 37 * MiB, WS_SSQ1 = 38 * MiB, WS_SSQ2 = 40 * MiB;
constexpr size_t WS_PB = 42 * MiB, WS_BUFA = 58 * MiB, WS_BUFB = 122 * MiB, WS_QKV = 186 * MiB, WS_SG = 378 * MiB, WS_H = 186 * MiB, WS_E = 442 * MiB, WS_END = 506 * MiB;

__device__ __forceinline__ unsigned cvt_pk_bf16(float lo, float hi) { f32x2 v = {lo, hi}; bf16x2_t b = __builtin_convertvector(v, bf16x2_t); return __builtin_bit_cast(unsigned, b); }
__device__ __forceinline__ float bf_lo(unsigned w) { return __uint_as_float(w << 16); }
__device__ __forceinline__ float bf_hi(unsigned w) { return __uint_as_float(w & 0xffff0000u); }
__device__ __forceinline__ float fast_sigmoid(float v) { return __builtin_amdgcn_rcpf(1.0f + __builtin_amdgcn_exp2f(-v * LOG2E)); }

__device__ __forceinline__ const char* uni_ptr(const char* p) { const unsigned long long v = (unsigned long long)p; const unsigned lo = __builtin_amdgcn_readfirstlane((unsigned)v), hi = __builtin_amdgcn_readfirstlane((unsigned)(v >> 32)); return (const char*)(((unsigned long long)hi << 32) | lo); }
namespace pg8 {
constexpr int BM = 256, BK = 64, HALF = 128, HTB = HALF * BK * 2, STAGE_BYTES = 8 * HTB, NXCD = 8, WGM = 8;
__host__ __device__ __forceinline__ int lds_byte(int r, int c) { const int st = (r >> 4) * 2 + (c >> 5), rr = r & 15, cc = c & 31, ob = rr * 64 + cc * 2; return st * 1024 + (ob ^ (((ob >> 9) & 1) << 5)); }
__host__ __device__ __forceinline__ void stage_rc(int b, int& R, int& C) { const int st = b / 1024, sb = b % 1024, swz = sb ^ (((sb >> 9) & 1) << 5); R = (st >> 1) * 16 + swz / 64; C = (st & 1) * 32 + (swz % 64) / 2; }
__host__ __device__ __forceinline__ int perm32(int rho) { const int n = rho >> 4, i = rho & 15; return 8 * (i >> 2) + 4 * n + (i & 3); }

struct Unit { int pm, pn; const char* A; const char* B; int chain; };
struct Gemm { int lda, ldb, K; };

struct TileOrder {
    int nM, nN, nwg, G, c;
    __device__ void init(int Mrows, int N, int G_, int c_) { nM = Mrows / BM; nN = N / BM; nwg = nM * nN; G = G_; c = c_; }
    __device__ bool tile(int i, int& pm, int& pn) const {
        const long L = (long)i * G + c; if (L >= nwg) return false;
        int wgid = (int)L; { const int q = nwg / NXCD, r = nwg % NXCD, xcd = wgid % NXCD, off = wgid / NXCD; wgid = (xcd < r ? xcd * (q + 1) : r * (q + 1) + (xcd - r) * q) + off; }
        const int nig = WGM * nN, gid = wgid / nig, fm = gid * WGM, gsz = (nM - fm) < WGM ? (nM - fm) : WGM;
        pm = fm + ((wgid % nig) % gsz); pn = (wgid % nig) / gsz; return true;
    }
};
struct PlainSched {
    TileOrder T; const char* A; const char* B; size_t astep, bstep;
    __device__ bool next(int i, Unit& u) const { int pm, pn; if (!T.tile(i, pm, pn)) return false; u.pm = pm; u.pn = pn; u.A = A + (size_t)pm * astep; u.B = B + (size_t)pn * bstep; u.chain = 0; return true; }
};
struct PairSched {
    TileOrder T; const char* A0; const char* A1; const char* B0; const char* B1; size_t astep, bstep;
    __device__ bool next(int i, Unit& u) const { int pm, pn; if (!T.tile(i >> 1, pm, pn)) return false; const int s = i & 1; u.pm = pm; u.pn = pn;
        u.A = (s ? A1 : A0) + (size_t)pm * astep; u.B = (s ? B1 : B0) + (size_t)pn * bstep; u.chain = s ? 0 : 1; return true; }
};

typedef f32x4 Acc[2][2][4][2];

struct EpiQKVG {
    static constexpr bool PERM = true;
    bf16_t* QKV; bf16_t* SG; const float* bgate;
    __device__ __forceinline__ void operator()(Acc& acc, const Unit& u, int wr, int wc, int fr, int fq) const {
        const int row0 = u.pm * BM + wr * 64 + fr;
        if (u.pn < 12) {
            const float sc = (u.pn < 2 || (u.pn >= 6 && u.pn < 8)) ? C2 : 1.0f;
            const int col0 = u.pn * BM + wc * 32 + 8 * fq;
#pragma unroll
            for (int ai = 0; ai < 2; ++ai)
#pragma unroll
                for (int m = 0; m < 4; ++m) { bf16_t* rowp = QKV + (size_t)(row0 + ai * HALF + m * 16) * NQKV + col0;
#pragma unroll
                    for (int bj = 0; bj < 2; ++bj) { const f32x4 v0 = acc[ai][bj][m][0] * sc, v1 = acc[ai][bj][m][1] * sc;
                        u32x4 w; w.x = cvt_pk_bf16(v0[0], v0[1]); w.y = cvt_pk_bf16(v0[2], v0[3]); w.z = cvt_pk_bf16(v1[0], v1[1]); w.w = cvt_pk_bf16(v1[2], v1[3]);
                        *(u32x4*)(rowp + bj * HALF) = w; } }
        } else {
            const int col0 = (u.pn - 12) * BM + wc * 32 + 8 * fq;
            f32x4 bv[2][2];
#pragma unroll
            for (int bj = 0; bj < 2; ++bj)
#pragma unroll
                for (int n = 0; n < 2; ++n) bv[bj][n] = *(const f32x4*)(bgate + col0 + bj * HALF + 4 * n);
#pragma unroll
            for (int ai = 0; ai < 2; ++ai)
#pragma unroll
                for (int m = 0; m < 4; ++m) { bf16_t* rowp = SG + (size_t)(row0 + ai * HALF + m * 16) * NGATE + col0;
#pragma unroll
                    for (int bj = 0; bj < 2; ++bj) { const f32x4 a0 = acc[ai][bj][m][0] + bv[bj][0], a1 = acc[ai][bj][m][1] + bv[bj][1];
                        u32x4 w; w.x = cvt_pk_bf16(fast_sigmoid(a0[0]), fast_sigmoid(a0[1])); w.y = cvt_pk_bf16(fast_sigmoid(a0[2]), fast_sigmoid(a0[3]));
                        w.z = cvt_pk_bf16(fast_sigmoid(a1[0]), fast_sigmoid(a1[1])); w.w = cvt_pk_bf16(fast_sigmoid(a1[2]), fast_sigmoid(a1[3]));
                        *(u32x4*)(rowp + bj * HALF) = w; } }
        }
    }
};
struct EpiBf16 {
    static constexpr bool PERM = true;
    bf16_t* O; int ldc;
    __device__ __forceinline__ void operator()(Acc& acc, const Unit& u, int wr, int wc, int fr, int fq) const {
        const int row0 = u.pm * BM + wr * 64 + fr, col0 = u.pn * BM + wc * 32 + 8 * fq;
#pragma unroll
        for (int ai = 0; ai < 2; ++ai)
#pragma unroll
            for (int m = 0; m < 4; ++m) { bf16_t* rowp = O + (size_t)(row0 + ai * HALF + m * 16) * ldc + col0;
#pragma unroll
                for (int bj = 0; bj < 2; ++bj) { const f32x4 v0 = acc[ai][bj][m][0], v1 = acc[ai][bj][m][1];
                    u32x4 w; w.x = cvt_pk_bf16(v0[0], v0[1]); w.y = cvt_pk_bf16(v0[2], v0[3]); w.z = cvt_pk_bf16(v1[0], v1[1]); w.w = cvt_pk_bf16(v1[2], v1[3]);
                    *(u32x4*)(rowp + bj * HALF) = w; } }
    }
};
struct EpiBranch {
    static constexpr bool PERM = true;
    const bf16_t* SG; bf16_t* MG;
    __device__ __forceinline__ void operator()(Acc& acc, const Unit& u, int wr, int wc, int fr, int fq) const {
        const int row0 = u.pm * BM + wr * 64 + fr, col0 = u.pn * BM + wc * 32 + 8 * fq;
#pragma unroll
        for (int ai = 0; ai < 2; ++ai)
#pragma unroll
            for (int m = 0; m < 4; ++m) { const size_t row = (size_t)(row0 + ai * HALF + m * 16);
#pragma unroll
                for (int bj = 0; bj < 2; ++bj) {
                    const u32x4 gb = *(const u32x4*)(SG + row * NGATE + DM + col0 + bj * HALF);
                    f32x4 b0 = {bf_lo(gb.x), bf_hi(gb.x), bf_lo(gb.y), bf_hi(gb.y)}, b1 = {bf_lo(gb.z), bf_hi(gb.z), bf_lo(gb.w), bf_hi(gb.w)};
                    if (u.chain) {
                        const u32x4 ga = *(const u32x4*)(SG + row * NGATE + col0 + bj * HALF);
                        const f32x4 a0 = {bf_lo(ga.x), bf_hi(ga.x), bf_lo(ga.y), bf_hi(ga.y)}, a1 = {bf_lo(ga.z), bf_hi(ga.z), bf_lo(ga.w), bf_hi(ga.w)};
#pragma unroll
                        for (int e = 0; e < 4; ++e) { acc[ai][bj][m][0][e] *= a0[e] * __builtin_amdgcn_rcpf(fmaxf(b0[e], 1e-30f)); acc[ai][bj][m][1][e] *= a1[e] * __builtin_amdgcn_rcpf(fmaxf(b1[e], 1e-30f)); }
                    } else {
                        const f32x4 v0 = acc[ai][bj][m][0] * b0, v1 = acc[ai][bj][m][1] * b1;
                        u32x4 w; w.x = cvt_pk_bf16(v0[0], v0[1]); w.y = cvt_pk_bf16(v0[2], v0[3]); w.z = cvt_pk_bf16(v1[0], v1[1]); w.w = cvt_pk_bf16(v1[2], v1[3]);
                        *(u32x4*)(MG + row * DM + col0 + bj * HALF) = w;
                    }
                }
                asm volatile("" ::: "memory"); }
    }
};
struct EpiRes {
    static constexpr bool PERM = false;
    const float* base; float* out; bf16_t* an; const float* g; float* ssq;
    __device__ __forceinline__ void operator()(Acc& acc, const Unit& u, int wr, int wc, int fr, int fq) const {
        const int col0 = u.pn * BM + wc * 32 + 4 * fq;
        f32x4 gv[2][2];
#pragma unroll
        for (int bj = 0; bj < 2; ++bj)
#pragma unroll
            for (int n = 0; n < 2; ++n) gv[bj][n] = *(const f32x4*)(g + col0 + bj * HALF + n * 16);
#pragma unroll
        for (int ai = 0; ai < 2; ++ai)
#pragma unroll
            for (int m = 0; m < 4; ++m) { const int row = u.pm * BM + ai * HALF + wr * 64 + m * 16 + fr; const size_t off = (size_t)row * DM + col0; float s = 0.f;
#pragma unroll
                for (int bj = 0; bj < 2; ++bj)
#pragma unroll
                    for (int n = 0; n < 2; ++n) { const f32x4 bs = *(const f32x4*)(base + off + bj * HALF + n * 16); const f32x4 x1 = bs + acc[ai][bj][m][n];
                        *(f32x4*)(out + off + bj * HALF + n * 16) = x1; s += (x1[0] * x1[0] + x1[1] * x1[1]) + (x1[2] * x1[2] + x1[3] * x1[3]);
                        const f32x4 y = x1 * gv[bj][n]; u32x2 w; w.x = cvt_pk_bf16(y[0], y[1]); w.y = cvt_pk_bf16(y[2], y[3]); *(u32x2*)(an + off + bj * HALF + n * 16) = w; }
                s += __shfl_xor(s, 16); s += __shfl_xor(s, 32);
                if (fq == 0) ssq[(size_t)row * 16 + u.pn * 4 + wc] = s;
                asm volatile("" ::: "memory"); }
    }
};
__device__ __forceinline__ float row_rstd(const float* ssq, int row) {
    const f32x4* p = (const f32x4*)(ssq + (size_t)row * 16); const f32x4 a = p[0], b = p[1], c = p[2], d = p[3];
    const float s = ((a[0] + a[1]) + (a[2] + a[3])) + ((b[0] + b[1]) + (b[2] + b[3])) + ((c[0] + c[1]) + (c[2] + c[3])) + ((d[0] + d[1]) + (d[2] + d[3]));
    return __builtin_amdgcn_rsqf(s * (1.0f / DM) + EPS);
}
struct EpiUp {
    static constexpr bool PERM = true;
    bf16_t* H; const float* ssq;
    __device__ __forceinline__ void operator()(Acc& acc, const Unit& u, int wr, int wc, int fr, int fq) const {
        const int row0 = u.pm * BM + wr * 64 + fr, col0 = u.pn * BM + wc * 32 + 8 * fq;
#pragma unroll
        for (int ai = 0; ai < 2; ++ai)
#pragma unroll
            for (int m = 0; m < 4; ++m) { const int row = row0 + ai * HALF + m * 16; const float r = row_rstd(ssq, row); bf16_t* rowp = H + (size_t)row * DFF + col0;
#pragma unroll
                for (int bj = 0; bj < 2; ++bj) { f32x4 v0 = acc[ai][bj][m][0] * r, v1 = acc[ai][bj][m][1] * r;
#pragma unroll
                    for (int e = 0; e < 4; ++e) { const float a = fmaxf(v0[e], 0.f), b = fmaxf(v1[e], 0.f); v0[e] = a * a; v1[e] = b * b; }
                    u32x4 w; w.x = cvt_pk_bf16(v0[0], v0[1]); w.y = cvt_pk_bf16(v0[2], v0[3]); w.z = cvt_pk_bf16(v1[0], v1[1]); w.w = cvt_pk_bf16(v1[2], v1[3]);
                    *(u32x4*)(rowp + bj * HALF) = w; }
                asm volatile("" ::: "memory"); }
    }
};
struct EpiPle {
    static constexpr bool PERM = false;
    const float* base; float* out; const bf16_t* E; const float* ssq;
    __device__ __forceinline__ void operator()(Acc& acc, const Unit& u, int wr, int wc, int fr, int fq) const {
        const int col0 = u.pn * BM + wc * 32 + 4 * fq;
#pragma unroll
        for (int ai = 0; ai < 2; ++ai)
#pragma unroll
            for (int m = 0; m < 4; ++m) { const int row = u.pm * BM + ai * HALF + wr * 64 + m * 16 + fr; const size_t off = (size_t)row * DM + col0; const float r = row_rstd(ssq, row);
#pragma unroll
                for (int bj = 0; bj < 2; ++bj)
#pragma unroll
                    for (int n = 0; n < 2; ++n) { const f32x4 bs = *(const f32x4*)(base + off + bj * HALF + n * 16); const u32x2 ew = *(const u32x2*)(E + off + bj * HALF + n * 16);
                        const f32x4 ev = {bf_lo(ew.x), bf_hi(ew.x), bf_lo(ew.y), bf_hi(ew.y)}; const f32x4 a = acc[ai][bj][m][n] * r; f32x4 o;
#pragma unroll
                        for (int e = 0; e < 4; ++e) o[e] = bs[e] + fast_sigmoid(a[e]) * ev[e];
                        *(f32x4*)(out + off + bj * HALF + n * 16) = o; }
                asm volatile("" ::: "memory"); }
    }
};

template <class Epi, class Sched>
__device__ __forceinline__ void gemm_phase(LAS unsigned char* lds, const Gemm g, const Sched& S, const Epi& E) {
    const int tid = threadIdx.x, wid = __builtin_amdgcn_readfirstlane(tid >> 6), lane = tid & 63, wr = wid >> 2, wc = wid & 3, fr = lane & 15, fq = lane >> 4;
    const int K = g.K, nt = K / BK;
    unsigned voffA[2], voffB[2];
#pragma unroll
    for (int i = 0; i < 2; ++i) { int R, C; stage_rc(tid * 16 + i * 8192, R, C); const int Rb = Epi::PERM ? ((R & ~31) + perm32(R & 31)) : R;
        voffA[i] = (unsigned)(R * g.lda + C) * 2u; voffB[i] = (unsigned)(Rb * g.ldb + C) * 2u; }
    const size_t kstep = (size_t)(BK * 2);
    const size_t hA = (size_t)HALF * g.lda * 2, hB = (size_t)HALF * g.ldb * 2;
    const unsigned ldsw = (unsigned)wid * 1024u;
    const int aoff = lds_byte(wr * 64 + fr, fq * 8), boff = lds_byte(wc * 32 + fr, fq * 8);
#define PG8_SA(b, h) (((b) * 2 + (h)) * HTB)
#define PG8_SB(b, h) ((4 + (b) * 2 + (h)) * HTB)
#define PG8_STAGE(bufoff, gbase, voff) do { _Pragma("unroll") for (int _i = 0; _i < 2; ++_i) \
        __builtin_amdgcn_global_load_lds((const unsigned*)((const char*)(gbase) + (voff)[_i]), (LAS unsigned*)(lds + (bufoff) + ldsw + _i * 8192), 16, 0, 0); } while (0)
#define PG8_LDA(dst, b, h) do { _Pragma("unroll") for (int m = 0; m < 4; ++m) _Pragma("unroll") for (int k = 0; k < 2; ++k) dst[m][k] = *(const LAS bf16x8*)(lds + PG8_SA(b, h) + aoff + m * 2048 + k * 1024); } while (0)
#define PG8_LDB(dst, b, h) do { _Pragma("unroll") for (int n = 0; n < 2; ++n) _Pragma("unroll") for (int k = 0; k < 2; ++k) dst[n][k] = *(const LAS bf16x8*)(lds + PG8_SB(b, h) + boff + n * 2048 + k * 1024); } while (0)
#define PG8_MMA(ai, bj, At, Bt) do { __builtin_amdgcn_s_setprio(1); _Pragma("unroll") for (int m = 0; m < 4; ++m) _Pragma("unroll") for (int n = 0; n < 2; ++n) _Pragma("unroll") for (int k = 0; k < 2; ++k) \
        acc[ai][bj][m][n] = __builtin_amdgcn_mfma_f32_16x16x32_bf16(Bt[n][k], At[m][k], acc[ai][bj][m][n], 0, 0, 0); __builtin_amdgcn_s_setprio(0); } while (0)
#define PG8_WAIT_V(n) asm volatile("s_waitcnt vmcnt(" #n ")" ::: "memory")
#define PG8_WAIT_L(n) asm volatile("s_waitcnt lgkmcnt(" #n ")" ::: "memory")
#define PG8_BAR __builtin_amdgcn_s_barrier()
#define PG8_SCHED __builtin_amdgcn_sched_barrier(0)
#define PG8_ZERO() do { _Pragma("unroll") for (int a = 0; a < 2; ++a) _Pragma("unroll") for (int b = 0; b < 2; ++b) _Pragma("unroll") for (int m = 0; m < 4; ++m) _Pragma("unroll") for (int n = 0; n < 2; ++n) acc[a][b][m][n] = (f32x4){0.f, 0.f, 0.f, 0.f}; } while (0)
    Unit cur, nxt; int ui = 0;
    if (!S.next(0, cur)) return;
    Acc acc;
    PG8_ZERO();
    bf16x8 At[4][2], B0[2][2], B1[2][2];
    const char* cA = uni_ptr(cur.A); const char* cB = uni_ptr(cur.B);
    PG8_STAGE(PG8_SB(0, 0), cB, voffB); PG8_STAGE(PG8_SB(0, 1), cB + hB, voffB); PG8_STAGE(PG8_SA(0, 0), cA, voffA); PG8_STAGE(PG8_SA(0, 1), cA + hA, voffA);
    if (wr == 1) PG8_BAR;
    PG8_WAIT_V(2); PG8_BAR;
    PG8_STAGE(PG8_SB(1, 0), cB + kstep, voffB); PG8_STAGE(PG8_SA(1, 0), cA + kstep, voffA); PG8_STAGE(PG8_SB(1, 1), cB + hB + kstep, voffB);
    PG8_WAIT_V(6); PG8_BAR;
    for (;;) {
        const bool has_next = S.next(ui + 1, nxt);
        const char* nA = uni_ptr(has_next ? nxt.A : cA); const char* nB = uni_ptr(has_next ? nxt.B : cB);
#pragma nounroll
        for (int t = 0; t < nt; t += 2) {
            const bool last = (t == nt - 2);
            const char* a1 = cA + (size_t)(t + 1) * kstep;
            const char* a2 = last ? nA : cA + (size_t)(t + 2) * kstep; const char* b2 = last ? nB : cB + (size_t)(t + 2) * kstep;
            const char* a3 = a2 + kstep; const char* b3 = b2 + kstep;
            PG8_LDB(B0, 0, 0); PG8_LDB(B1, 0, 1); PG8_SCHED; PG8_LDA(At, 0, 0); PG8_STAGE(PG8_SA(1, 1), a1 + hA, voffA);
            PG8_WAIT_V(8); PG8_WAIT_L(0); PG8_BAR; PG8_MMA(0, 0, At, B0); PG8_MMA(0, 1, At, B1); PG8_BAR; PG8_SCHED;
            PG8_LDA(At, 0, 1); PG8_STAGE(PG8_SB(0, 0), b2, voffB); PG8_STAGE(PG8_SB(0, 1), b2 + hB, voffB); PG8_STAGE(PG8_SA(0, 0), a2, voffA);
            PG8_WAIT_V(8); PG8_WAIT_L(0); PG8_BAR; PG8_MMA(1, 0, At, B0); PG8_MMA(1, 1, At, B1); PG8_BAR; PG8_SCHED;
            PG8_LDB(B0, 1, 0); PG8_LDB(B1, 1, 1); PG8_SCHED; PG8_LDA(At, 1, 0); PG8_STAGE(PG8_SA(0, 1), a2 + hA, voffA);
            PG8_WAIT_V(8); PG8_WAIT_L(0); PG8_BAR; PG8_MMA(0, 0, At, B0); PG8_MMA(0, 1, At, B1); PG8_BAR; PG8_SCHED;
            PG8_LDA(At, 1, 1); PG8_STAGE(PG8_SB(1, 0), b3, voffB); PG8_STAGE(PG8_SB(1, 1), b3 + hB, voffB); PG8_STAGE(PG8_SA(1, 0), a3, voffA);
            PG8_WAIT_V(8); PG8_WAIT_L(0); PG8_BAR; PG8_MMA(1, 0, At, B0); PG8_MMA(1, 1, At, B1); PG8_BAR; PG8_SCHED;
        }
        if (wr == 0) PG8_BAR;
        E(acc, cur, wr, wc, fr, fq);
        if (!has_next) break;
        if (!cur.chain) PG8_ZERO();
        cur = nxt; cA = nA; cB = nB; ++ui;
        if (wr == 1) PG8_BAR;
    }
    PG8_WAIT_V(0);
    PG8_BAR;
#undef PG8_SA
#undef PG8_SB
#undef PG8_STAGE
#undef PG8_LDA
#undef PG8_LDB
#undef PG8_MMA
#undef PG8_WAIT_V
#undef PG8_WAIT_L
#undef PG8_BAR
#undef PG8_SCHED
#undef PG8_ZERO
}
}

namespace att {
constexpr int PITCH = NQKV, OPITCH = DM;
constexpr int L_K = 0, L_V = 8192, BUFSZ = 16384;
constexpr int L_WS = 2 * BUFSZ, L_OST = L_WS + 8 * 256, L_FLAG = L_OST + 8 * 4096, L_END = L_FLAG + 64;
constexpr float SB_THR = -160.0f;
__device__ __forceinline__ int crow(int r, int hi) { return (r & 3) + 8 * (r >> 2) + 4 * hi; }
__device__ __forceinline__ s16x4 vtr(const LAS unsigned char* p) { typedef short v4i16_t __attribute__((ext_vector_type(4))); return __builtin_bit_cast(s16x4, __builtin_amdgcn_ds_read_tr16_b64_v4i16((LAS v4i16_t*)p)); }
__device__ __forceinline__ void swap_halves(float v, float& lo, float& hi_) { auto rr = __builtin_amdgcn_permlane32_swap(__float_as_uint(v), __float_as_uint(v), false, false); lo = __uint_as_float(rr[0]); hi_ = __uint_as_float(rr[1]); }

template <int KIND>
__device__ __forceinline__ void attn_unit(int b, int h, int qb, const bf16_t* QKV, const float* cc, bf16_t* O, LAS unsigned char* lds) {
    const int tid = threadIdx.x, lane = tid & 63, r32 = lane & 31, hi = lane >> 5; const int wid = __builtin_amdgcn_readfirstlane(tid >> 6);
    const size_t rowbase = (size_t)b * SEQ; const int q0 = qb * 256, qw = q0 + wid * 32, qabs = qw + r32;
    const int colq = KIND * 1536 + h * HD;
    const bf16_t* Qw = QKV + (rowbase + qw) * PITCH + colq;
    bf16x8 qr[4];
#pragma unroll
    for (int d0 = 0; d0 < 4; ++d0) qr[d0] = *(const bf16x8*)(Qw + (size_t)r32 * PITCH + d0 * 16 + hi * 8);
    const bf16_t* ksrc = QKV + rowbase * PITCH + colq + 512 + (size_t)lane * PITCH + wid * 8;
    const bf16_t* vsrc = QKV + rowbase * PITCH + colq + 1024 + (size_t)(16 * (wid & 3) + (lane >> 2)) * PITCH + (wid >> 2) * 32 + (lane & 3) * 8;
    const int wdst = wid * 1024 + lane * 16;
    const int T_last = qb * 4 + 3, td = qw >> 6;
    LAS float* wsf = (LAS float*)(lds + L_WS) + wid * 64;
    LAS unsigned* flags = (LAS unsigned*)(lds + L_FLAG);
    const float* ccb = cc + (size_t)(b * NH + h) * SEQ;
    float cref = 0.f; if (KIND == 0) cref = ccb[q0 + 255];
    u32x4 kreg = *(const u32x4*)(ksrc + (size_t)T_last * 64 * PITCH), vreg = *(const u32x4*)(vsrc + (size_t)T_last * 64 * PITCH);
    *(LAS u32x4*)(lds + L_K + wdst) = kreg; *(LAS u32x4*)(lds + L_V + wdst) = vreg;
    __syncthreads();
    f32x16 o[2]; o[0] = (f32x16){}; o[1] = (f32x16){};
    float mrun = -INFINITY, lrun = 0.f, R = 0.f; bool mydone = false;
    for (int it = 0;; ++it) {
        const int t = T_last - it; const int buf = (it & 1) * BUFSZ;
        if (t > 0) { kreg = *(const u32x4*)(ksrc + (size_t)(t - 1) * 64 * PITCH); vreg = *(const u32x4*)(vsrc + (size_t)(t - 1) * 64 * PITCH); }
        if (t <= td && !mydone) {
            f32x16 p0 = (f32x16){}, p1 = (f32x16){};
            const LAS unsigned char* kb = lds + buf + L_K + hi * 1024 + r32 * 16;
#pragma unroll
            for (int d0 = 0; d0 < 4; ++d0) { const bf16x8 b0 = *(const LAS bf16x8*)(kb + d0 * 2048), b1 = *(const LAS bf16x8*)(kb + d0 * 2048 + 512);
                p0 = __builtin_amdgcn_mfma_f32_32x32x16_bf16(b0, qr[d0], p0, 0, 0, 0); p1 = __builtin_amdgcn_mfma_f32_32x32x16_bf16(b1, qr[d0], p1, 0, 0, 0); }
            const bool diag = (t == td); const int kv0 = t * 64 + 4 * hi;
            if (KIND == 0) {
                const float* cb = ccb + t * 64 + 4 * hi;
#pragma unroll
                for (int g = 0; g < 4; ++g) { const f32x4 c0 = *(const f32x4*)(cb + 8 * g), c1 = *(const f32x4*)(cb + 32 + 8 * g);
#pragma unroll
                    for (int i = 0; i < 4; ++i) { p0[4 * g + i] += cref - c0[i]; p1[4 * g + i] += cref - c1[i]; } }
                if (diag) {
#pragma unroll
                    for (int r = 0; r < 16; ++r) { const int kv = kv0 + (r & 3) + 8 * (r >> 2); if (kv > qabs) p0[r] = -INFINITY; if (kv + 32 > qabs) p1[r] = -INFINITY; }
                }
                float rm = fmaxf(p0[0], p1[0]);
#pragma unroll
                for (int r = 1; r < 16; ++r) rm = fmaxf(rm, fmaxf(p0[r], p1[r]));
                { float a, c; swap_halves(rm, a, c); rm = fmaxf(a, c); }
                const float mnew = fmaxf(mrun, rm); const float f = __builtin_amdgcn_exp2f(mrun - mnew); mrun = mnew;
                float ls = 0.f;
#pragma unroll
                for (int r = 0; r < 16; ++r) { p0[r] = __builtin_amdgcn_exp2f(p0[r] - mnew); p1[r] = __builtin_amdgcn_exp2f(p1[r] - mnew); ls += p0[r] + p1[r]; }
                lrun = lrun * f + ls;
                if (__any(f != 1.0f)) {
                    if (hi == 0) wsf[r32] = f;
                    asm volatile("s_waitcnt lgkmcnt(0)" ::: "memory");
#pragma unroll
                    for (int r = 0; r < 16; ++r) { const float fr_ = wsf[crow(r, hi)]; o[0][r] *= fr_; o[1][r] *= fr_; }
                    asm volatile("s_waitcnt lgkmcnt(0)" ::: "memory");
                }
            } else {
                f32x16 l0, l1;
#pragma unroll
                for (int r = 0; r < 16; ++r) {
                    const int kv = kv0 + (r & 3) + 8 * (r >> 2);
                    { const float z = p0[r]; const float tt = __builtin_amdgcn_logf(1.0f + __builtin_amdgcn_exp2f(-fabsf(z))); float L = -(fmaxf(z, 0.f) + tt); if (diag && !(kv < qabs)) L = 0.f; l0[r] = L; }
                    { const float z = p1[r]; const float tt = __builtin_amdgcn_logf(1.0f + __builtin_amdgcn_exp2f(-fabsf(z))); float L = -(fmaxf(z, 0.f) + tt); if (diag && !(kv + 32 < qabs)) L = 0.f; l1[r] = L; }
                }
                float G[8], Gp[8];
#pragma unroll
                for (int g = 0; g < 4; ++g) { G[g] = (l0[4 * g] + l0[4 * g + 1]) + (l0[4 * g + 2] + l0[4 * g + 3]); G[4 + g] = (l1[4 * g] + l1[4 * g + 1]) + (l1[4 * g + 2] + l1[4 * g + 3]); }
#pragma unroll
                for (int c = 0; c < 8; ++c) { float a, d; swap_halves(G[c], a, d); Gp[c] = hi ? a : d; }
                float cs = 0.f;
#pragma unroll
                for (int c = 7; c >= 0; --c) {
                    const float ex = cs + (hi ? 0.f : Gp[c]);
                    const int g = c & 3;
                    if (c >= 4) { float s3 = l1[4 * g + 3] + ex, s2 = l1[4 * g + 2] + s3, s1 = l1[4 * g + 1] + s2, s0 = l1[4 * g] + s1; l1[4 * g + 3] = s3; l1[4 * g + 2] = s2; l1[4 * g + 1] = s1; l1[4 * g] = s0; }
                    else        { float s3 = l0[4 * g + 3] + ex, s2 = l0[4 * g + 2] + s3, s1 = l0[4 * g + 1] + s2, s0 = l0[4 * g] + s1; l0[4 * g + 3] = s3; l0[4 * g + 2] = s2; l0[4 * g + 1] = s1; l0[4 * g] = s0; }
                    cs += G[c] + Gp[c];
                }
#pragma unroll
                for (int r = 0; r < 16; ++r) {
                    const int kv = kv0 + (r & 3) + 8 * (r >> 2);
                    float w0 = __builtin_amdgcn_exp2f(p0[r] + l0[r] + R), w1 = __builtin_amdgcn_exp2f(p1[r] + l1[r] + R);
                    if (diag && !(kv < qabs)) w0 = 0.f; if (diag && !(kv + 32 < qabs)) w1 = 0.f;
                    p0[r] = w0; p1[r] = w1;
                }
                R += cs;
                mydone = __all(R < SB_THR);
            }
            u32x4 pw[4];
            pw[0] = (u32x4){cvt_pk_bf16(p0[0], p0[1]), cvt_pk_bf16(p0[2], p0[3]), cvt_pk_bf16(p0[4], p0[5]), cvt_pk_bf16(p0[6], p0[7])};
            pw[1] = (u32x4){cvt_pk_bf16(p0[8], p0[9]), cvt_pk_bf16(p0[10], p0[11]), cvt_pk_bf16(p0[12], p0[13]), cvt_pk_bf16(p0[14], p0[15])};
            pw[2] = (u32x4){cvt_pk_bf16(p1[0], p1[1]), cvt_pk_bf16(p1[2], p1[3]), cvt_pk_bf16(p1[4], p1[5]), cvt_pk_bf16(p1[6], p1[7])};
            pw[3] = (u32x4){cvt_pk_bf16(p1[8], p1[9]), cvt_pk_bf16(p1[10], p1[11]), cvt_pk_bf16(p1[12], p1[13]), cvt_pk_bf16(p1[14], p1[15])};
            const LAS unsigned char* vp = lds + buf + L_V + ((lane >> 4) & 1) * 32 + (lane & 3) * 8 + (4 * hi + ((lane & 15) >> 2)) * 64;
#pragma unroll
            for (int d0 = 0; d0 < 2; ++d0)
#pragma unroll
                for (int ks = 0; ks < 4; ++ks) { const s16x4 lo = vtr(vp + d0 * 4096 + ks * 1024), hh = vtr(vp + d0 * 4096 + ks * 1024 + 512);
                    const bf16x8 vf = {lo[0], lo[1], lo[2], lo[3], hh[0], hh[1], hh[2], hh[3]};
                    o[d0] = __builtin_amdgcn_mfma_f32_32x32x16_bf16(__builtin_bit_cast(bf16x8, pw[ks]), vf, o[d0], 0, 0, 0); }
        }
        if (KIND == 1) { if (lane == 0) flags[(it & 1) * 8 + wid] = mydone ? 1u : 0u; }
        if (t > 0) { *(LAS u32x4*)(lds + (buf ^ BUFSZ) + L_K + wdst) = kreg; *(LAS u32x4*)(lds + (buf ^ BUFSZ) + L_V + wdst) = vreg; }
        __syncthreads();
        if (t == 0) break;
        if (KIND == 1) { const u32x4 fa = *(const LAS u32x4*)(flags + (it & 1) * 8), fb = *(const LAS u32x4*)(flags + (it & 1) * 8 + 4);
            if ((fa.x & fa.y & fa.z & fa.w & fb.x & fb.y & fb.z & fb.w) != 0u) break; }
    }
    float inv = 1.0f;
    if (KIND == 0) { float a, c; swap_halves(lrun, a, c); inv = 1.0f / (a + c); }
    if (hi == 0) wsf[32 + r32] = inv;
    asm volatile("s_waitcnt lgkmcnt(0)" ::: "memory");
    LAS bf16_t* stg = (LAS bf16_t*)(lds + L_OST) + wid * 2048;
#pragma unroll
    for (int r = 0; r < 16; ++r) { const int orow = crow(r, hi); const float rl = wsf[32 + orow];
        const unsigned w = cvt_pk_bf16(o[0][r] * rl, o[1][r] * rl);
        stg[orow * 64 + r32] = (bf16_t)(w & 0xffffu); stg[orow * 64 + 32 + r32] = (bf16_t)(w >> 16); }
    asm volatile("s_waitcnt lgkmcnt(0)" ::: "memory");
    bf16_t* Ow = O + (rowbase + qw) * OPITCH + KIND * 512 + h * HD;
#pragma unroll
    for (int i = 0; i < 4; ++i) { const int row = i * 8 + (lane >> 3), ch = lane & 7; const u32x4 v = *(const LAS u32x4*)(stg + row * 64 + ch * 8); *(u32x4*)(Ow + (size_t)row * OPITCH + ch * 8) = v; }
    asm volatile("s_waitcnt lgkmcnt(0)" ::: "memory");
}
}

constexpr int NWAVES = 8;
constexpr int RING_BYTES = 131072, LDS_BYTES = 147456;
static_assert(att::L_END <= RING_BYTES, "attention scratch fits the ring region");

__device__ __forceinline__ float wave_sum(float v) {
#pragma unroll
    for (int o = 1; o < 64; o <<= 1) v += __shfl_xor(v, o);
    return v;
}
__device__ __forceinline__ void tr_item(const float* W, int ldw, int col0, int K, bf16_t* WT, int row_off, LAS float* scr, int kb, int nb, int lane) {
    const int k0 = 64 * kb, n0 = 32 * nb;
#pragma unroll 8
    for (int i = 0; i < 32; ++i) { const int kk = 2 * i + (lane >> 5); scr[kk * 33 + (lane & 31)] = W[(size_t)(k0 + kk) * ldw + col0 + n0 + (lane & 31)]; }
    asm volatile("s_waitcnt lgkmcnt(0)" ::: "memory");
    const int c = lane & 7;
#pragma unroll
    for (int j = 0; j < 4; ++j) { const int n = (lane >> 3) + 8 * j; const LAS float* s = scr + (8 * c) * 33 + n;
        u32x4 o; o.x = cvt_pk_bf16(s[0 * 33], s[1 * 33]); o.y = cvt_pk_bf16(s[2 * 33], s[3 * 33]); o.z = cvt_pk_bf16(s[4 * 33], s[5 * 33]); o.w = cvt_pk_bf16(s[6 * 33], s[7 * 33]);
        *(u32x4*)(WT + (size_t)(row_off + n0 + n) * K + k0 + 8 * c) = o; }
    asm volatile("s_waitcnt lgkmcnt(0)" ::: "memory");
}

struct Args { const float* in[16]; float* out; unsigned char* ws; int ph_lo, ph_hi; };

__global__ void __launch_bounds__(NWAVES * 64, 2) fwd_megakernel(Args args) {
    __builtin_assume(__builtin_amdgcn_workitem_id_y() == 0); __builtin_assume(__builtin_amdgcn_workitem_id_z() == 0);
    extern __shared__ __attribute__((aligned(16))) unsigned char lds_raw[];
    LAS unsigned char* lds = (LAS unsigned char*)lds_raw;
    const int tid = threadIdx.x, lane = tid & 63, wave = __builtin_amdgcn_readfirstlane(tid >> 6);
    const int G = gridDim.x, bx = blockIdx.x, vcu = (G % 8 == 0) ? (bx % 8) * (G / 8) + bx / 8 : bx;
    const int gw = vcu * NWAVES + wave, NGW = G * NWAVES;
    unsigned char* ws = args.ws;
    const float* x = args.in[0]; const float* p_in = args.in[1]; const float* g_mix = args.in[2]; const float* w_in = args.in[3]; const float* b_forget = args.in[4]; const float* b_gate = args.in[5];
    const float* w_bf = args.in[6]; const float* w_bs = args.in[7]; const float* w_out = args.in[8]; const float* g_mlp = args.in[9]; const float* w_up = args.in[10]; const float* w_dn = args.in[11];
    const float* g_ple = args.in[12]; const float* w_pg = args.in[13]; const float* w_ple = args.in[14]; const float* g_final = args.in[15];
    float* out = args.out;
    bf16_t* Win_t = (bf16_t*)(ws + WS_WIN); bf16_t* Wbf_t = (bf16_t*)(ws + WS_WBF); bf16_t* Wbs_t = (bf16_t*)(ws + WS_WBS); bf16_t* Wout_t = (bf16_t*)(ws + WS_WOUT);
    bf16_t* Wup_t = (bf16_t*)(ws + WS_WUP); bf16_t* Wdn_t = (bf16_t*)(ws + WS_WDN); bf16_t* Wpg_t = (bf16_t*)(ws + WS_WPG); bf16_t* Wple_t = (bf16_t*)(ws + WS_WPLE);
    float* LOGF = (float*)(ws + WS_LOGF); float* CC = (float*)(ws + WS_CC); float* SSQ1 = (float*)(ws + WS_SSQ1); float* SSQ2 = (float*)(ws + WS_SSQ2);
    bf16_t* PB = (bf16_t*)(ws + WS_PB); bf16_t* BUFA = (bf16_t*)(ws + WS_BUFA); bf16_t* BUFB = (bf16_t*)(ws + WS_BUFB); bf16_t* QKV = (bf16_t*)(ws + WS_QKV); bf16_t* SG = (bf16_t*)(ws + WS_SG);
    bf16_t* HB = (bf16_t*)(ws + WS_H); bf16_t* EB = (bf16_t*)(ws + WS_E);
    const int lo = args.ph_lo, hi = args.ph_hi;
#define IN(k) (lo <= (k) && (k) < hi)
#define SEAM(k) do { if (IN(k) && IN((k) + 1)) { cg::this_grid().sync(); } } while (0)

    if (IN(0)) {
        LAS float* scr = (LAS float*)(lds + wave * 16384);
        {
            constexpr int NSEG = 9;
            int base = 0;
            for (int it = gw; ; it += NGW) {
                int r = it; const float* W; int ldw, col0, K, nblk, row_off; bf16_t* WT;
                if (r < 16 * 48) { W = w_in; ldw = NIN_SRC; col0 = 0; K = DM; nblk = 48; WT = Win_t; row_off = 0; }
                else if ((r -= 16 * 48) < 16 * 112) { W = w_in; ldw = NIN_SRC; col0 = 1544; K = DM; nblk = 112; WT = Win_t; row_off = 1536; }
                else if ((r -= 16 * 112) < 8 * 32) { W = w_bf; ldw = DM; col0 = 0; K = 512; nblk = 32; WT = Wbf_t; row_off = 0; }
                else if ((r -= 8 * 32) < 8 * 32) { W = w_bs; ldw = DM; col0 = 0; K = 512; nblk = 32; WT = Wbs_t; row_off = 0; }
                else if ((r -= 8 * 32) < 16 * 32) { W = w_out; ldw = DM; col0 = 0; K = DM; nblk = 32; WT = Wout_t; row_off = 0; }
                else if ((r -= 16 * 32) < 16 * 128) { W = w_up; ldw = DFF; col0 = 0; K = DM; nblk = 128; WT = Wup_t; row_off = 0; }
                else if ((r -= 16 * 128) < 64 * 32) { W = w_dn; ldw = DM; col0 = 0; K = DFF; nblk = 32; WT = Wdn_t; row_off = 0; }
                else if ((r -= 64 * 32) < 16 * 32) { W = w_pg; ldw = DM; col0 = 0; K = DM; nblk = 32; WT = Wpg_t; row_off = 0; }
                else if ((r -= 16 * 32) < 4 * 32) { W = w_ple; ldw = DM; col0 = 0; K = DPLE; nblk = 32; WT = Wple_t; row_off = 0; }
                else break;
                tr_item(W, ldw, col0, K, WT, row_off, scr, r / nblk, r % nblk, lane);
                (void)base; (void)NSEG;
            }
        }
        {
            f32x4 gm[4]; f32x4 wf[4][4][2];
#pragma unroll
            for (int j = 0; j < 4; ++j) { gm[j] = *((const f32x4*)g_mix + lane + 64 * j);
#pragma unroll
                for (int e = 0; e < 4; ++e) { const float* wp = w_in + (size_t)(4 * lane + 256 * j + e) * NIN_SRC + 1536; wf[j][e][0] = *(const f32x4*)wp * gm[j][e]; wf[j][e][1] = *(const f32x4*)(wp + 4) * gm[j][e]; } }
            const float bfv = b_forget[lane & 7];
            for (int m = gw; m < M; m += NGW) {
                const f32x4* xr = (const f32x4*)(x + (size_t)m * DM) + lane;
                f32x4 v[4]; float s = 0.f;
#pragma unroll
                for (int j = 0; j < 4; ++j) { v[j] = xr[64 * j]; s += (v[j][0] * v[j][0] + v[j][1] * v[j][1]) + (v[j][2] * v[j][2] + v[j][3] * v[j][3]); }
                const float rstd = __builtin_amdgcn_rsqf(wave_sum(s) * (1.0f / DM) + EPS);
                f32x4 f0 = {0.f, 0.f, 0.f, 0.f}, f1 = {0.f, 0.f, 0.f, 0.f};
#pragma unroll
                for (int j = 0; j < 4; ++j)
#pragma unroll
                    for (int e = 0; e < 4; ++e) { f0 += wf[j][e][0] * v[j][e]; f1 += wf[j][e][1] * v[j][e]; }
                unsigned long long* o8 = (unsigned long long*)(BUFA + (size_t)m * DM) + lane;
#pragma unroll
                for (int j = 0; j < 4; ++j) { const f32x4 y = v[j] * gm[j] * rstd; o8[64 * j] = (unsigned long long)cvt_pk_bf16(y[0], y[1]) | ((unsigned long long)cvt_pk_bf16(y[2], y[3]) << 32); }
                float fl[8];
#pragma unroll
                for (int e = 0; e < 4; ++e) { fl[e] = wave_sum(f0[e]); fl[4 + e] = wave_sum(f1[e]); }
                float mine = fl[0];
#pragma unroll
                for (int e = 1; e < 8; ++e) mine = ((lane & 7) == e) ? fl[e] : mine;
                const float y2 = (mine * rstd + bfv) * LOG2E;
                const float lf = -(fmaxf(-y2, 0.f) + __builtin_amdgcn_logf(1.0f + __builtin_amdgcn_exp2f(-fabsf(y2))));
                if (lane < 8) LOGF[(size_t)((m / SEQ) * NH + lane) * SEQ + (m % SEQ)] = lf;
            }
        }
        {
            const size_t n8 = (size_t)M * DPLE / 8;
            for (size_t i = (size_t)bx * 512 + tid; i < n8; i += (size_t)G * 512) { const f32x4 a = *((const f32x4*)p_in + 2 * i), c = *((const f32x4*)p_in + 2 * i + 1);
                u32x4 w; w.x = cvt_pk_bf16(a[0], a[1]); w.y = cvt_pk_bf16(a[2], a[3]); w.z = cvt_pk_bf16(c[0], c[1]); w.w = cvt_pk_bf16(c[2], c[3]); *((u32x4*)PB + i) = w; }
        }
    }
    SEAM(0);

    if (IN(1)) {
        if (gw < BATCH * NH) {
            const float* src = LOGF + (size_t)gw * SEQ + lane * 32; float* dst = CC + (size_t)gw * SEQ + lane * 32;
            f32x4 v[8]; float run = 0.f;
#pragma unroll
            for (int j = 0; j < 8; ++j) { v[j] = *((const f32x4*)src + j);
#pragma unroll
                for (int e = 0; e < 4; ++e) { run += v[j][e]; v[j][e] = run; } }
            float incl = run;
#pragma unroll
            for (int o = 1; o < 64; o <<= 1) { const float tv = __shfl_up(incl, o); if (lane >= o) incl += tv; }
            const float excl = incl - run;
#pragma unroll
            for (int j = 0; j < 8; ++j) *((f32x4*)dst + j) = v[j] + excl;
        }
        pg8::Gemm g{DM, DM, DM};
        pg8::PlainSched S; S.T.init(M, NIN, G, bx); S.A = (const char*)BUFA; S.B = (const char*)Win_t; S.astep = (size_t)256 * DM * 2; S.bstep = (size_t)256 * DM * 2;
        pg8::EpiQKVG E{QKV, SG, b_gate};
        pg8::gemm_phase<pg8::EpiQKVG, pg8::PlainSched>(lds, g, S, E);
    }
    SEAM(1);

    if (IN(2)) {
        for (int i = 0; i < 8; ++i) {
            const int j = i & 3, kind = i >> 2;
            for (int bh = (vcu >> 1); bh < BATCH * NH; bh += (G >> 1)) {
                const int s = (vcu & 1) * 2 + (j >> 1); const int qb = (j & 1) ? 7 - s : s;
                if (kind == 0) att::attn_unit<0>(bh / NH, bh % NH, qb, QKV, CC, BUFB, lds);
                else att::attn_unit<1>(bh / NH, bh % NH, qb, QKV, CC, BUFB, lds);
            }
        }
    }
    SEAM(2);

    if (IN(3)) {
        pg8::Gemm g{DM, 512, 512};
        pg8::PairSched S; S.T.init(M, DM, G, bx); S.A0 = (const char*)BUFB; S.A1 = (const char*)(BUFB + 512); S.B0 = (const char*)Wbf_t; S.B1 = (const char*)Wbs_t; S.astep = (size_t)256 * DM * 2; S.bstep = (size_t)256 * 512 * 2;
        pg8::EpiBranch E{SG, BUFA};
        pg8::gemm_phase<pg8::EpiBranch, pg8::PairSched>(lds, g, S, E);
    }
    SEAM(3);

    if (IN(4)) {
        {
            pg8::Gemm g{DM, DM, DM};
            pg8::PlainSched S; S.T.init(M, DM, G, bx); S.A = (const char*)BUFA; S.B = (const char*)Wout_t; S.astep = (size_t)256 * DM * 2; S.bstep = (size_t)256 * DM * 2;
            pg8::EpiRes E{x, out, BUFB, g_mlp, SSQ1};
            pg8::gemm_phase<pg8::EpiRes, pg8::PlainSched>(lds, g, S, E);
        }
        {
            pg8::Gemm g{DPLE, DPLE, DPLE};
            pg8::PlainSched S; S.T.init(M, DM, G, bx); S.A = (const char*)PB; S.B = (const char*)Wple_t; S.astep = (size_t)256 * DPLE * 2; S.bstep = (size_t)256 * DPLE * 2;
            pg8::EpiBf16 E{EB, DM};
            pg8::gemm_phase<pg8::EpiBf16, pg8::PlainSched>(lds, g, S, E);
        }
    }
    SEAM(4);

    if (IN(5)) {
        pg8::Gemm g{DM, DM, DM};
        pg8::PlainSched S; S.T.init(M, DFF, G, bx); S.A = (const char*)BUFB; S.B = (const char*)Wup_t; S.astep = (size_t)256 * DM * 2; S.bstep = (size_t)256 * DM * 2;
        pg8::EpiUp E{HB, SSQ1};
        pg8::gemm_phase<pg8::EpiUp, pg8::PlainSched>(lds, g, S, E);
    }
    SEAM(5);

    if (IN(6)) {
        pg8::Gemm g{DFF, DFF, DFF};
        pg8::PlainSched S; S.T.init(M, DM, G, bx); S.A = (const char*)HB; S.B = (const char*)Wdn_t; S.astep = (size_t)256 * DFF * 2; S.bstep = (size_t)256 * DFF * 2;
        pg8::EpiRes E{out, out, BUFA, g_ple, SSQ2};
        pg8::gemm_phase<pg8::EpiRes, pg8::PlainSched>(lds, g, S, E);
    }
    SEAM(6);

    if (IN(7)) {
        pg8::Gemm g{DM, DM, DM};
        pg8::PlainSched S; S.T.init(M, DM, G, bx); S.A = (const char*)BUFA; S.B = (const char*)Wpg_t; S.astep = (size_t)256 * DM * 2; S.bstep = (size_t)256 * DM * 2;
        pg8::EpiPle E{out, out, EB, SSQ2};
        pg8::gemm_phase<pg8::EpiPle, pg8::PlainSched>(lds, g, S, E);
    }
    SEAM(7);

    if (IN(8)) {
        f32x4 gf[4];
#pragma unroll
        for (int j = 0; j < 4; ++j) gf[j] = *((const f32x4*)g_final + lane + 64 * j);
        for (int m = gw; m < M; m += NGW) {
            f32x4* xr = (f32x4*)(out + (size_t)m * DM) + lane;
            f32x4 v[4]; float s = 0.f;
#pragma unroll
            for (int j = 0; j < 4; ++j) { v[j] = xr[64 * j]; s += (v[j][0] * v[j][0] + v[j][1] * v[j][1]) + (v[j][2] * v[j][2] + v[j][3] * v[j][3]); }
            const float rstd = __builtin_amdgcn_rsqf(wave_sum(s) * (1.0f / DM) + EPS);
#pragma unroll
            for (int j = 0; j < 4; ++j) xr[64 * j] = v[j] * gf[j] * rstd;
        }
    }
#undef IN
#undef SEAM
}

extern "C" void kernel_launch(void* const* d_in, const int* in_sizes, int n_in, void* d_out, int out_size, void* d_ws, size_t ws_size, hipStream_t stream) {
    static int grid = 0;
    if (grid == 0) {
        if (n_in != 16 || in_sizes[0] != M * DM || out_size != M * DM || ws_size < WS_END) { fprintf(stderr, "kernel_launch: unexpected shapes (n_in %d, in0 %d, out %d, ws %zu); nothing launched\n", n_in, n_in > 0 ? in_sizes[0] : -1, out_size, ws_size); grid = -1; return; }
        int dev = 0, cus = 0, per_cu = 0;
        if (hipGetDevice(&dev) != hipSuccess || hipDeviceGetAttribute(&cus, hipDeviceAttributeMultiprocessorCount, dev) != hipSuccess) { grid = -1; return; }
        if (hipFuncSetAttribute((const void*)fwd_megakernel, hipFuncAttributeMaxDynamicSharedMemorySize, LDS_BYTES) != hipSuccess) { fprintf(stderr, "kernel_launch: hipFuncSetAttribute failed\n"); grid = -1; return; }
        if (hipOccupancyMaxActiveBlocksPerMultiprocessor(&per_cu, (const void*)fwd_megakernel, NWAVES * 64, LDS_BYTES) != hipSuccess || per_cu < 1) { fprintf(stderr, "kernel_launch: occupancy query says %d\n", per_cu); per_cu = 1; }
        (void)hipGetLastError();
        grid = cus;
        if (grid != 256) fprintf(stderr, "kernel_launch: %d CUs; built for 256\n", grid);
    }
    if (grid < 0) return;
    Args a{};
    for (int i = 0; i < 16; ++i) a.in[i] = (const float*)d_in[i];
    a.out = (float*)d_out; a.ws = (unsigned char*)d_ws;
#if MK_N_LAUNCHES == 1
    a.ph_lo = 0; a.ph_hi = N_PHASES;
    void* kargs[] = {&a};
    hipError_t e = hipLaunchCooperativeKernel((const void*)fwd_megakernel, dim3(grid), dim3(NWAVES * 64), kargs, LDS_BYTES, stream);
    if (e != hipSuccess) fprintf(stderr, "kernel_launch: cooperative launch failed: %s (grid %d)\n", hipGetErrorString(e), grid);
#else
    for (int li = 0; li < N_PHASES; ++li) { a.ph_lo = li; a.ph_hi = li + 1; hipLaunchKernelGGL(fwd_megakernel, dim3(grid), dim3(NWAVES * 64), LDS_BYTES, stream, a); }
#endif
}
```

```cpp
#include <hip/hip_runtime.h>
#include <hip/hip_cooperative_groups.h>
#include <cstdio>
#include <cstdint>
namespace cg = cooperative_groups;

#ifndef MK_N_LAUNCHES
#define MK_N_LAUNCHES 1
#endif
constexpr int N_PHASES = 9;

#define LAS __attribute__((address_space(3)))
typedef unsigned short bf16_t;
typedef short bf16x8 __attribute__((ext_vector_type(8)));
typedef short s16x4 __attribute__((ext_vector_type(4)));
typedef float f32x4 __attribute__((ext_vector_type(4)));
typedef float f32x2 __attribute__((ext_vector_type(2)));
typedef float f32x16 __attribute__((ext_vector_type(16)));
typedef unsigned u32x4 __attribute__((ext_vector_type(4)));
typedef unsigned u32x2 __attribute__((ext_vector_type(2)));
typedef __bf16 bf16x2_t __attribute__((ext_vector_type(2)));

constexpr int BATCH = 16, SEQ = 2048, DM = 1024, M = BATCH * SEQ, NH = 8, HD = 64, DFF = 4096, DPLE = 256;
constexpr int NIN_SRC = 5128, NQKV = 3072, NGATE = 2048, NIN = NQKV + NGATE;
constexpr float EPS = 1e-6f;
constexpr float LOG2E = 1.4426950408889634f;
constexpr float C2 = 0.125f * LOG2E;

constexpr size_t MiB = 1u << 20;
constexpr size_t WS_WIN = 2 * MiB, WS_WBF = 12 * MiB, WS_WBS = 13 * MiB, WS_WOUT = 14 * MiB, WS_WUP = 16 * MiB, WS_WDN = 24 * MiB, WS_WPG = 32 * MiB, WS_WPLE = 34 * MiB;
constexpr size_t WS_LOGF = 36 * MiB, WS_CC = 37 * MiB, WS_SSQ1 = 38 * MiB, WS_SSQ2 = 40 * MiB;
constexpr size_t WS_PB = 42 * MiB, WS_BUFA = 58 * MiB, WS_BUFB = 122 * MiB, WS_QKV = 186 * MiB, WS_SG = 378 * MiB, WS_H = 186 * MiB, WS_E = 442 * MiB, WS_END = 506 * MiB;

__device__ __forceinline__ unsigned cvt_pk_bf16(float lo, float hi) { f32x2 v = {lo, hi}; bf16x2_t b = __builtin_convertvector(v, bf16x2_t); return __builtin_bit_cast(unsigned, b); }
__device__ __forceinline__ float bf_lo(unsigned w) { return __uint_as_float(w << 16); }
__device__ __forceinline__ float bf_hi(unsigned w) { return __uint_as_float(w & 0xffff0000u); }
__device__ __forceinline__ float fast_sigmoid(float v) { return __builtin_amdgcn_rcpf(1.0f + __builtin_amdgcn_exp2f(-v * LOG2E)); }

__device__ __forceinline__ const char* uni_ptr(const char* p) { const unsigned long long v = (unsigned long long)p; const unsigned lo = __builtin_amdgcn_readfirstlane((unsigned)v), hi = __builtin_amdgcn_readfirstlane((unsigned)(v >> 32)); return (const char*)(((unsigned long long)hi << 32) | lo); }
namespace pg8 {
constexpr int BM = 256, BK = 64, HALF = 128, HTB = HALF * BK * 2, STAGE_BYTES = 8 * HTB, NXCD = 8, WGM = 8;
__host__ __device__ __forceinline__ int lds_byte(int r, int c) { const int st = (r >> 4) * 2 + (c >> 5), rr = r & 15, cc = c & 31, ob = rr * 64 + cc * 2; return st * 1024 + (ob ^ (((ob >> 9) & 1) << 5)); }
__host__ __device__ __forceinline__ void stage_rc(int b, int& R, int& C) { const int st = b / 1024, sb = b % 1024, swz = sb ^ (((sb >> 9) & 1) << 5); R = (st >> 1) * 16 + swz / 64; C = (st & 1) * 32 + (swz % 64) / 2; }
__host__ __device__ __forceinline__ int perm32(int rho) { const int n = rho >> 4, i = rho & 15; return 8 * (i >> 2) + 4 * n + (i & 3); }

struct Unit { int pm, pn; const char* A; const char* B; int chain; };
struct Gemm { int lda, ldb, K; };

struct TileOrder {
    int nM, nN, nwg, G, c;
    __device__ void init(int Mrows, int N, int G_, int c_) { nM = Mrows / BM; nN = N / BM; nwg = nM * nN; G = G_; c = c_; }
    __device__ bool tile(int i, int& pm, int& pn) const {
        const long L = (long)i * G + c; if (L >= nwg) return false;
        int wgid = (int)L; { const int q = nwg / NXCD, r = nwg % NXCD, xcd = wgid % NXCD, off = wgid / NXCD; wgid = (xcd < r ? xcd * (q + 1) : r * (q + 1) + (xcd - r) * q) + off; }
        const int nig = WGM * nN, gid = wgid / nig, fm = gid * WGM, gsz = (nM - fm) < WGM ? (nM - fm) : WGM;
        pm = fm + ((wgid % nig) % gsz); pn = (wgid % nig) / gsz; return true;
    }
};
struct PlainSched {
    TileOrder T; const char* A; const char* B; size_t astep, bstep;
    __device__ bool next(int i, Unit& u) const { int pm, pn; if (!T.tile(i, pm, pn)) return false; u.pm = pm; u.pn = pn; u.A = A + (size_t)pm * astep; u.B = B + (size_t)pn * bstep; u.chain = 0; return true; }
};
struct PairSched {
    TileOrder T; const char* A0; const char* A1; const char* B0; const char* B1; size_t astep, bstep;
    __device__ bool next(int i, Unit& u) const { int pm, pn; if (!T.tile(i >> 1, pm, pn)) return false; const int s = i & 1; u.pm = pm; u.pn = pn;
        u.A = (s ? A1 : A0) + (size_t)pm * astep; u.B = (s ? B1 : B0) + (size_t)pn * bstep; u.chain = s ? 0 : 1; return true; }
};

typedef f32x4 Acc[2][2][4][2];

struct EpiQKVG {
    static constexpr bool PERM = true;
    bf16_t* QKV; bf16_t* SG; const float* bgate;
    __device__ __forceinline__ void operator()(Acc& acc, const Unit& u, int wr, int wc, int fr, int fq) const {
        const int row0 = u.pm * BM + wr * 64 + fr;
        if (u.pn < 12) {
            const float sc = (u.pn < 2 || (u.pn >= 6 && u.pn < 8)) ? C2 : 1.0f;
            const int col0 = u.pn * BM + wc * 32 + 8 * fq;
#pragma unroll
            for (int ai = 0; ai < 2; ++ai)
#pragma unroll
                for (int m = 0; m < 4; ++m) { bf16_t* rowp = QKV + (size_t)(row0 + ai * HALF + m * 16) * NQKV + col0;
#pragma unroll
                    for (int bj = 0; bj < 2; ++bj) { const f32x4 v0 = acc[ai][bj][m][0] * sc, v1 = acc[ai][bj][m][1] * sc;
                        u32x4 w; w.x = cvt_pk_bf16(v0[0], v0[1]); w.y = cvt_pk_bf16(v0[2], v0[3]); w.z = cvt_pk_bf16(v1[0], v1[1]); w.w = cvt_pk_bf16(v1[2], v1[3]);
                        *(u32x4*)(rowp + bj * HALF) = w; } }
        } else {
            const int col0 = (u.pn - 12) * BM + wc * 32 + 8 * fq;
            f32x4 bv[2][2];
#pragma unroll
            for (int bj = 0; bj < 2; ++bj)
#pragma unroll
                for (int n = 0; n < 2; ++n) bv[bj][n] = *(const f32x4*)(bgate + col0 + bj * HALF + 4 * n);
#pragma unroll
            for (int ai = 0; ai < 2; ++ai)
#pragma unroll
                for (int m = 0; m < 4; ++m) { bf16_t* rowp = SG + (size_t)(row0 + ai * HALF + m * 16) * NGATE + col0;
#pragma unroll
                    for (int bj = 0; bj < 2; ++bj) { const f32x4 a0 = acc[ai][bj][m][0] + bv[bj][0], a1 = acc[ai][bj][m][1] + bv[bj][1];
                        u32x4 w; w.x = cvt_pk_bf16(fast_sigmoid(a0[0]), fast_sigmoid(a0[1])); w.y = cvt_pk_bf16(fast_sigmoid(a0[2]), fast_sigmoid(a0[3]));
                        w.z = cvt_pk_bf16(fast_sigmoid(a1[0]), fast_sigmoid(a1[1])); w.w = cvt_pk_bf16(fast_sigmoid(a1[2]), fast_sigmoid(a1[3]));
                        *(u32x4*)(rowp + bj * HALF) = w; } }
        }
    }
};
struct EpiBf16 {
    static constexpr bool PERM = true;
    bf16_t* O; int ldc;
    __device__ __forceinline__ void operator()(Acc& acc, const Unit& u, int wr, int wc, int fr, int fq) const {
        const int row0 = u.pm * BM + wr * 64 + fr, col0 = u.pn * BM + wc * 32 + 8 * fq;
#pragma unroll
        for (int ai = 0; ai < 2; ++ai)
#pragma unroll
            for (int m = 0; m < 4; ++m) { bf16_t* rowp = O + (size_t)(row0 + ai * HALF + m * 16) * ldc + col0;
#pragma unroll
                for (int bj = 0; bj < 2; ++bj) { const f32x4 v0 = acc[ai][bj][m][0], v1 = acc[ai][bj][m][1];
                    u32x4 w; w.x = cvt_pk_bf16(v0[0], v0[1]); w.y = cvt_pk_bf16(v0[2], v0[3]); w.z = cvt_pk_bf16(v1[0], v1[1]); w.w = cvt_pk_bf16(v1[2], v1[3]);
                    *(u32x4*)(rowp + bj * HALF) = w; } }
    }
};
struct EpiBranch {
    static constexpr bool PERM = true;
    const bf16_t* SG; bf16_t* MG;
    __device__ __forceinline__ void operator()(Acc& acc, const Unit& u, int wr, int wc, int fr, int fq) const {
        const int row0 = u.pm * BM + wr * 64 + fr, col0 = u.pn * BM + wc * 32 + 8 * fq;
#pragma unroll
        for (int ai = 0; ai < 2; ++ai)
#pragma unroll
            for (int m = 0; m < 4; ++m) { const size_t row = (size_t)(row0 + ai * HALF + m * 16);
#pragma unroll
                for (int bj = 0; bj < 2; ++bj) {
                    const u32x4 gb = *(const u32x4*)(SG + row * NGATE + DM + col0 + bj * HALF);
                    f32x4 b0 = {bf_lo(gb.x), bf_hi(gb.x), bf_lo(gb.y), bf_hi(gb.y)}, b1 = {bf_lo(gb.z), bf_hi(gb.z), bf_lo(gb.w), bf_hi(gb.w)};
                    if (u.chain) {
                        const u32x4 ga = *(const u32x4*)(SG + row * NGATE + col0 + bj * HALF);
                        const f32x4 a0 = {bf_lo(ga.x), bf_hi(ga.x), bf_lo(ga.y), bf_hi(ga.y)}, a1 = {bf_lo(ga.z), bf_hi(ga.z), bf_lo(ga.w), bf_hi(ga.w)};
#pragma unroll
                        for (int e = 0; e < 4; ++e) { acc[ai][bj][m][0][e] *= a0[e] * __builtin_amdgcn_rcpf(fmaxf(b0[e], 1e-30f)); acc[ai][bj][m][1][e] *= a1[e] * __builtin_amdgcn_rcpf(fmaxf(b1[e], 1e-30f)); }
                    } else {
                        const f32x4 v0 = acc[ai][bj][m][0] * b0, v1 = acc[ai][bj][m][1] * b1;
                        u32x4 w; w.x = cvt_pk_bf16(v0[0], v0[1]); w.y = cvt_pk_bf16(v0[2], v0[3]); w.z = cvt_pk_bf16(v1[0], v1[1]); w.w = cvt_pk_bf16(v1[2], v1[3]);
                        *(u32x4*)(MG + row * DM + col0 + bj * HALF) = w;
                    }
                }
                asm volatile("" ::: "memory"); }
    }
};
struct EpiRes {
    static constexpr bool PERM = false;
    const float* base; float* out; bf16_t* an; const float* g; float* ssq;
    __device__ __forceinline__ void operator()(Acc& acc, const Unit& u, int wr, int wc, int fr, int fq) const {
        const int col0 = u.pn * BM + wc * 32 + 4 * fq;
        f32x4 gv[2][2];
#pragma unroll
        for (int bj = 0; bj < 2; ++bj)
#pragma unroll
            for (int n = 0; n < 2; ++n) gv[bj][n] = *(const f32x4*)(g + col0 + bj * HALF + n * 16);
#pragma unroll
        for (int ai = 0; ai < 2; ++ai)
#pragma unroll
            for (int m = 0; m < 4; ++m) { const int row = u.pm * BM + ai * HALF + wr * 64 + m * 16 + fr; const size_t off = (size_t)row * DM + col0; float s = 0.f;
#pragma unroll
                for (int bj = 0; bj < 2; ++bj)
#pragma unroll
                    for (int n = 0; n < 2; ++n) { const f32x4 bs = *(const f32x4*)(base + off + bj * HALF + n * 16); const f32x4 x1 = bs + acc[ai][bj][m][n];
                        *(f32x4*)(out + off + bj * HALF + n * 16) = x1; s += (x1[0] * x1[0] + x1[1] * x1[1]) + (x1[2] * x1[2] + x1[3] * x1[3]);
                        const f32x4 y = x1 * gv[bj][n]; u32x2 w; w.x = cvt_pk_bf16(y[0], y[1]); w.y = cvt_pk_bf16(y[2], y[3]); *(u32x2*)(an + off + bj * HALF + n * 16) = w; }
                s += __shfl_xor(s, 16); s += __shfl_xor(s, 32);
                if (fq == 0) ssq[(size_t)row * 16 + u.pn * 4 + wc] = s;
                asm volatile("" ::: "memory"); }
    }
};
__device__ __forceinline__ float row_rstd(const float* ssq, int row) {
    const f32x4* p = (const f32x4*)(ssq + (size_t)row * 16); const f32x4 a = p[0], b = p[1], c = p[2], d = p[3];
    const float s = ((a[0] + a[1]) + (a[2] + a[3])) + ((b[0] + b[1]) + (b[2] + b[3])) + ((c[0] + c[1]) + (c[2] + c[3])) + ((d[0] + d[1]) + (d[2] + d[3]));
    return __builtin_amdgcn_rsqf(s * (1.0f / DM) + EPS);
}
struct EpiUp {
    static constexpr bool PERM = true;
    bf16_t* H; const float* ssq;
    __device__ __forceinline__ void operator()(Acc& acc, const Unit& u, int wr, int wc, int fr, int fq) const {
        const int row0 = u.pm * BM + wr * 64 + fr, col0 = u.pn * BM + wc * 32 + 8 * fq;
#pragma unroll
        for (int ai = 0; ai < 2; ++ai)
#pragma unroll
            for (int m = 0; m < 4; ++m) { const int row = row0 + ai * HALF + m * 16; const float r = row_rstd(ssq, row); bf16_t* rowp = H + (size_t)row * DFF + col0;
#pragma unroll
                for (int bj = 0; bj < 2; ++bj) { f32x4 v0 = acc[ai][bj][m][0] * r, v1 = acc[ai][bj][m][1] * r;
#pragma unroll
                    for (int e = 0; e < 4; ++e) { const float a = fmaxf(v0[e], 0.f), b = fmaxf(v1[e], 0.f); v0[e] = a * a; v1[e] = b * b; }
                    u32x4 w; w.x = cvt_pk_bf16(v0[0], v0[1]); w.y = cvt_pk_bf16(v0[2], v0[3]); w.z = cvt_pk_bf16(v1[0], v1[1]); w.w = cvt_pk_bf16(v1[2], v1[3]);
                    *(u32x4*)(rowp + bj * HALF) = w; }
                asm volatile("" ::: "memory"); }
    }
};
struct EpiPle {
    static constexpr bool PERM = false;
    const float* base; float* out; const bf16_t* E; const float* ssq;
    __device__ __forceinline__ void operator()(Acc& acc, const Unit& u, int wr, int wc, int fr, int fq) const {
        const int col0 = u.pn * BM + wc * 32 + 4 * fq;
#pragma unroll
        for (int ai = 0; ai < 2; ++ai)
#pragma unroll
            for (int m = 0; m < 4; ++m) { const int row = u.pm * BM + ai * HALF + wr * 64 + m * 16 + fr; const size_t off = (size_t)row * DM + col0; const float r = row_rstd(ssq, row);
#pragma unroll
                for (int bj = 0; bj < 2; ++bj)
#pragma unroll
                    for (int n = 0; n < 2; ++n) { const f32x4 bs = *(const f32x4*)(base + off + bj * HALF + n * 16); const u32x2 ew = *(const u32x2*)(E + off + bj * HALF + n * 16);
                        const f32x4 ev = {bf_lo(ew.x), bf_hi(ew.x), bf_lo(ew.y), bf_hi(ew.y)}; const f32x4 a = acc[ai][bj][m][n] * r; f32x4 o;
#pragma unroll
                        for (int e = 0; e < 4; ++e) o[e] = bs[e] + fast_sigmoid(a[e]) * ev[e];
                        *(f32x4*)(out + off + bj * HALF + n * 16) = o; }
                asm volatile("" ::: "memory"); }
    }
};

template <class Epi, class Sched>
__device__ __forceinline__ void gemm_phase(LAS unsigned char* lds, const Gemm g, const Sched& S, const Epi& E) {
    const int tid = threadIdx.x, wid = __builtin_amdgcn_readfirstlane(tid >> 6), lane = tid & 63, wr = wid >> 2, wc = wid & 3, fr = lane & 15, fq = lane >> 4;
    const int K = g.K, nt = K / BK;
    unsigned voffA[2], voffB[2];
#pragma unroll
    for (int i = 0; i < 2; ++i) { int R, C; stage_rc(tid * 16 + i * 8192, R, C); const int Rb = Epi::PERM ? ((R & ~31) + perm32(R & 31)) : R;
        voffA[i] = (unsigned)(R * g.lda + C) * 2u; voffB[i] = (unsigned)(Rb * g.ldb + C) * 2u; }
    const size_t kstep = (size_t)(BK * 2);
    const size_t hA = (size_t)HALF * g.lda * 2, hB = (size_t)HALF * g.ldb * 2;
    const unsigned ldsw = (unsigned)wid * 1024u;
    const int aoff = lds_byte(wr * 64 + fr, fq * 8), boff = lds_byte(wc * 32 + fr, fq * 8);
#define PG8_SA(b, h) (((b) * 2 + (h)) * HTB)
#define PG8_SB(b, h) ((4 + (b) * 2 + (h)) * HTB)
#define PG8_STAGE(bufoff, gbase, voff) do { _Pragma("unroll") for (int _i = 0; _i < 2; ++_i) \
        __builtin_amdgcn_global_load_lds((const unsigned*)((const char*)(gbase) + (voff)[_i]), (LAS unsigned*)(lds + (bufoff) + ldsw + _i * 8192), 16, 0, 0); } while (0)
#define PG8_LDA(dst, b, h) do { _Pragma("unroll") for (int m = 0; m < 4; ++m) _Pragma("unroll") for (int k = 0; k < 2; ++k) dst[m][k] = *(const LAS bf16x8*)(lds + PG8_SA(b, h) + aoff + m * 2048 + k * 1024); } while (0)
#define PG8_LDB(dst, b, h) do { _Pragma("unroll") for (int n = 0; n < 2; ++n) _Pragma("unroll") for (int k = 0; k < 2; ++k) dst[n][k] = *(const LAS bf16x8*)(lds + PG8_SB(b, h) + boff + n * 2048 + k * 1024); } while (0)
#define PG8_MMA(ai, bj, At, Bt) do { __builtin_amdgcn_s_setprio(1); _Pragma("unroll") for (int m = 0; m < 4; ++m) _Pragma("unroll") for (int n = 0; n < 2; ++n) _Pragma("unroll") for (int k = 0; k < 2; ++k) \
        acc[ai][bj][m][n] = __builtin_amdgcn_mfma_f32_16x16x32_bf16(Bt[n][k], At[m][k], acc[ai][bj][m][n], 0, 0, 0); __builtin_amdgcn_s_setprio(0); } while (0)
#define PG8_WAIT_V(n) asm volatile("s_waitcnt vmcnt(" #n ")" ::: "memory")
#define PG8_WAIT_L(n) asm volatile("s_waitcnt lgkmcnt(" #n ")" ::: "memory")
#define PG8_BAR __builtin_amdgcn_s_barrier()
#define PG8_SCHED __builtin_amdgcn_sched_barrier(0)
#define PG8_ZERO() do { _Pragma("unroll") for (int a = 0; a < 2; ++a) _Pragma("unroll") for (int b = 0; b < 2; ++b) _Pragma("unroll") for (int m = 0; m < 4; ++m) _Pragma("unroll") for (int n = 0; n < 2; ++n) acc[a][b][m][n] = (f32x4){0.f, 0.f, 0.f, 0.f}; } while (0)
    Unit cur, nxt; int ui = 0;
    if (!S.next(0, cur)) return;
    Acc acc;
    PG8_ZERO();
    bf16x8 At[4][2], B0[2][2], B1[2][2];
    const char* cA = uni_ptr(cur.A); const char* cB = uni_ptr(cur.B);
    PG8_STAGE(PG8_SB(0, 0), cB, voffB); PG8_STAGE(PG8_SB(0, 1), cB + hB, voffB); PG8_STAGE(PG8_SA(0, 0), cA, voffA); PG8_STAGE(PG8_SA(0, 1), cA + hA, voffA);
    if (wr == 1) PG8_BAR;
    PG8_WAIT_V(2); PG8_BAR;
    PG8_STAGE(PG8_SB(1, 0), cB + kstep, voffB); PG8_STAGE(PG8_SA(1, 0), cA + kstep, voffA); PG8_STAGE(PG8_SB(1, 1), cB + hB + kstep, voffB);
    PG8_WAIT_V(6); PG8_BAR;
    for (;;) {
        const bool has_next = S.next(ui + 1, nxt);
        const char* nA = uni_ptr(has_next ? nxt.A : cA); const char* nB = uni_ptr(has_next ? nxt.B : cB);
#pragma nounroll
        for (int t = 0; t < nt; t += 2) {
            const bool last = (t == nt - 2);
            const char* a1 = cA + (size_t)(t + 1) * kstep;
            const char* a2 = last ? nA : cA + (size_t)(t + 2) * kstep; const char* b2 = last ? nB : cB + (size_t)(t + 2) * kstep;
            const char* a3 = a2 + kstep; const char* b3 = b2 + kstep;
            PG8_LDB(B0, 0, 0); PG8_LDB(B1, 0, 1); PG8_SCHED; PG8_LDA(At, 0, 0); PG8_STAGE(PG8_SA(1, 1), a1 + hA, voffA);
            PG8_WAIT_V(8); PG8_WAIT_L(0); PG8_BAR; PG8_MMA(0, 0, At, B0); PG8_MMA(0, 1, At, B1); PG8_BAR; PG8_SCHED;
            PG8_LDA(At, 0, 1); PG8_STAGE(PG8_SB(0, 0), b2, voffB); PG8_STAGE(PG8_SB(0, 1), b2 + hB, voffB); PG8_STAGE(PG8_SA(0, 0), a2, voffA);
            PG8_WAIT_V(8); PG8_WAIT_L(0); PG8_BAR; PG8_MMA(1, 0, At, B0); PG8_MMA(1, 1, At, B1); PG8_BAR; PG8_SCHED;
            PG8_LDB(B0, 1, 0); PG8_LDB(B1, 1, 1); PG8_SCHED; PG8_LDA(At, 1, 0); PG8_STAGE(PG8_SA(0, 1), a2 + hA, voffA);
            PG8_WAIT_V(8); PG8_WAIT_L(0); PG8_BAR; PG8_MMA(0, 0, At, B0); PG8_MMA(0, 1, At, B1); PG8_BAR; PG8_SCHED;
            PG8_LDA(At, 1, 1); PG8_STAGE(PG8_SB(1, 0), b3, voffB); PG8_STAGE(PG8_SB(1, 1), b3 + hB, voffB); PG8_STAGE(PG8_SA(1, 0), a3, voffA);
            PG8_WAIT_V(8); PG8_WAIT_L(0); PG8_BAR; PG8_MMA(1, 0, At, B0); PG8_MMA(1, 1, At, B1); PG8_BAR; PG8_SCHED;
        }
        if (wr == 0) PG8_BAR;
        E(acc, cur, wr, wc, fr, fq);
        if (!has_next) break;
        if (!cur.chain) PG8_ZERO();
        cur = nxt; cA = nA; cB = nB; ++ui;
        if (wr == 1) PG8_BAR;
    }
    PG8_WAIT_V(0);
    PG8_BAR;
#undef PG8_SA
#undef PG8_SB
#undef PG8_STAGE
#undef PG8_LDA
#undef PG8_LDB
#undef PG8_MMA
#undef PG8_WAIT_V
#undef PG8_WAIT_L
#undef PG8_BAR
#undef PG8_SCHED
#undef PG8_ZERO
}
}

namespace att {
constexpr int PITCH = NQKV, OPITCH = DM;
constexpr int L_K = 0, L_V = 8192, BUFSZ = 16384;
constexpr int L_WS = 2 * BUFSZ, L_OST = L_WS + 8 * 256, L_FLAG = L_OST + 8 * 4096, L_END = L_FLAG + 64;
constexpr float SB_THR = -160.0f;
__device__ __forceinline__ int crow(int r, int hi) { return (r & 3) + 8 * (r >> 2) + 4 * hi; }
__device__ __forceinline__ s16x4 vtr(const LAS unsigned char* p) { typedef short v4i16_t __attribute__((ext_vector_type(4))); return __builtin_bit_cast(s16x4, __builtin_amdgcn_ds_read_tr16_b64_v4i16((LAS v4i16_t*)p)); }
__device__ __forceinline__ void swap_halves(float v, float& lo, float& hi_) { auto rr = __builtin_amdgcn_permlane32_swap(__float_as_uint(v), __float_as_uint(v), false, false); lo = __uint_as_float(rr[0]); hi_ = __uint_as_float(rr[1]); }

template <int KIND>
__device__ __forceinline__ void attn_unit(int b, int h, int qb, const bf16_t* QKV, const float* cc, bf16_t* O, LAS unsigned char* lds) {
    const int tid = threadIdx.x, lane = tid & 63, r32 = lane & 31, hi = lane >> 5; const int wid = __builtin_amdgcn_readfirstlane(tid >> 6);
    const size_t rowbase = (size_t)b * SEQ; const int q0 = qb * 256, qw = q0 + wid * 32, qabs = qw + r32;
    const int colq = KIND * 1536 + h * HD;
    const bf16_t* Qw = QKV + (rowbase + qw) * PITCH + colq;
    bf16x8 qr[4];
#pragma unroll
    for (int d0 = 0; d0 < 4; ++d0) qr[d0] = *(const bf16x8*)(Qw + (size_t)r32 * PITCH + d0 * 16 + hi * 8);
    const bf16_t* ksrc = QKV + rowbase * PITCH + colq + 512 + (size_t)lane * PITCH + wid * 8;
    const bf16_t* vsrc = QKV + rowbase * PITCH + colq + 1024 + (size_t)(16 * (wid & 3) + (lane >> 2)) * PITCH + (wid >> 2) * 32 + (lane & 3) * 8;
    const int wdst = wid * 1024 + lane * 16;
    const int T_last = qb * 4 + 3, td = qw >> 6;
    LAS float* wsf = (LAS float*)(lds + L_WS) + wid * 64;
    LAS unsigned* flags = (LAS unsigned*)(lds + L_FLAG);
    const float* ccb = cc + (size_t)(b * NH + h) * SEQ;
    float cref = 0.f; if (KIND == 0) cref = ccb[q0 + 255];
    u32x4 kreg = *(const u32x4*)(ksrc + (size_t)T_last * 64 * PITCH), vreg = *(const u32x4*)(vsrc + (size_t)T_last * 64 * PITCH);
    *(LAS u32x4*)(lds + L_K + wdst) = kreg; *(LAS u32x4*)(lds + L_V + wdst) = vreg;
    __syncthreads();
    f32x16 o[2]; o[0] = (f32x16){}; o[1] = (f32x16){};
    float mrun = -INFINITY, lrun = 0.f, R = 0.f; bool mydone = false;
    for (int it = 0;; ++it) {
        const int t = T_last - it; const int buf = (it & 1) * BUFSZ;
        if (t > 0) { kreg = *(const u32x4*)(ksrc + (size_t)(t - 1) * 64 * PITCH); vreg = *(const u32x4*)(vsrc + (size_t)(t - 1) * 64 * PITCH); }
        if (t <= td && !mydone) {
            f32x16 p0 = (f32x16){}, p1 = (f32x16){};
            const LAS unsigned char* kb = lds + buf + L_K + hi * 1024 + r32 * 16;
#pragma unroll
            for (int d0 = 0; d0 < 4; ++d0) { const bf16x8 b0 = *(const LAS bf16x8*)(kb + d0 * 2048), b1 = *(const LAS bf16x8*)(kb + d0 * 2048 + 512);
                p0 = __builtin_amdgcn_mfma_f32_32x32x16_bf16(b0, qr[d0], p0, 0, 0, 0); p1 = __builtin_amdgcn_mfma_f32_32x32x16_bf16(b1, qr[d0], p1, 0, 0, 0); }
            const bool diag = (t == td); const int kv0 = t * 64 + 4 * hi;
            if (KIND == 0) {
                const float* cb = ccb + t * 64 + 4 * hi;
#pragma unroll
                for (int g = 0; g < 4; ++g) { const f32x4 c0 = *(const f32x4*)(cb + 8 * g), c1 = *(const f32x4*)(cb + 32 + 8 * g);
#pragma unroll
                    for (int i = 0; i < 4; ++i) { p0[4 * g + i] += cref - c0[i]; p1[4 * g + i] += cref - c1[i]; } }
                if (diag) {
#pragma unroll
                    for (int r = 0; r < 16; ++r) { const int kv = kv0 + (r & 3) + 8 * (r >> 2); if (kv > qabs) p0[r] = -INFINITY; if (kv + 32 > qabs) p1[r] = -INFINITY; }
                }
                float rm = fmaxf(p0[0], p1[0]);
#pragma unroll
                for (int r = 1; r < 16; ++r) rm = fmaxf(rm, fmaxf(p0[r], p1[r]));
                { float a, c; swap_halves(rm, a, c); rm = fmaxf(a, c); }
                const float mnew = fmaxf(mrun, rm); const float f = __builtin_amdgcn_exp2f(mrun - mnew); mrun = mnew;
                float ls = 0.f;
#pragma unroll
                for (int r = 0; r < 16; ++r) { p0[r] = __builtin_amdgcn_exp2f(p0[r] - mnew); p1[r] = __builtin_amdgcn_exp2f(p1[r] - mnew); ls += p0[r] + p1[r]; }
                lrun = lrun * f + ls;
                if (__any(f != 1.0f)) {
                    if (hi == 0) wsf[r32] = f;
                    asm volatile("s_waitcnt lgkmcnt(0)" ::: "memory");
#pragma unroll
                    for (int r = 0; r < 16; ++r) { const float fr_ = wsf[crow(r, hi)]; o[0][r] *= fr_; o[1][r] *= fr_; }
                    asm volatile("s_waitcnt lgkmcnt(0)" ::: "memory");
                }
            } else {
                f32x16 l0, l1;
#pragma unroll
                for (int r = 0; r < 16; ++r) {
                    const int kv = kv0 + (r & 3) + 8 * (r >> 2);
                    { const float z = p0[r]; const float tt = __builtin_amdgcn_logf(1.0f + __builtin_amdgcn_exp2f(-fabsf(z))); float L = -(fmaxf(z, 0.f) + tt); if (diag && !(kv < qabs)) L = 0.f; l0[r] = L; }
                    { const float z = p1[r]; const float tt = __builtin_amdgcn_logf(1.0f + __builtin_amdgcn_exp2f(-fabsf(z))); float L = -(fmaxf(z, 0.f) + tt); if (diag && !(kv + 32 < qabs)) L = 0.f; l1[r] = L; }
                }
                float G[8], Gp[8];
#pragma unroll
                for (int g = 0; g < 4; ++g) { G[g] = (l0[4 * g] + l0[4 * g + 1]) + (l0[4 * g + 2] + l0[4 * g + 3]); G[4 + g] = (l1[4 * g] + l1[4 * g + 1]) + (l1[4 * g + 2] + l1[4 * g + 3]); }
#pragma unroll
                for (int c = 0; c < 8; ++c) { float a, d; swap_halves(G[c], a, d); Gp[c] = hi ? a : d; }
                float cs = 0.f;
#pragma unroll
                for (int c = 7; c >= 0; --c) {
                    const float ex = cs + (hi ? 0.f : Gp[c]);
                    const int g = c & 3;
                    if (c >= 4) { float s3 = l1[4 * g + 3] + ex, s2 = l1[4 * g + 2] + s3, s1 = l1[4 * g + 1] + s2, s0 = l1[4 * g] + s1; l1[4 * g + 3] = s3; l1[4 * g + 2] = s2; l1[4 * g + 1] = s1; l1[4 * g] = s0; }
                    else        { float s3 = l0[4 * g + 3] + ex, s2 = l0[4 * g + 2] + s3, s1 = l0[4 * g + 1] + s2, s0 = l0[4 * g] + s1; l0[4 * g + 3] = s3; l0[4 * g + 2] = s2; l0[4 * g + 1] = s1; l0[4 * g] = s0; }
                    cs += G[c] + Gp[c];
                }
#pragma unroll
                for (int r = 0; r < 16; ++r) {
                    const int kv = kv0 + (r & 3) + 8 * (r >> 2);
                    float w0 = __builtin_amdgcn_exp2f(p0[r] + l0[r] + R), w1 = __builtin_amdgcn_exp2f(p1[r] + l1[r] + R);
                    if (diag && !(kv < qabs)) w0 = 0.f; if (diag && !(kv + 32 < qabs)) w1 = 0.f;
                    p0[r] = w0; p1[r] = w1;
                }
                R += cs;
                mydone = __all(R < SB_THR);
            }
            u32x4 pw[4];
            pw[0] = (u32x4){cvt_pk_bf16(p0[0], p0[1]), cvt_pk_bf16(p0[2], p0[3]), cvt_pk_bf16(p0[4], p0[5]), cvt_pk_bf16(p0[6], p0[7])};
            pw[1] = (u32x4){cvt_pk_bf16(p0[8], p0[9]), cvt_pk_bf16(p0[10], p0[11]), cvt_pk_bf16(p0[12], p0[13]), cvt_pk_bf16(p0[14], p0[15])};
            pw[2] = (u32x4){cvt_pk_bf16(p1[0], p1[1]), cvt_pk_bf16(p1[2], p1[3]), cvt_pk_bf16(p1[4], p1[5]), cvt_pk_bf16(p1[6], p1[7])};
            pw[3] = (u32x4){cvt_pk_bf16(p1[8], p1[9]), cvt_pk_bf16(p1[10], p1[11]), cvt_pk_bf16(p1[12], p1[13]), cvt_pk_bf16(p1[14], p1[15])};
            const LAS unsigned char* vp = lds + buf + L_V + ((lane >> 4) & 1) * 32 + (lane & 3) * 8 + (4 * hi + ((lane & 15) >> 2)) * 64;
#pragma unroll
            for (int d0 = 0; d0 < 2; ++d0)
#pragma unroll
                for (int ks = 0; ks < 4; ++ks) { const s16x4 lo = vtr(vp + d0 * 4096 + ks * 1024), hh = vtr(vp + d0 * 4096 + ks * 1024 + 512);
                    const bf16x8 vf = {lo[0], lo[1], lo[2], lo[3], hh[0], hh[1], hh[2], hh[3]};
                    o[d0] = __builtin_amdgcn_mfma_f32_32x32x16_bf16(__builtin_bit_cast(bf16x8, pw[ks]), vf, o[d0], 0, 0, 0); }
        }
        if (KIND == 1) { if (lane == 0) flags[(it & 1) * 8 + wid] = mydone ? 1u : 0u; }
        if (t > 0) { *(LAS u32x4*)(lds + (buf ^ BUFSZ) + L_K + wdst) = kreg; *(LAS u32x4*)(lds + (buf ^ BUFSZ) + L_V + wdst) = vreg; }
        __syncthreads();
        if (t == 0) break;
        if (KIND == 1) { const u32x4 fa = *(const LAS u32x4*)(flags + (it & 1) * 8), fb = *(const LAS u32x4*)(flags + (it & 1) * 8 + 4);
            if ((fa.x & fa.y & fa.z & fa.w & fb.x & fb.y & fb.z & fb.w) != 0u) break; }
    }
    float inv = 1.0f;
    if (KIND == 0) { float a, c; swap_halves(lrun, a, c); inv = 1.0f / (a + c); }
    if (hi == 0) wsf[32 + r32] = inv;
    asm volatile("s_waitcnt lgkmcnt(0)" ::: "memory");
    LAS bf16_t* stg = (LAS bf16_t*)(lds + L_OST) + wid * 2048;
#pragma unroll
    for (int r = 0; r < 16; ++r) { const int orow = crow(r, hi); const float rl = wsf[32 + orow];
        const unsigned w = cvt_pk_bf16(o[0][r] * rl, o[1][r] * rl);
        stg[orow * 64 + r32] = (bf16_t)(w & 0xffffu); stg[orow * 64 + 32 + r32] = (bf16_t)(w >> 16); }
    asm volatile("s_waitcnt lgkmcnt(0)" ::: "memory");
    bf16_t* Ow = O + (rowbase + qw) * OPITCH + KIND * 512 + h * HD;
#pragma unroll
    for (int i = 0; i < 4; ++i) { const int row = i * 8 + (lane >> 3), ch = lane & 7; const u32x4 v = *(const LAS u32x4*)(stg + row * 64 + ch * 8); *(u32x4*)(Ow + (size_t)row * OPITCH + ch * 8) = v; }
    asm volatile("s_waitcnt lgkmcnt(0)" ::: "memory");
}
}

#define XB_TMO      128
#define XB_XCNT(j)  (256  + 64 * (j))
#define XB_XSUB(j)  (1280 + 64 * (j))
#define XB_XGEN(j)  (2304 + 64 * (j))
#define XB_TOP      3328
#define XB_TOPGEN   3392
#define XCD_BAR_WORDS 3456
#define XB_SPIN_CAP (1u << 18)
__device__ __forceinline__ unsigned xb_ld(unsigned* p)              { return __hip_atomic_load(p, __ATOMIC_RELAXED, __HIP_MEMORY_SCOPE_AGENT); }
__device__ __forceinline__ unsigned xb_add(unsigned* p, unsigned v) { return __hip_atomic_fetch_add(p, v, __ATOMIC_RELAXED, __HIP_MEMORY_SCOPE_AGENT); }
__device__ __forceinline__ unsigned xb_xcc_id() { return (unsigned)__builtin_amdgcn_s_getreg((3 << 11) | 20) & 0xFu; }
#define XB_SPIN(cond, bar) do { unsigned _sp = 0; while (cond) { __builtin_amdgcn_s_sleep(1); \
    if ((++_sp & 255u) == 0u) { if (xb_ld(&(bar)[XB_TMO])) break; if (_sp > XB_SPIN_CAP) { atomicAdd(&(bar)[XB_TMO], 1u); break; } } } } while (0)
struct XcdBarrier { unsigned* bar; unsigned x; volatile LAS unsigned* st; };
__device__ __forceinline__ XcdBarrier xcd_barrier_post(unsigned* bar, volatile LAS unsigned* st) {
    XcdBarrier b; b.bar = bar; b.x = xb_xcc_id(); b.st = st;
    if (threadIdx.x == 0) (void)xb_add(&bar[XB_XCNT(b.x)], 1u);
    return b;
}
__device__ __forceinline__ void xcd_barrier_complete(unsigned* bar, unsigned x, unsigned& nloc, unsigned& nx) {
    const unsigned G = gridDim.x * gridDim.y * gridDim.z;
    unsigned sum, cnt, mine, sp = 0u;
    for (;;) {
        sum = 0u; cnt = 0u; mine = 0u;
#pragma unroll
        for (unsigned j = 0; j < 16; ++j) { const unsigned c = xb_ld(&bar[XB_XCNT(j)]); sum += c; cnt += (c > 0u) ? 1u : 0u; mine = (j == x) ? c : mine; }
        if (sum == G) break;
        __builtin_amdgcn_s_sleep(1);
        if ((++sp & 255u) == 0u) { if (xb_ld(&bar[XB_TMO])) break; if (sp > XB_SPIN_CAP) { atomicAdd(&bar[XB_TMO], 1u); break; } }
    }
    nloc = mine > 0u ? mine : 1u; nx = cnt > 0u ? cnt : 1u;
}
__device__ __forceinline__ void xcd_barrier(const XcdBarrier& b) {
    asm volatile("s_waitcnt vmcnt(0)" ::: "memory");
    __syncthreads();
    if (threadIdx.x == 0) {
        unsigned* bar = b.bar;
        __builtin_amdgcn_s_waitcnt(0);
        unsigned nloc = b.st[0], nx = b.st[1];
        if (nloc == 0u) { xcd_barrier_complete(bar, b.x, nloc, nx); b.st[0] = nloc; b.st[1] = nx; }
        const unsigned old = xb_add(&bar[XB_XSUB(b.x)], 1u);
        const unsigned gen = old / nloc;
        if (old + 1u == (gen + 1u) * nloc) {
            __builtin_amdgcn_fence(__ATOMIC_RELEASE, "agent");
            asm volatile("s_waitcnt vmcnt(0)" ::: "memory");
            const unsigned og = xb_add(&bar[XB_TOP], 1u);
            const unsigned tg = og / nx;
            if (og + 1u == (tg + 1u) * nx) xb_add(&bar[XB_TOPGEN], 1u);
            else XB_SPIN(xb_ld(&bar[XB_TOPGEN]) == tg, bar);
            __builtin_amdgcn_fence(__ATOMIC_ACQUIRE, "agent");
            xb_add(&bar[XB_XGEN(b.x)], 1u);
            asm volatile("s_waitcnt vmcnt(0)" ::: "memory");
        } else {
            XB_SPIN(xb_ld(&bar[XB_XGEN(b.x)]) == gen, bar);
            __builtin_amdgcn_fence(__ATOMIC_ACQUIRE, "agent");
            asm volatile("s_waitcnt vmcnt(0)" ::: "memory");
        }
    }
    __syncthreads();
}

constexpr int NWAVES = 8;
constexpr int RING_BYTES = 131072, LDS_BYTES = 147456;
static_assert(att::L_END <= RING_BYTES, "attention scratch fits the ring region");

__device__ __forceinline__ float wave_sum(float v) {
#pragma unroll
    for (int o = 1; o < 64; o <<= 1) v += __shfl_xor(v, o);
    return v;
}
__device__ __forceinline__ void tr_item(const float* W, int ldw, int col0, int K, bf16_t* WT, int row_off, LAS float* scr, int kb, int nb, int lane) {
    const int k0 = 64 * kb, n0 = 32 * nb;
#pragma unroll 8
    for (int i = 0; i < 32; ++i) { const int kk = 2 * i + (lane >> 5); scr[kk * 33 + (lane & 31)] = W[(size_t)(k0 + kk) * ldw + col0 + n0 + (lane & 31)]; }
    asm volatile("s_waitcnt lgkmcnt(0)" ::: "memory");
    const int c = lane & 7;
#pragma unroll
    for (int j = 0; j < 4; ++j) { const int n = (lane >> 3) + 8 * j; const LAS float* s = scr + (8 * c) * 33 + n;
        u32x4 o; o.x = cvt_pk_bf16(s[0 * 33], s[1 * 33]); o.y = cvt_pk_bf16(s[2 * 33], s[3 * 33]); o.z = cvt_pk_bf16(s[4 * 33], s[5 * 33]); o.w = cvt_pk_bf16(s[6 * 33], s[7 * 33]);
        *(u32x4*)(WT + (size_t)(row_off + n0 + n) * K + k0 + 8 * c) = o; }
    asm volatile("s_waitcnt lgkmcnt(0)" ::: "memory");
}

struct Args { const float* in[16]; float* out; unsigned char* ws; int ph_lo, ph_hi; };

__global__ void __launch_bounds__(NWAVES * 64, 2) fwd_megakernel(Args args) {
    __builtin_assume(__builtin_amdgcn_workitem_id_y() == 0); __builtin_assume(__builtin_amdgcn_workitem_id_z() == 0);
    extern __shared__ __attribute__((aligned(16))) unsigned char lds_raw[];
    LAS unsigned char* lds = (LAS unsigned char*)lds_raw;
    const int tid = threadIdx.x, lane = tid & 63, wave = __builtin_amdgcn_readfirstlane(tid >> 6);
    const int G = gridDim.x, bx = blockIdx.x, vcu = (G % 8 == 0) ? (bx % 8) * (G / 8) + bx / 8 : bx;
    const int gw = vcu * NWAVES + wave, NGW = G * NWAVES;
    unsigned char* ws = args.ws;
    const float* x = args.in[0]; const float* p_in = args.in[1]; const float* g_mix = args.in[2]; const float* w_in = args.in[3]; const float* b_forget = args.in[4]; const float* b_gate = args.in[5];
    const float* w_bf = args.in[6]; const float* w_bs = args.in[7]; const float* w_out = args.in[8]; const float* g_mlp = args.in[9]; const float* w_up = args.in[10]; const float* w_dn = args.in[11];
    const float* g_ple = args.in[12]; const float* w_pg = args.in[13]; const float* w_ple = args.in[14]; const float* g_final = args.in[15];
    float* out = args.out;
    bf16_t* Win_t = (bf16_t*)(ws + WS_WIN); bf16_t* Wbf_t = (bf16_t*)(ws + WS_WBF); bf16_t* Wbs_t = (bf16_t*)(ws + WS_WBS); bf16_t* Wout_t = (bf16_t*)(ws + WS_WOUT);
    bf16_t* Wup_t = (bf16_t*)(ws + WS_WUP); bf16_t* Wdn_t = (bf16_t*)(ws + WS_WDN); bf16_t* Wpg_t = (bf16_t*)(ws + WS_WPG); bf16_t* Wple_t = (bf16_t*)(ws + WS_WPLE);
    float* LOGF = (float*)(ws + WS_LOGF); float* CC = (float*)(ws + WS_CC); float* SSQ1 = (float*)(ws + WS_SSQ1); float* SSQ2 = (float*)(ws + WS_SSQ2);
    bf16_t* PB = (bf16_t*)(ws + WS_PB); bf16_t* BUFA = (bf16_t*)(ws + WS_BUFA); bf16_t* BUFB = (bf16_t*)(ws + WS_BUFB); bf16_t* QKV = (bf16_t*)(ws + WS_QKV); bf16_t* SG = (bf16_t*)(ws + WS_SG);
    bf16_t* HB = (bf16_t*)(ws + WS_H); bf16_t* EB = (bf16_t*)(ws + WS_E);
    const int lo = args.ph_lo, hi = args.ph_hi;
#define IN(k) (lo <= (k) && (k) < hi)
    volatile LAS unsigned* bst = (volatile LAS unsigned*)(lds + RING_BYTES);
    if (tid < 2) bst[tid] = 0u;
    __syncthreads();
    XcdBarrier xbar; xbar.bar = (unsigned*)ws; xbar.x = 0; xbar.st = bst;
    if (hi - lo > 1) xbar = xcd_barrier_post((unsigned*)ws, bst);
#define SEAM(k) do { if (IN(k) && IN((k) + 1)) { if ((k) == 0) cg::this_grid().sync(); else xcd_barrier(xbar); } } while (0)

    if (IN(0)) {
        LAS float* scr = (LAS float*)(lds + wave * 16384);
        {
            constexpr int NSEG = 9;
            int base = 0;
            for (int it = gw; ; it += NGW) {
                int r = it; const float* W; int ldw, col0, K, nblk, row_off; bf16_t* WT;
                if (r < 16 * 48) { W = w_in; ldw = NIN_SRC; col0 = 0; K = DM; nblk = 48; WT = Win_t; row_off = 0; }
                else if ((r -= 16 * 48) < 16 * 112) { W = w_in; ldw = NIN_SRC; col0 = 1544; K = DM; nblk = 112; WT = Win_t; row_off = 1536; }
                else if ((r -= 16 * 112) < 8 * 32) { W = w_bf; ldw = DM; col0 = 0; K = 512; nblk = 32; WT = Wbf_t; row_off = 0; }
                else if ((r -= 8 * 32) < 8 * 32) { W = w_bs; ldw = DM; col0 = 0; K = 512; nblk = 32; WT = Wbs_t; row_off = 0; }
                else if ((r -= 8 * 32) < 16 * 32) { W = w_out; ldw = DM; col0 = 0; K = DM; nblk = 32; WT = Wout_t; row_off = 0; }
                else if ((r -= 16 * 32) < 16 * 128) { W = w_up; ldw = DFF; col0 = 0; K = DM; nblk = 128; WT = Wup_t; row_off = 0; }
                else if ((r -= 16 * 128) < 64 * 32) { W = w_dn; ldw = DM; col0 = 0; K = DFF; nblk = 32; WT = Wdn_t; row_off = 0; }
                else if ((r -= 64 * 32) < 16 * 32) { W = w_pg; ldw = DM; col0 = 0; K = DM; nblk = 32; WT = Wpg_t; row_off = 0; }
                else if ((r -= 16 * 32) < 4 * 32) { W = w_ple; ldw = DM; col0 = 0; K = DPLE; nblk = 32; WT = Wple_t; row_off = 0; }
                else break;
                tr_item(W, ldw, col0, K, WT, row_off, scr, r / nblk, r % nblk, lane);
                (void)base; (void)NSEG;
            }
        }
        {
            f32x4 gm[4]; f32x4 wf[4][4][2];
#pragma unroll
            for (int j = 0; j < 4; ++j) { gm[j] = *((const f32x4*)g_mix + lane + 64 * j);
#pragma unroll
                for (int e = 0; e < 4; ++e) { const float* wp = w_in + (size_t)(4 * lane + 256 * j + e) * NIN_SRC + 1536; wf[j][e][0] = *(const f32x4*)wp * gm[j][e]; wf[j][e][1] = *(const f32x4*)(wp + 4) * gm[j][e]; } }
            const float bfv = b_forget[lane & 7];
            for (int m = gw; m < M; m += NGW) {
                const f32x4* xr = (const f32x4*)(x + (size_t)m * DM) + lane;
                f32x4 v[4]; float s = 0.f;
#pragma unroll
                for (int j = 0; j < 4; ++j) { v[j] = xr[64 * j]; s += (v[j][0] * v[j][0] + v[j][1] * v[j][1]) + (v[j][2] * v[j][2] + v[j][3] * v[j][3]); }
                const float rstd = __builtin_amdgcn_rsqf(wave_sum(s) * (1.0f / DM) + EPS);
                f32x4 f0 = {0.f, 0.f, 0.f, 0.f}, f1 = {0.f, 0.f, 0.f, 0.f};
#pragma unroll
                for (int j = 0; j < 4; ++j)
#pragma unroll
                    for (int e = 0; e < 4; ++e) { f0 += wf[j][e][0] * v[j][e]; f1 += wf[j][e][1] * v[j][e]; }
                unsigned long long* o8 = (unsigned long long*)(BUFA + (size_t)m * DM) + lane;
#pragma unroll
                for (int j = 0; j < 4; ++j) { const f32x4 y = v[j] * gm[j] * rstd; o8[64 * j] = (unsigned long long)cvt_pk_bf16(y[0], y[1]) | ((unsigned long long)cvt_pk_bf16(y[2], y[3]) << 32); }
                float fl[8];
#pragma unroll
                for (int e = 0; e < 4; ++e) { fl[e] = wave_sum(f0[e]); fl[4 + e] = wave_sum(f1[e]); }
                float mine = fl[0];
#pragma unroll
                for (int e = 1; e < 8; ++e) mine = ((lane & 7) == e) ? fl[e] : mine;
                const float y2 = (mine * rstd + bfv) * LOG2E;
                const float lf = -(fmaxf(-y2, 0.f) + __builtin_amdgcn_logf(1.0f + __builtin_amdgcn_exp2f(-fabsf(y2))));
                if (lane < 8) LOGF[(size_t)((m / SEQ) * NH + lane) * SEQ + (m % SEQ)] = lf;
            }
        }
        {
            const size_t n8 = (size_t)M * DPLE / 8;
            for (size_t i = (size_t)bx * 512 + tid; i < n8; i += (size_t)G * 512) { const f32x4 a = *((const f32x4*)p_in + 2 * i), c = *((const f32x4*)p_in + 2 * i + 1);
                u32x4 w; w.x = cvt_pk_bf16(a[0], a[1]); w.y = cvt_pk_bf16(a[2], a[3]); w.z = cvt_pk_bf16(c[0], c[1]); w.w = cvt_pk_bf16(c[2], c[3]); *((u32x4*)PB + i) = w; }
        }
    }
    SEAM(0);

    if (IN(1)) {
        if (gw < BATCH * NH) {
            const float* src = LOGF + (size_t)gw * SEQ + lane * 32; float* dst = CC + (size_t)gw * SEQ + lane * 32;
            f32x4 v[8]; float run = 0.f;
#pragma unroll
            for (int j = 0; j < 8; ++j) { v[j] = *((const f32x4*)src + j);
#pragma unroll
                for (int e = 0; e < 4; ++e) { run += v[j][e]; v[j][e] = run; } }
            float incl = run;
#pragma unroll
            for (int o = 1; o < 64; o <<= 1) { const float tv = __shfl_up(incl, o); if (lane >= o) incl += tv; }
            const float excl = incl - run;
#pragma unroll
            for (int j = 0; j < 8; ++j) *((f32x4*)dst + j) = v[j] + excl;
        }
        pg8::Gemm g{DM, DM, DM};
        pg8::PlainSched S; S.T.init(M, NIN, G, bx); S.A = (const char*)BUFA; S.B = (const char*)Win_t; S.astep = (size_t)256 * DM * 2; S.bstep = (size_t)256 * DM * 2;
        pg8::EpiQKVG E{QKV, SG, b_gate};
        pg8::gemm_phase<pg8::EpiQKVG, pg8::PlainSched>(lds, g, S, E);
    }
    SEAM(1);

    if (IN(2)) {
        for (int i = 0; i < 8; ++i) {
            const int j = i & 3, kind = i >> 2;
            for (int bh = (vcu >> 1); bh < BATCH * NH; bh += (G >> 1)) {
                const int s = (vcu & 1) * 2 + (j >> 1); const int qb = (j & 1) ? 7 - s : s;
                if (kind == 0) att::attn_unit<0>(bh / NH, bh % NH, qb, QKV, CC, BUFB, lds);
                else att::attn_unit<1>(bh / NH, bh % NH, qb, QKV, CC, BUFB, lds);
            }
        }
    }
    SEAM(2);

    if (IN(3)) {
        pg8::Gemm g{DM, 512, 512};
        pg8::PairSched S; S.T.init(M, DM, G, bx); S.A0 = (const char*)BUFB; S.A1 = (const char*)(BUFB + 512); S.B0 = (const char*)Wbf_t; S.B1 = (const char*)Wbs_t; S.astep = (size_t)256 * DM * 2; S.bstep = (size_t)256 * 512 * 2;
        pg8::EpiBranch E{SG, BUFA};
        pg8::gemm_phase<pg8::EpiBranch, pg8::PairSched>(lds, g, S, E);
    }
    SEAM(3);

    if (IN(4)) {
        {
            pg8::Gemm g{DM, DM, DM};
            pg8::PlainSched S; S.T.init(M, DM, G, bx); S.A = (const char*)BUFA; S.B = (const char*)Wout_t; S.astep = (size_t)256 * DM * 2; S.bstep = (size_t)256 * DM * 2;
            pg8::EpiRes E{x, out, BUFB, g_mlp, SSQ1};
            pg8::gemm_phase<pg8::EpiRes, pg8::PlainSched>(lds, g, S, E);
        }
        {
            pg8::Gemm g{DPLE, DPLE, DPLE};
            pg8::PlainSched S; S.T.init(M, DM, G, bx); S.A = (const char*)PB; S.B = (const char*)Wple_t; S.astep = (size_t)256 * DPLE * 2; S.bstep = (size_t)256 * DPLE * 2;
            pg8::EpiBf16 E{EB, DM};
            pg8::gemm_phase<pg8::EpiBf16, pg8::PlainSched>(lds, g, S, E);
        }
    }
    SEAM(4);

    if (IN(5)) {
        pg8::Gemm g{DM, DM, DM};
        pg8::PlainSched S; S.T.init(M, DFF, G, bx); S.A = (const char*)BUFB; S.B = (const char*)Wup_t; S.astep = (size_t)256 * DM * 2; S.bstep = (size_t)256 * DM * 2;
        pg8::EpiUp E{HB, SSQ1};
        pg8::gemm_phase<pg8::EpiUp, pg8::PlainSched>(lds, g, S, E);
    }
    SEAM(5);

    if (IN(6)) {
        pg8::Gemm g{DFF, DFF, DFF};
        pg8::PlainSched S; S.T.init(M, DM, G, bx); S.A = (const char*)HB; S.B = (const char*)Wdn_t; S.astep = (size_t)256 * DFF * 2; S.bstep = (size_t)256 * DFF * 2;
        pg8::EpiRes E{out, out, BUFA, g_ple, SSQ2};
        pg8::gemm_phase<pg8::EpiRes, pg8::PlainSched>(lds, g, S, E);
    }
    SEAM(6);

    if (IN(7)) {
        pg8::Gemm g{DM, DM, DM};
        pg8::PlainSched S; S.T.init(M, DM, G, bx); S.A = (const char*)BUFA; S.B = (const char*)Wpg_t; S.astep = (size_t)256 * DM * 2; S.bstep = (size_t)256 * DM * 2;
        pg8::EpiPle E{out, out, EB, SSQ2};
        pg8::gemm_phase<pg8::EpiPle, pg8::PlainSched>(lds, g, S, E);
    }
    SEAM(7);

    if (IN(8)) {
        f32x4 gf[4];
#pragma unroll
        for (int j = 0; j < 4; ++j) gf[j] = *((const f32x4*)g_final + lane + 64 * j);
        for (int m = gw; m < M; m += NGW) {
            f32x4* xr = (f32x4*)(out + (size_t)m * DM) + lane;
            f32x4 v[4]; float s = 0.f;
#pragma unroll
            for (int j = 0; j < 4; ++j) { v[j] = xr[64 * j]; s += (v[j][0] * v[j][0] + v[j][1] * v[j][1]) + (v[j][2] * v[j][2] + v[j][3] * v[j][3]); }
            const float rstd = __builtin_amdgcn_rsqf(wave_sum(s) * (1.0f / DM) + EPS);
#pragma unroll
            for (int j = 0; j < 4; ++j) xr[64 * j] = v[j] * gf[j] * rstd;
        }
    }
#undef IN
#undef SEAM
}

extern "C" void kernel_launch(void* const* d_in, const int* in_sizes, int n_in, void* d_out, int out_size, void* d_ws, size_t ws_size, hipStream_t stream) {
    static int grid = 0;
    if (grid == 0) {
        if (n_in != 16 || in_sizes[0] != M * DM || out_size != M * DM || ws_size < WS_END) { fprintf(stderr, "kernel_launch: unexpected shapes (n_in %d, in0 %d, out %d, ws %zu); nothing launched\n", n_in, n_in > 0 ? in_sizes[0] : -1, out_size, ws_size); grid = -1; return; }
        int dev = 0, cus = 0, per_cu = 0;
        if (hipGetDevice(&dev) != hipSuccess || hipDeviceGetAttribute(&cus, hipDeviceAttributeMultiprocessorCount, dev) != hipSuccess) { grid = -1; return; }
        if (hipFuncSetAttribute((const void*)fwd_megakernel, hipFuncAttributeMaxDynamicSharedMemorySize, LDS_BYTES) != hipSuccess) { fprintf(stderr, "kernel_launch: hipFuncSetAttribute failed\n"); grid = -1; return; }
        if (hipOccupancyMaxActiveBlocksPerMultiprocessor(&per_cu, (const void*)fwd_megakernel, NWAVES * 64, LDS_BYTES) != hipSuccess || per_cu < 1) { fprintf(stderr, "kernel_launch: occupancy query says %d\n", per_cu); per_cu = 1; }
        (void)hipGetLastError();
        grid = cus;
        if (grid != 256) fprintf(stderr, "kernel_launch: %d CUs; built for 256\n", grid);
    }
    if (grid < 0) return;
    if (hipMemsetAsync(d_ws, 0, 16384, stream) != hipSuccess) { fprintf(stderr, "kernel_launch: memset failed\n"); return; }
    Args a{};
    for (int i = 0; i < 16; ++i) a.in[i] = (const float*)d_in[i];
    a.out = (float*)d_out; a.ws = (unsigned char*)d_ws;
#if MK_N_LAUNCHES == 1
    a.ph_lo = 0; a.ph_hi = N_PHASES;
    void* kargs[] = {&a};
    hipError_t e = hipLaunchCooperativeKernel((const void*)fwd_megakernel, dim3(grid), dim3(NWAVES * 64), kargs, LDS_BYTES, stream);
    if (e != hipSuccess) fprintf(stderr, "kernel_launch: cooperative launch failed: %s (grid %d)\n", hipGetErrorString(e), grid);
#else
    for (int li = 0; li < N_PHASES; ++li) { a.ph_lo = li; a.ph_hi = li + 1; hipLaunchKernelGGL(fwd_megakernel, dim3(grid), dim3(NWAVES * 64), LDS_BYTES, stream, a); }
#endif
}
```

```cpp
#include <hip/hip_runtime.h>
#include <hip/hip_cooperative_groups.h>
#include <cstdio>
#include <cstdint>
namespace cg = cooperative_groups;

#ifndef MK_N_LAUNCHES
#define MK_N_LAUNCHES 1
#endif
constexpr int N_PHASES = 9;

#define LAS __attribute__((address_space(3)))
typedef unsigned short bf16_t;
typedef short bf16x8 __attribute__((ext_vector_type(8)));
typedef short s16x4 __attribute__((ext_vector_type(4)));
typedef float f32x4 __attribute__((ext_vector_type(4)));
typedef float f32x2 __attribute__((ext_vector_type(2)));
typedef float f32x16 __attribute__((ext_vector_type(16)));
typedef unsigned u32x4 __attribute__((ext_vector_type(4)));
typedef unsigned u32x2 __attribute__((ext_vector_type(2)));
typedef __bf16 bf16x2_t __attribute__((ext_vector_type(2)));

constexpr int BATCH = 16, SEQ = 2048, DM = 1024, M = BATCH * SEQ, NH = 8, HD = 64, DFF = 4096, DPLE = 256;
constexpr int NIN_SRC = 5128, NQKV = 3072, NGATE = 2048, NIN = NQKV + NGATE;
constexpr float EPS = 1e-6f;
constexpr float LOG2E = 1.4426950408889634f;
constexpr float C2 = 0.125f * LOG2E;

constexpr size_t MiB = 1u << 20;
constexpr size_t WS_WIN = 2 * MiB, WS_WBF = 12 * MiB, WS_WBS = 13 * MiB, WS_WOUT = 14 * MiB, WS_WUP = 16 * MiB, WS_WDN = 24 * MiB, WS_WPG = 32 * MiB, WS_WPLE = 34 * MiB;
constexpr size_t WS_LOGF = 36 * MiB, WS_CC = 37 * MiB, WS_SSQ1 = 38 * MiB, WS_SSQ2 = 40 * MiB;
constexpr size_t WS_PB = 42 * MiB, WS_BUFA = 58 * MiB, WS_BUFB = 122 * MiB, WS_QKV = 186 * MiB, WS_SG = 378 * MiB, WS_H = 186 * MiB, WS_E = 442 * MiB, WS_END = 506 * MiB;

__device__ __forceinline__ unsigned cvt_pk_bf16(float lo, float hi) { f32x2 v = {lo, hi}; bf16x2_t b = __builtin_convertvector(v, bf16x2_t); return __builtin_bit_cast(unsigned, b); }
__device__ __forceinline__ float bf_lo(unsigned w) { return __uint_as_float(w << 16); }
__device__ __forceinline__ float bf_hi(unsigned w) { return __uint_as_float(w & 0xffff0000u); }
__device__ __forceinline__ float fast_sigmoid(float v) { return __builtin_amdgcn_rcpf(1.0f + __builtin_amdgcn_exp2f(-v * LOG2E)); }

__device__ __forceinline__ const char* uni_ptr(const char* p) { const unsigned long long v = (unsigned long long)p; const unsigned lo = __builtin_amdgcn_readfirstlane((unsigned)v), hi = __builtin_amdgcn_readfirstlane((unsigned)(v >> 32)); return (const char*)(((unsigned long long)hi << 32) | lo); }
namespace pg8 {
constexpr int BM = 256, BK = 64, HALF = 128, HTB = HALF * BK * 2, STAGE_BYTES = 8 * HTB, NXCD = 8, WGM = 8;
__host__ __device__ __forceinline__ int lds_byte(int r, int c) { const int st = (r >> 4) * 2 + (c >> 5), rr = r & 15, cc = c & 31, ob = rr * 64 + cc * 2; return st * 1024 + (ob ^ (((ob >> 9) & 1) << 5)); }
__host__ __device__ __forceinline__ void stage_rc(int b, int& R, int& C) { const int st = b / 1024, sb = b % 1024, swz = sb ^ (((sb >> 9) & 1) << 5); R = (st >> 1) * 16 + swz / 64; C = (st & 1) * 32 + (swz % 64) / 2; }
__host__ __device__ __forceinline__ int perm32(int rho) { const int n = rho >> 4, i = rho & 15; return 8 * (i >> 2) + 4 * n + (i & 3); }

struct Unit { int pm, pn; const char* A; const char* B; int chain; };
struct Gemm { int lda, ldb, K; };

struct TileOrder {
    int nM, nN, nwg, G, c;
    __device__ void init(int Mrows, int N, int G_, int c_) { nM = Mrows / BM; nN = N / BM; nwg = nM * nN; G = G_; c = c_; }
    __device__ bool tile(int i, int& pm, int& pn) const {
        const long L = (long)i * G + c; if (L >= nwg) return false;
        int wgid = (int)L; { const int q = nwg / NXCD, r = nwg % NXCD, xcd = wgid % NXCD, off = wgid / NXCD; wgid = (xcd < r ? xcd * (q + 1) : r * (q + 1) + (xcd - r) * q) + off; }
        const int nig = WGM * nN, gid = wgid / nig, fm = gid * WGM, gsz = (nM - fm) < WGM ? (nM - fm) : WGM;
        pm = fm + ((wgid % nig) % gsz); pn = (wgid % nig) / gsz; return true;
    }
};
struct PlainSched {
    TileOrder T; const char* A; const char* B; size_t astep, bstep;
    __device__ bool next(int i, Unit& u) const { int pm, pn; if (!T.tile(i, pm, pn)) return false; u.pm = pm; u.pn = pn; u.A = A + (size_t)pm * astep; u.B = B + (size_t)pn * bstep; u.chain = 0; return true; }
};
struct PairSched {
    TileOrder T; const char* A0; const char* A1; const char* B0; const char* B1; size_t astep, bstep;
    __device__ bool next(int i, Unit& u) const { int pm, pn; if (!T.tile(i >> 1, pm, pn)) return false; const int s = i & 1; u.pm = pm; u.pn = pn;
        u.A = (s ? A1 : A0) + (size_t)pm * astep; u.B = (s ? B1 : B0) + (size_t)pn * bstep; u.chain = s ? 0 : 1; return true; }
};

typedef f32x4 Acc[2][2][4][2];

struct EpiQKVG {
    static constexpr bool PERM = true;
    bf16_t* QKV; bf16_t* SG; const float* bgate;
    __device__ __forceinline__ void operator()(Acc& acc, const Unit& u, int wr, int wc, int fr, int fq, LAS float* tab, int tid) const {
        const int row0 = u.pm * BM + wr * 64 + fr;
        if (u.pn < 12) {
            const float sc = (u.pn < 2 || (u.pn >= 6 && u.pn < 8)) ? C2 : 1.0f;
            const int col0 = u.pn * BM + wc * 32 + 8 * fq;
#pragma unroll
            for (int ai = 0; ai < 2; ++ai)
#pragma unroll
                for (int m = 0; m < 4; ++m) { bf16_t* rowp = QKV + (size_t)(row0 + ai * HALF + m * 16) * NQKV + col0;
#pragma unroll
                    for (int bj = 0; bj < 2; ++bj) { const f32x4 v0 = acc[ai][bj][m][0] * sc, v1 = acc[ai][bj][m][1] * sc;
                        u32x4 w; w.x = cvt_pk_bf16(v0[0], v0[1]); w.y = cvt_pk_bf16(v0[2], v0[3]); w.z = cvt_pk_bf16(v1[0], v1[1]); w.w = cvt_pk_bf16(v1[2], v1[3]);
                        *(u32x4*)(rowp + bj * HALF) = w; } }
        } else {
            const int col0 = (u.pn - 12) * BM + wc * 32 + 8 * fq;
            f32x4 bv[2][2];
#pragma unroll
            for (int bj = 0; bj < 2; ++bj)
#pragma unroll
                for (int n = 0; n < 2; ++n) bv[bj][n] = *(const f32x4*)(bgate + col0 + bj * HALF + 4 * n);
#pragma unroll
            for (int ai = 0; ai < 2; ++ai)
#pragma unroll
                for (int m = 0; m < 4; ++m) { bf16_t* rowp = SG + (size_t)(row0 + ai * HALF + m * 16) * NGATE + col0;
#pragma unroll
                    for (int bj = 0; bj < 2; ++bj) { const f32x4 a0 = acc[ai][bj][m][0] + bv[bj][0], a1 = acc[ai][bj][m][1] + bv[bj][1];
                        u32x4 w; w.x = cvt_pk_bf16(fast_sigmoid(a0[0]), fast_sigmoid(a0[1])); w.y = cvt_pk_bf16(fast_sigmoid(a0[2]), fast_sigmoid(a0[3]));
                        w.z = cvt_pk_bf16(fast_sigmoid(a1[0]), fast_sigmoid(a1[1])); w.w = cvt_pk_bf16(fast_sigmoid(a1[2]), fast_sigmoid(a1[3]));
                        *(u32x4*)(rowp + bj * HALF) = w; } }
        }
    }
};
struct EpiBf16 {
    static constexpr bool PERM = true;
    bf16_t* O; int ldc;
    __device__ __forceinline__ void operator()(Acc& acc, const Unit& u, int wr, int wc, int fr, int fq, LAS float* tab, int tid) const {
        const int row0 = u.pm * BM + wr * 64 + fr, col0 = u.pn * BM + wc * 32 + 8 * fq;
#pragma unroll
        for (int ai = 0; ai < 2; ++ai)
#pragma unroll
            for (int m = 0; m < 4; ++m) { bf16_t* rowp = O + (size_t)(row0 + ai * HALF + m * 16) * ldc + col0;
#pragma unroll
                for (int bj = 0; bj < 2; ++bj) { const f32x4 v0 = acc[ai][bj][m][0], v1 = acc[ai][bj][m][1];
                    u32x4 w; w.x = cvt_pk_bf16(v0[0], v0[1]); w.y = cvt_pk_bf16(v0[2], v0[3]); w.z = cvt_pk_bf16(v1[0], v1[1]); w.w = cvt_pk_bf16(v1[2], v1[3]);
                    *(u32x4*)(rowp + bj * HALF) = w; } }
    }
};
__device__ __forceinline__ f32x4 bf4_lo(const u32x4 w) { return (f32x4){bf_lo(w.x), bf_hi(w.x), bf_lo(w.y), bf_hi(w.y)}; }
__device__ __forceinline__ f32x4 bf4_hi(const u32x4 w) { return (f32x4){bf_lo(w.z), bf_hi(w.z), bf_lo(w.w), bf_hi(w.w)}; }
__device__ __forceinline__ u32x4 pack8(const f32x4 v0, const f32x4 v1) { u32x4 w; w.x = cvt_pk_bf16(v0[0], v0[1]); w.y = cvt_pk_bf16(v0[2], v0[3]); w.z = cvt_pk_bf16(v1[0], v1[1]); w.w = cvt_pk_bf16(v1[2], v1[3]); return w; }
struct EpiBranch {
    static constexpr bool PERM = true;
    const bf16_t* SG; bf16_t* MG;
    __device__ __forceinline__ void operator()(Acc& acc, const Unit& u, int wr, int wc, int fr, int fq, LAS float* tab, int tid) const {
        const int row0 = u.pm * BM + wr * 64 + fr, col0 = u.pn * BM + wc * 32 + 8 * fq;
#pragma unroll
        for (int ai = 0; ai < 2; ++ai) {
            u32x4 ga[4][2], gb[4][2];
#pragma unroll
            for (int m = 0; m < 4; ++m)
#pragma unroll
                for (int bj = 0; bj < 2; ++bj) { const bf16_t* p = SG + (size_t)(row0 + ai * HALF + m * 16) * NGATE + col0 + bj * HALF; gb[m][bj] = *(const u32x4*)(p + DM); if (u.chain) ga[m][bj] = *(const u32x4*)p; }
#pragma unroll
            for (int m = 0; m < 4; ++m)
#pragma unroll
                for (int bj = 0; bj < 2; ++bj) { const f32x4 b0 = bf4_lo(gb[m][bj]), b1 = bf4_hi(gb[m][bj]);
                    if (u.chain) { const f32x4 a0 = bf4_lo(ga[m][bj]), a1 = bf4_hi(ga[m][bj]);
#pragma unroll
                        for (int e = 0; e < 4; ++e) { acc[ai][bj][m][0][e] *= a0[e] * __builtin_amdgcn_rcpf(fmaxf(b0[e], 1e-30f)); acc[ai][bj][m][1][e] *= a1[e] * __builtin_amdgcn_rcpf(fmaxf(b1[e], 1e-30f)); }
                    } else *(u32x4*)(MG + (size_t)(row0 + ai * HALF + m * 16) * DM + col0 + bj * HALF) = pack8(acc[ai][bj][m][0] * b0, acc[ai][bj][m][1] * b1); }
            asm volatile("" ::: "memory");
        }
    }
};
__device__ __forceinline__ void ssq_publish(LAS float* tab, float* ssq, const Unit& u, int tid) {
    asm volatile("s_waitcnt lgkmcnt(0)" ::: "memory"); __builtin_amdgcn_s_barrier(); asm volatile("" ::: "memory");
    if (tid < 256) { const f32x4 t = *(const LAS f32x4*)(tab + tid * 4); ssq[(size_t)(u.pm * BM + tid) * 4 + u.pn] = (t[0] + t[1]) + (t[2] + t[3]); }
}
struct EpiRes4 {
    static constexpr bool PERM = true;
    const float* base; bf16_t* xb; float* ssq;
    __device__ __forceinline__ void operator()(Acc& acc, const Unit& u, int wr, int wc, int fr, int fq, LAS float* tab, int tid) const {
        const int row0 = u.pm * BM + wr * 64 + fr, col0 = u.pn * BM + wc * 32 + 8 * fq;
#pragma unroll
        for (int ai = 0; ai < 2; ++ai) {
            f32x4 bs[4][2][2];
#pragma unroll
            for (int m = 0; m < 4; ++m)
#pragma unroll
                for (int bj = 0; bj < 2; ++bj)
#pragma unroll
                    for (int n = 0; n < 2; ++n) bs[m][bj][n] = *(const f32x4*)(base + (size_t)(row0 + ai * HALF + m * 16) * DM + col0 + bj * HALF + 4 * n);
#pragma unroll
            for (int m = 0; m < 4; ++m) { float s = 0.f;
#pragma unroll
                for (int bj = 0; bj < 2; ++bj) { const f32x4 x0 = bs[m][bj][0] + acc[ai][bj][m][0], x1 = bs[m][bj][1] + acc[ai][bj][m][1];
                    s += ((x0[0] * x0[0] + x0[1] * x0[1]) + (x0[2] * x0[2] + x0[3] * x0[3])) + ((x1[0] * x1[0] + x1[1] * x1[1]) + (x1[2] * x1[2] + x1[3] * x1[3]));
                    *(u32x4*)(xb + (size_t)(row0 + ai * HALF + m * 16) * DM + col0 + bj * HALF) = pack8(x0, x1); }
                s += __shfl_xor(s, 16); s += __shfl_xor(s, 32);
                if (fq == 0) tab[(ai * HALF + wr * 64 + m * 16 + fr) * 4 + wc] = s; }
            asm volatile("" ::: "memory");
        }
        ssq_publish(tab, ssq, u, tid);
    }
};
struct EpiRes6 {
    static constexpr bool PERM = true;
    const bf16_t* xin; bf16_t* xb; float* ssq;
    __device__ __forceinline__ void operator()(Acc& acc, const Unit& u, int wr, int wc, int fr, int fq, LAS float* tab, int tid) const {
        const int row0 = u.pm * BM + wr * 64 + fr, col0 = u.pn * BM + wc * 32 + 8 * fq;
        u32x4 xi[2][4][2];
#pragma unroll
        for (int ai = 0; ai < 2; ++ai)
#pragma unroll
            for (int m = 0; m < 4; ++m)
#pragma unroll
                for (int bj = 0; bj < 2; ++bj) xi[ai][m][bj] = *(const u32x4*)(xin + (size_t)(row0 + ai * HALF + m * 16) * DM + col0 + bj * HALF);
#pragma unroll
        for (int ai = 0; ai < 2; ++ai)
#pragma unroll
            for (int m = 0; m < 4; ++m) { float s = 0.f;
#pragma unroll
                for (int bj = 0; bj < 2; ++bj) { const f32x4 x0 = bf4_lo(xi[ai][m][bj]) + acc[ai][bj][m][0], x1 = bf4_hi(xi[ai][m][bj]) + acc[ai][bj][m][1];
                    s += ((x0[0] * x0[0] + x0[1] * x0[1]) + (x0[2] * x0[2] + x0[3] * x0[3])) + ((x1[0] * x1[0] + x1[1] * x1[1]) + (x1[2] * x1[2] + x1[3] * x1[3]));
                    *(u32x4*)(xb + (size_t)(row0 + ai * HALF + m * 16) * DM + col0 + bj * HALF) = pack8(x0, x1); }
                s += __shfl_xor(s, 16); s += __shfl_xor(s, 32);
                if (fq == 0) tab[(ai * HALF + wr * 64 + m * 16 + fr) * 4 + wc] = s; }
        ssq_publish(tab, ssq, u, tid);
    }
};
__device__ __forceinline__ float rstd_of(const f32x4 q) { return __builtin_amdgcn_rsqf(((q[0] + q[1]) + (q[2] + q[3])) * (1.0f / DM) + EPS); }
struct EpiUp {
    static constexpr bool PERM = true;
    bf16_t* H; const float* ssq;
    __device__ __forceinline__ void operator()(Acc& acc, const Unit& u, int wr, int wc, int fr, int fq, LAS float* tab, int tid) const {
        const int row0 = u.pm * BM + wr * 64 + fr, col0 = u.pn * BM + wc * 32 + 8 * fq;
        f32x4 sq[2][4];
#pragma unroll
        for (int ai = 0; ai < 2; ++ai)
#pragma unroll
            for (int m = 0; m < 4; ++m) sq[ai][m] = *(const f32x4*)(ssq + (size_t)(row0 + ai * HALF + m * 16) * 4);
#pragma unroll
        for (int ai = 0; ai < 2; ++ai)
#pragma unroll
            for (int m = 0; m < 4; ++m) { const float r = rstd_of(sq[ai][m]); bf16_t* rowp = H + (size_t)(row0 + ai * HALF + m * 16) * DFF + col0;
#pragma unroll
                for (int bj = 0; bj < 2; ++bj) { f32x4 v0 = acc[ai][bj][m][0] * r, v1 = acc[ai][bj][m][1] * r;
#pragma unroll
                    for (int e = 0; e < 4; ++e) { const float a = fmaxf(v0[e], 0.f), b = fmaxf(v1[e], 0.f); v0[e] = a * a; v1[e] = b * b; }
                    *(u32x4*)(rowp + bj * HALF) = pack8(v0, v1); } }
    }
};
struct EpiPle {
    static constexpr bool PERM = true;
    const bf16_t* xin; bf16_t* xb; const bf16_t* E; const float* ssq;
    __device__ __forceinline__ void operator()(Acc& acc, const Unit& u, int wr, int wc, int fr, int fq, LAS float* tab, int tid) const {
        const int row0 = u.pm * BM + wr * 64 + fr, col0 = u.pn * BM + wc * 32 + 8 * fq;
#pragma unroll
        for (int ai = 0; ai < 2; ++ai)
#pragma unroll
            for (int mh = 0; mh < 2; ++mh) {
                u32x4 xi[2][2], ei[2][2]; f32x4 sq[2];
#pragma unroll
                for (int mm = 0; mm < 2; ++mm) { const int row = row0 + ai * HALF + (2 * mh + mm) * 16; sq[mm] = *(const f32x4*)(ssq + (size_t)row * 4);
#pragma unroll
                    for (int bj = 0; bj < 2; ++bj) { const size_t off = (size_t)row * DM + col0 + bj * HALF; xi[mm][bj] = *(const u32x4*)(xin + off); ei[mm][bj] = *(const u32x4*)(E + off); } }
#pragma unroll
                for (int mm = 0; mm < 2; ++mm) { const int m = 2 * mh + mm; const float r = rstd_of(sq[mm]);
#pragma unroll
                    for (int bj = 0; bj < 2; ++bj) { const f32x4 a0 = acc[ai][bj][m][0] * r, a1 = acc[ai][bj][m][1] * r, e0 = bf4_lo(ei[mm][bj]), e1 = bf4_hi(ei[mm][bj]); f32x4 o0 = bf4_lo(xi[mm][bj]), o1 = bf4_hi(xi[mm][bj]);
#pragma unroll
                        for (int e = 0; e < 4; ++e) { o0[e] += fast_sigmoid(a0[e]) * e0[e]; o1[e] += fast_sigmoid(a1[e]) * e1[e]; }
                        *(u32x4*)(xb + (size_t)(row0 + ai * HALF + m * 16) * DM + col0 + bj * HALF) = pack8(o0, o1); } }
                asm volatile("" ::: "memory");
            }
    }
};

template <class Epi, class Sched>
__device__ __forceinline__ void gemm_phase(LAS unsigned char* lds, const Gemm g, const Sched& S, const Epi& E) {
    const int tid = threadIdx.x, wid = __builtin_amdgcn_readfirstlane(tid >> 6), lane = tid & 63, wr = wid >> 2, wc = wid & 3, fr = lane & 15, fq = lane >> 4;
    const int K = g.K, nt = K / BK;
    unsigned voffA[2], voffB[2];
#pragma unroll
    for (int i = 0; i < 2; ++i) { int R, C; stage_rc(tid * 16 + i * 8192, R, C); const int Rb = Epi::PERM ? ((R & ~31) + perm32(R & 31)) : R;
        voffA[i] = (unsigned)(R * g.lda + C) * 2u; voffB[i] = (unsigned)(Rb * g.ldb + C) * 2u; }
    const size_t kstep = (size_t)(BK * 2);
    const size_t hA = (size_t)HALF * g.lda * 2, hB = (size_t)HALF * g.ldb * 2;
    const unsigned ldsw = (unsigned)wid * 1024u;
    const int aoff = lds_byte(wr * 64 + fr, fq * 8), boff = lds_byte(wc * 32 + fr, fq * 8);
#define PG8_SA(b, h) (((b) * 2 + (h)) * HTB)
#define PG8_SB(b, h) ((4 + (b) * 2 + (h)) * HTB)
#define PG8_STAGE(bufoff, gbase, voff) do { _Pragma("unroll") for (int _i = 0; _i < 2; ++_i) \
        __builtin_amdgcn_global_load_lds((const unsigned*)((const char*)(gbase) + (voff)[_i]), (LAS unsigned*)(lds + (bufoff) + ldsw + _i * 8192), 16, 0, 0); } while (0)
#define PG8_LDA(dst, b, h) do { _Pragma("unroll") for (int m = 0; m < 4; ++m) _Pragma("unroll") for (int k = 0; k < 2; ++k) dst[m][k] = *(const LAS bf16x8*)(lds + PG8_SA(b, h) + aoff + m * 2048 + k * 1024); } while (0)
#define PG8_LDB(dst, b, h) do { _Pragma("unroll") for (int n = 0; n < 2; ++n) _Pragma("unroll") for (int k = 0; k < 2; ++k) dst[n][k] = *(const LAS bf16x8*)(lds + PG8_SB(b, h) + boff + n * 2048 + k * 1024); } while (0)
#define PG8_MMA(ai, bj, At, Bt) do { __builtin_amdgcn_s_setprio(1); _Pragma("unroll") for (int m = 0; m < 4; ++m) _Pragma("unroll") for (int n = 0; n < 2; ++n) _Pragma("unroll") for (int k = 0; k < 2; ++k) \
        acc[ai][bj][m][n] = __builtin_amdgcn_mfma_f32_16x16x32_bf16(Bt[n][k], At[m][k], acc[ai][bj][m][n], 0, 0, 0); __builtin_amdgcn_s_setprio(0); } while (0)
#define PG8_WAIT_V(n) asm volatile("s_waitcnt vmcnt(" #n ")" ::: "memory")
#define PG8_WAIT_L(n) asm volatile("s_waitcnt lgkmcnt(" #n ")" ::: "memory")
#define PG8_BAR __builtin_amdgcn_s_barrier()
#define PG8_SCHED __builtin_amdgcn_sched_barrier(0)
#define PG8_ZERO() do { _Pragma("unroll") for (int a = 0; a < 2; ++a) _Pragma("unroll") for (int b = 0; b < 2; ++b) _Pragma("unroll") for (int m = 0; m < 4; ++m) _Pragma("unroll") for (int n = 0; n < 2; ++n) acc[a][b][m][n] = (f32x4){0.f, 0.f, 0.f, 0.f}; } while (0)
    Unit cur, nxt; int ui = 0;
    if (!S.next(0, cur)) return;
    Acc acc;
    PG8_ZERO();
    bf16x8 At[4][2], B0[2][2], B1[2][2];
    const char* cA = uni_ptr(cur.A); const char* cB = uni_ptr(cur.B);
    PG8_STAGE(PG8_SB(0, 0), cB, voffB); PG8_STAGE(PG8_SB(0, 1), cB + hB, voffB); PG8_STAGE(PG8_SA(0, 0), cA, voffA); PG8_STAGE(PG8_SA(0, 1), cA + hA, voffA);
    if (wr == 1) PG8_BAR;
    PG8_WAIT_V(2); PG8_BAR;
    PG8_STAGE(PG8_SB(1, 0), cB + kstep, voffB); PG8_STAGE(PG8_SA(1, 0), cA + kstep, voffA); PG8_STAGE(PG8_SB(1, 1), cB + hB + kstep, voffB);
    PG8_WAIT_V(6); PG8_BAR;
    for (;;) {
        const bool has_next = S.next(ui + 1, nxt);
        const char* nA = uni_ptr(has_next ? nxt.A : cA); const char* nB = uni_ptr(has_next ? nxt.B : cB);
#pragma nounroll
        for (int t = 0; t < nt; t += 2) {
            const bool last = (t == nt - 2);
            const char* a1 = cA + (size_t)(t + 1) * kstep;
            const char* a2 = last ? nA : cA + (size_t)(t + 2) * kstep; const char* b2 = last ? nB : cB + (size_t)(t + 2) * kstep;
            const char* a3 = a2 + kstep; const char* b3 = b2 + kstep;
            PG8_LDB(B0, 0, 0); PG8_LDB(B1, 0, 1); PG8_SCHED; PG8_LDA(At, 0, 0); PG8_STAGE(PG8_SA(1, 1), a1 + hA, voffA);
            PG8_WAIT_V(8); PG8_WAIT_L(0); PG8_BAR; PG8_MMA(0, 0, At, B0); PG8_MMA(0, 1, At, B1); PG8_BAR; PG8_SCHED;
            PG8_LDA(At, 0, 1); PG8_STAGE(PG8_SB(0, 0), b2, voffB); PG8_STAGE(PG8_SB(0, 1), b2 + hB, voffB); PG8_STAGE(PG8_SA(0, 0), a2, voffA);
            PG8_WAIT_V(8); PG8_WAIT_L(0); PG8_BAR; PG8_MMA(1, 0, At, B0); PG8_MMA(1, 1, At, B1); PG8_BAR; PG8_SCHED;
            PG8_LDB(B0, 1, 0); PG8_LDB(B1, 1, 1); PG8_SCHED; PG8_LDA(At, 1, 0); PG8_STAGE(PG8_SA(0, 1), a2 + hA, voffA);
            PG8_WAIT_V(8); PG8_WAIT_L(0); PG8_BAR; PG8_MMA(0, 0, At, B0); PG8_MMA(0, 1, At, B1); PG8_BAR; PG8_SCHED;
            PG8_LDA(At, 1, 1); PG8_STAGE(PG8_SB(1, 0), b3, voffB); PG8_STAGE(PG8_SB(1, 1), b3 + hB, voffB); PG8_STAGE(PG8_SA(1, 0), a3, voffA);
            PG8_WAIT_V(8); PG8_WAIT_L(0); PG8_BAR; PG8_MMA(1, 0, At, B0); PG8_MMA(1, 1, At, B1); PG8_BAR; PG8_SCHED;
        }
        if (wr == 0) PG8_BAR;
        E(acc, cur, wr, wc, fr, fq, (LAS float*)(lds + STAGE_BYTES + 64), tid);
        if (!has_next) break;
        if (!cur.chain) PG8_ZERO();
        cur = nxt; cA = nA; cB = nB; ++ui;
        if (wr == 1) PG8_BAR;
    }
    PG8_WAIT_V(0);
    PG8_BAR;
#undef PG8_SA
#undef PG8_SB
#undef PG8_STAGE
#undef PG8_LDA
#undef PG8_LDB
#undef PG8_MMA
#undef PG8_WAIT_V
#undef PG8_WAIT_L
#undef PG8_BAR
#undef PG8_SCHED
#undef PG8_ZERO
}
}

namespace att {
constexpr int PITCH = NQKV, OPITCH = DM;
constexpr int L_K = 0, L_V = 8192, BUFSZ = 16384;
constexpr int L_WS = 2 * BUFSZ, L_OST = L_WS + 8 * 256, L_FLAG = L_OST + 8 * 4096, L_END = L_FLAG + 64;
constexpr float SB_THR = -160.0f;
__device__ __forceinline__ int crow(int r, int hi) { return (r & 3) + 8 * (r >> 2) + 4 * hi; }
__device__ __forceinline__ s16x4 vtr(const LAS unsigned char* p) { typedef short v4i16_t __attribute__((ext_vector_type(4))); return __builtin_bit_cast(s16x4, __builtin_amdgcn_ds_read_tr16_b64_v4i16((LAS v4i16_t*)p)); }
__device__ __forceinline__ void swap_halves(float v, float& lo, float& hi_) { auto rr = __builtin_amdgcn_permlane32_swap(__float_as_uint(v), __float_as_uint(v), false, false); lo = __uint_as_float(rr[0]); hi_ = __uint_as_float(rr[1]); }

template <int KIND>
__device__ __forceinline__ void attn_unit(int b, int h, int qb, const bf16_t* QKV, const float* cc, bf16_t* O, LAS unsigned char* lds) {
    const int tid = threadIdx.x, lane = tid & 63, r32 = lane & 31, hi = lane >> 5; const int wid = __builtin_amdgcn_readfirstlane(tid >> 6);
    const size_t rowbase = (size_t)b * SEQ; const int q0 = qb * 256, qw = q0 + wid * 32, qabs = qw + r32;
    const int colq = KIND * 1536 + h * HD;
    const bf16_t* Qw = QKV + (rowbase + qw) * PITCH + colq;
    bf16x8 qr[4];
#pragma unroll
    for (int d0 = 0; d0 < 4; ++d0) qr[d0] = *(const bf16x8*)(Qw + (size_t)r32 * PITCH + d0 * 16 + hi * 8);
    const bf16_t* ksrc = QKV + rowbase * PITCH + colq + 512 + (size_t)lane * PITCH + wid * 8;
    const bf16_t* vsrc = QKV + rowbase * PITCH + colq + 1024 + (size_t)(16 * (wid & 3) + (lane >> 2)) * PITCH + (wid >> 2) * 32 + (lane & 3) * 8;
    const int wdst = wid * 1024 + lane * 16;
    const int T_last = qb * 4 + 3, td = qw >> 6;
    LAS float* wsf = (LAS float*)(lds + L_WS) + wid * 64;
    LAS unsigned* flags = (LAS unsigned*)(lds + L_FLAG);
    const float* ccb = cc + (size_t)(b * NH + h) * SEQ;
    float cref = 0.f; if (KIND == 0) cref = ccb[q0 + 255];
    u32x4 kreg = *(const u32x4*)(ksrc + (size_t)T_last * 64 * PITCH), vreg = *(const u32x4*)(vsrc + (size_t)T_last * 64 * PITCH);
    *(LAS u32x4*)(lds + L_K + wdst) = kreg; *(LAS u32x4*)(lds + L_V + wdst) = vreg;
    __syncthreads();
    f32x16 o[2]; o[0] = (f32x16){}; o[1] = (f32x16){};
    float mrun = -INFINITY, lrun = 0.f, R = 0.f; bool mydone = false;
    for (int it = 0;; ++it) {
        const int t = T_last - it; const int buf = (it & 1) * BUFSZ;
        if (t > 0) { kreg = *(const u32x4*)(ksrc + (size_t)(t - 1) * 64 * PITCH); vreg = *(const u32x4*)(vsrc + (size_t)(t - 1) * 64 * PITCH); }
        if (t <= td && !mydone) {
            f32x16 p0 = (f32x16){}, p1 = (f32x16){};
            const LAS unsigned char* kb = lds + buf + L_K + hi * 1024 + r32 * 16;
#pragma unroll
            for (int d0 = 0; d0 < 4; ++d0) { const bf16x8 b0 = *(const LAS bf16x8*)(kb + d0 * 2048), b1 = *(const LAS bf16x8*)(kb + d0 * 2048 + 512);
                p0 = __builtin_amdgcn_mfma_f32_32x32x16_bf16(b0, qr[d0], p0, 0, 0, 0); p1 = __builtin_amdgcn_mfma_f32_32x32x16_bf16(b1, qr[d0], p1, 0, 0, 0); }
            const bool diag = (t == td); const int kv0 = t * 64 + 4 * hi;
            if (KIND == 0) {
                const float* cb = ccb + t * 64 + 4 * hi;
#pragma unroll
                for (int g = 0; g < 4; ++g) { const f32x4 c0 = *(const f32x4*)(cb + 8 * g), c1 = *(const f32x4*)(cb + 32 + 8 * g);
#pragma unroll
                    for (int i = 0; i < 4; ++i) { p0[4 * g + i] += cref - c0[i]; p1[4 * g + i] += cref - c1[i]; } }
                if (diag) {
#pragma unroll
                    for (int r = 0; r < 16; ++r) { const int kv = kv0 + (r & 3) + 8 * (r >> 2); if (kv > qabs) p0[r] = -INFINITY; if (kv + 32 > qabs) p1[r] = -INFINITY; }
                }
                float rm = fmaxf(p0[0], p1[0]);
#pragma unroll
                for (int r = 1; r < 16; ++r) rm = fmaxf(rm, fmaxf(p0[r], p1[r]));
                { float a, c; swap_halves(rm, a, c); rm = fmaxf(a, c); }
                const float mnew = fmaxf(mrun, rm); const float f = __builtin_amdgcn_exp2f(mrun - mnew); mrun = mnew;
                float ls = 0.f;
#pragma unroll
                for (int r = 0; r < 16; ++r) { p0[r] = __builtin_amdgcn_exp2f(p0[r] - mnew); p1[r] = __builtin_amdgcn_exp2f(p1[r] - mnew); ls += p0[r] + p1[r]; }
                lrun = lrun * f + ls;
                if (__any(f != 1.0f)) {
                    if (hi == 0) wsf[r32] = f;
                    asm volatile("s_waitcnt lgkmcnt(0)" ::: "memory");
#pragma unroll
                    for (int r = 0; r < 16; ++r) { const float fr_ = wsf[crow(r, hi)]; o[0][r] *= fr_; o[1][r] *= fr_; }
                    asm volatile("s_waitcnt lgkmcnt(0)" ::: "memory");
                }
            } else {
                f32x16 l0, l1;
#pragma unroll
                for (int r = 0; r < 16; ++r) {
                    const int kv = kv0 + (r & 3) + 8 * (r >> 2);
                    { const float z = p0[r]; const float tt = __builtin_amdgcn_logf(1.0f + __builtin_amdgcn_exp2f(-fabsf(z))); float L = -(fmaxf(z, 0.f) + tt); if (diag && !(kv < qabs)) L = 0.f; l0[r] = L; }
                    { const float z = p1[r]; const float tt = __builtin_amdgcn_logf(1.0f + __builtin_amdgcn_exp2f(-fabsf(z))); float L = -(fmaxf(z, 0.f) + tt); if (diag && !(kv + 32 < qabs)) L = 0.f; l1[r] = L; }
                }
                float G[8], Gp[8];
#pragma unroll
                for (int g = 0; g < 4; ++g) { G[g] = (l0[4 * g] + l0[4 * g + 1]) + (l0[4 * g + 2] + l0[4 * g + 3]); G[4 + g] = (l1[4 * g] + l1[4 * g + 1]) + (l1[4 * g + 2] + l1[4 * g + 3]); }
#pragma unroll
                for (int c = 0; c < 8; ++c) { float a, d; swap_halves(G[c], a, d); Gp[c] = hi ? a : d; }
                float cs = 0.f;
#pragma unroll
                for (int c = 7; c >= 0; --c) {
                    const float ex = cs + (hi ? 0.f : Gp[c]);
                    const int g = c & 3;
                    if (c >= 4) { float s3 = l1[4 * g + 3] + ex, s2 = l1[4 * g + 2] + s3, s1 = l1[4 * g + 1] + s2, s0 = l1[4 * g] + s1; l1[4 * g + 3] = s3; l1[4 * g + 2] = s2; l1[4 * g + 1] = s1; l1[4 * g] = s0; }
                    else        { float s3 = l0[4 * g + 3] + ex, s2 = l0[4 * g + 2] + s3, s1 = l0[4 * g + 1] + s2, s0 = l0[4 * g] + s1; l0[4 * g + 3] = s3; l0[4 * g + 2] = s2; l0[4 * g + 1] = s1; l0[4 * g] = s0; }
                    cs += G[c] + Gp[c];
                }
#pragma unroll
                for (int r = 0; r < 16; ++r) {
                    const int kv = kv0 + (r & 3) + 8 * (r >> 2);
                    float w0 = __builtin_amdgcn_exp2f(p0[r] + l0[r] + R), w1 = __builtin_amdgcn_exp2f(p1[r] + l1[r] + R);
                    if (diag && !(kv < qabs)) w0 = 0.f; if (diag && !(kv + 32 < qabs)) w1 = 0.f;
                    p0[r] = w0; p1[r] = w1;
                }
                R += cs;
                mydone = __all(R < SB_THR);
            }
            u32x4 pw[4];
            pw[0] = (u32x4){cvt_pk_bf16(p0[0], p0[1]), cvt_pk_bf16(p0[2], p0[3]), cvt_pk_bf16(p0[4], p0[5]), cvt_pk_bf16(p0[6], p0[7])};
            pw[1] = (u32x4){cvt_pk_bf16(p0[8], p0[9]), cvt_pk_bf16(p0[10], p0[11]), cvt_pk_bf16(p0[12], p0[13]), cvt_pk_bf16(p0[14], p0[15])};
            pw[2] = (u32x4){cvt_pk_bf16(p1[0], p1[1]), cvt_pk_bf16(p1[2], p1[3]), cvt_pk_bf16(p1[4], p1[5]), cvt_pk_bf16(p1[6], p1[7])};
            pw[3] = (u32x4){cvt_pk_bf16(p1[8], p1[9]), cvt_pk_bf16(p1[10], p1[11]), cvt_pk_bf16(p1[12], p1[13]), cvt_pk_bf16(p1[14], p1[15])};
            const LAS unsigned char* vp = lds + buf + L_V + ((lane >> 4) & 1) * 32 + (lane & 3) * 8 + (4 * hi + ((lane & 15) >> 2)) * 64;
#pragma unroll
            for (int d0 = 0; d0 < 2; ++d0)
#pragma unroll
                for (int ks = 0; ks < 4; ++ks) { const s16x4 lo = vtr(vp + d0 * 4096 + ks * 1024), hh = vtr(vp + d0 * 4096 + ks * 1024 + 512);
                    const bf16x8 vf = {lo[0], lo[1], lo[2], lo[3], hh[0], hh[1], hh[2], hh[3]};
                    o[d0] = __builtin_amdgcn_mfma_f32_32x32x16_bf16(__builtin_bit_cast(bf16x8, pw[ks]), vf, o[d0], 0, 0, 0); }
        }
        if (KIND == 1) { if (lane == 0) flags[(it & 1) * 8 + wid] = mydone ? 1u : 0u; }
        if (t > 0) { *(LAS u32x4*)(lds + (buf ^ BUFSZ) + L_K + wdst) = kreg; *(LAS u32x4*)(lds + (buf ^ BUFSZ) + L_V + wdst) = vreg; }
        __syncthreads();
        if (t == 0) break;
        if (KIND == 1) { const u32x4 fa = *(const LAS u32x4*)(flags + (it & 1) * 8), fb = *(const LAS u32x4*)(flags + (it & 1) * 8 + 4);
            if ((fa.x & fa.y & fa.z & fa.w & fb.x & fb.y & fb.z & fb.w) != 0u) break; }
    }
    float inv = 1.0f;
    if (KIND == 0) { float a, c; swap_halves(lrun, a, c); inv = 1.0f / (a + c); }
    if (hi == 0) wsf[32 + r32] = inv;
    asm volatile("s_waitcnt lgkmcnt(0)" ::: "memory");
    LAS bf16_t* stg = (LAS bf16_t*)(lds + L_OST) + wid * 2048;
#pragma unroll
    for (int r = 0; r < 16; ++r) { const int orow = crow(r, hi); const float rl = wsf[32 + orow];
        const unsigned w = cvt_pk_bf16(o[0][r] * rl, o[1][r] * rl);
        stg[orow * 64 + r32] = (bf16_t)(w & 0xffffu); stg[orow * 64 + 32 + r32] = (bf16_t)(w >> 16); }
    asm volatile("s_waitcnt lgkmcnt(0)" ::: "memory");
    bf16_t* Ow = O + (rowbase + qw) * OPITCH + KIND * 512 + h * HD;
#pragma unroll
    for (int i = 0; i < 4; ++i) { const int row = i * 8 + (lane >> 3), ch = lane & 7; const u32x4 v = *(const LAS u32x4*)(stg + row * 64 + ch * 8); *(u32x4*)(Ow + (size_t)row * OPITCH + ch * 8) = v; }
    asm volatile("s_waitcnt lgkmcnt(0)" ::: "memory");
}
}

#define XB_TMO      128
#define XB_XCNT(j)  (256  + 64 * (j))
#define XB_XSUB(j)  (1280 + 64 * (j))
#define XB_XGEN(j)  (2304 + 64 * (j))
#define XB_TOP      3328
#define XB_TOPGEN   3392
#define XCD_BAR_WORDS 3456
#define XB_SPIN_CAP (1u << 18)
__device__ __forceinline__ unsigned xb_ld(unsigned* p)              { return __hip_atomic_load(p, __ATOMIC_RELAXED, __HIP_MEMORY_SCOPE_AGENT); }
__device__ __forceinline__ unsigned xb_add(unsigned* p, unsigned v) { return __hip_atomic_fetch_add(p, v, __ATOMIC_RELAXED, __HIP_MEMORY_SCOPE_AGENT); }
__device__ __forceinline__ unsigned xb_xcc_id() { return (unsigned)__builtin_amdgcn_s_getreg((3 << 11) | 20) & 0xFu; }
#define XB_SPIN(cond, bar) do { unsigned _sp = 0; while (cond) { __builtin_amdgcn_s_sleep(1); \
    if ((++_sp & 255u) == 0u) { if (xb_ld(&(bar)[XB_TMO])) break; if (_sp > XB_SPIN_CAP) { atomicAdd(&(bar)[XB_TMO], 1u); break; } } } } while (0)
struct XcdBarrier { unsigned* bar; unsigned x; volatile LAS unsigned* st; };
__device__ __forceinline__ XcdBarrier xcd_barrier_post(unsigned* bar, volatile LAS unsigned* st) {
    XcdBarrier b; b.bar = bar; b.x = xb_xcc_id(); b.st = st;
    if (threadIdx.x == 0) (void)xb_add(&bar[XB_XCNT(b.x)], 1u);
    return b;
}
__device__ __forceinline__ void xcd_barrier_complete(unsigned* bar, unsigned x, unsigned& nloc, unsigned& nx) {
    const unsigned G = gridDim.x * gridDim.y * gridDim.z;
    unsigned sum, cnt, mine, sp = 0u;
    for (;;) {
        sum = 0u; cnt = 0u; mine = 0u;
#pragma unroll
        for (unsigned j = 0; j < 16; ++j) { const unsigned c = xb_ld(&bar[XB_XCNT(j)]); sum += c; cnt += (c > 0u) ? 1u : 0u; mine = (j == x) ? c : mine; }
        if (sum == G) break;
        __builtin_amdgcn_s_sleep(1);
        if ((++sp & 255u) == 0u) { if (xb_ld(&bar[XB_TMO])) break; if (sp > XB_SPIN_CAP) { atomicAdd(&bar[XB_TMO], 1u); break; } }
    }
    nloc = mine > 0u ? mine : 1u; nx = cnt > 0u ? cnt : 1u;
}
__device__ __forceinline__ void xcd_barrier(const XcdBarrier& b) {
    asm volatile("s_waitcnt vmcnt(0)" ::: "memory");
    __syncthreads();
    if (threadIdx.x == 0) {
        unsigned* bar = b.bar;
        __builtin_amdgcn_s_waitcnt(0);
        unsigned nloc = b.st[0], nx = b.st[1];
        if (nloc == 0u) { xcd_barrier_complete(bar, b.x, nloc, nx); b.st[0] = nloc; b.st[1] = nx; }
        const unsigned old = xb_add(&bar[XB_XSUB(b.x)], 1u);
        const unsigned gen = old / nloc;
        if (old + 1u == (gen + 1u) * nloc) {
            __builtin_amdgcn_fence(__ATOMIC_RELEASE, "agent");
            asm volatile("s_waitcnt vmcnt(0)" ::: "memory");
            const unsigned og = xb_add(&bar[XB_TOP], 1u);
            const unsigned tg = og / nx;
            if (og + 1u == (tg + 1u) * nx) xb_add(&bar[XB_TOPGEN], 1u);
            else XB_SPIN(xb_ld(&bar[XB_TOPGEN]) == tg, bar);
            __builtin_amdgcn_fence(__ATOMIC_ACQUIRE, "agent");
            xb_add(&bar[XB_XGEN(b.x)], 1u);
            asm volatile("s_waitcnt vmcnt(0)" ::: "memory");
        } else {
            XB_SPIN(xb_ld(&bar[XB_XGEN(b.x)]) == gen, bar);
            __builtin_amdgcn_fence(__ATOMIC_ACQUIRE, "agent");
            asm volatile("s_waitcnt vmcnt(0)" ::: "memory");
        }
    }
    __syncthreads();
}

constexpr int NWAVES = 8;
constexpr int RING_BYTES = 131072, LDS_BYTES = 147456;
static_assert(att::L_END <= RING_BYTES, "attention scratch fits the ring region");

__device__ __forceinline__ float wave_sum(float v) {
#pragma unroll
    for (int o = 1; o < 64; o <<= 1) v += __shfl_xor(v, o);
    return v;
}
__device__ __forceinline__ void tr_item(const float* W, int ldw, int col0, int K, bf16_t* WT, int row_off, LAS float* scr, int kb, int nb, int lane, const float* gs) {
    const int k0 = 64 * kb, n0 = 32 * nb;
#pragma unroll 8
    for (int i = 0; i < 32; ++i) { const int kk = 2 * i + (lane >> 5); scr[kk * 33 + (lane & 31)] = W[(size_t)(k0 + kk) * ldw + col0 + n0 + (lane & 31)] * (gs ? gs[k0 + kk] : 1.0f); }
    asm volatile("s_waitcnt lgkmcnt(0)" ::: "memory");
    const int c = lane & 7;
#pragma unroll
    for (int j = 0; j < 4; ++j) { const int n = (lane >> 3) + 8 * j; const LAS float* s = scr + (8 * c) * 33 + n;
        u32x4 o; o.x = cvt_pk_bf16(s[0 * 33], s[1 * 33]); o.y = cvt_pk_bf16(s[2 * 33], s[3 * 33]); o.z = cvt_pk_bf16(s[4 * 33], s[5 * 33]); o.w = cvt_pk_bf16(s[6 * 33], s[7 * 33]);
        *(u32x4*)(WT + (size_t)(row_off + n0 + n) * K + k0 + 8 * c) = o; }
    asm volatile("s_waitcnt lgkmcnt(0)" ::: "memory");
}

struct Args { const float* in[16]; float* out; unsigned char* ws; int ph_lo, ph_hi; };

__global__ void __launch_bounds__(NWAVES * 64, 2) fwd_megakernel(Args args) {
    __builtin_assume(__builtin_amdgcn_workitem_id_y() == 0); __builtin_assume(__builtin_amdgcn_workitem_id_z() == 0);
    extern __shared__ __attribute__((aligned(16))) unsigned char lds_raw[];
    LAS unsigned char* lds = (LAS unsigned char*)lds_raw;
    const int tid = threadIdx.x, lane = tid & 63, wave = __builtin_amdgcn_readfirstlane(tid >> 6);
    const int G = gridDim.x, bx = blockIdx.x, vcu = (G % 8 == 0) ? (bx % 8) * (G / 8) + bx / 8 : bx;
    const int gw = vcu * NWAVES + wave, NGW = G * NWAVES;
    unsigned char* ws = args.ws;
    const float* x = args.in[0]; const float* p_in = args.in[1]; const float* g_mix = args.in[2]; const float* w_in = args.in[3]; const float* b_forget = args.in[4]; const float* b_gate = args.in[5];
    const float* w_bf = args.in[6]; const float* w_bs = args.in[7]; const float* w_out = args.in[8]; const float* g_mlp = args.in[9]; const float* w_up = args.in[10]; const float* w_dn = args.in[11];
    const float* g_ple = args.in[12]; const float* w_pg = args.in[13]; const float* w_ple = args.in[14]; const float* g_final = args.in[15];
    float* out = args.out;
    bf16_t* Win_t = (bf16_t*)(ws + WS_WIN); bf16_t* Wbf_t = (bf16_t*)(ws + WS_WBF); bf16_t* Wbs_t = (bf16_t*)(ws + WS_WBS); bf16_t* Wout_t = (bf16_t*)(ws + WS_WOUT);
    bf16_t* Wup_t = (bf16_t*)(ws + WS_WUP); bf16_t* Wdn_t = (bf16_t*)(ws + WS_WDN); bf16_t* Wpg_t = (bf16_t*)(ws + WS_WPG); bf16_t* Wple_t = (bf16_t*)(ws + WS_WPLE);
    float* LOGF = (float*)(ws + WS_LOGF); float* CC = (float*)(ws + WS_CC); float* SSQ1 = (float*)(ws + WS_SSQ1); float* SSQ2 = (float*)(ws + WS_SSQ2);
    bf16_t* PB = (bf16_t*)(ws + WS_PB); bf16_t* BUFA = (bf16_t*)(ws + WS_BUFA); bf16_t* BUFB = (bf16_t*)(ws + WS_BUFB); bf16_t* QKV = (bf16_t*)(ws + WS_QKV); bf16_t* SG = (bf16_t*)(ws + WS_SG);
    bf16_t* HB = (bf16_t*)(ws + WS_H); bf16_t* EB = (bf16_t*)(ws + WS_E);
    const int lo = args.ph_lo, hi = args.ph_hi;
#define IN(k) (lo <= (k) && (k) < hi)
    volatile LAS unsigned* bst = (volatile LAS unsigned*)(lds + RING_BYTES);
    if (tid < 2) bst[tid] = 0u;
    __syncthreads();
    XcdBarrier xbar; xbar.bar = (unsigned*)ws; xbar.x = 0; xbar.st = bst;
    if (hi - lo > 1) xbar = xcd_barrier_post((unsigned*)ws, bst);
#define SEAM(k) do { if (IN(k) && IN((k) + 1)) { if ((k) == 0) cg::this_grid().sync(); else xcd_barrier(xbar); } } while (0)

    if (IN(0)) {
        LAS float* scr = (LAS float*)(lds + wave * 16384);
        {
            constexpr int NSEG = 9;
            int base = 0;
            for (int it = gw; ; it += NGW) {
                int r = it; const float* W; int ldw, col0, K, nblk, row_off; bf16_t* WT; const float* gs = nullptr;
                if (r < 16 * 48) { W = w_in; ldw = NIN_SRC; col0 = 0; K = DM; nblk = 48; WT = Win_t; row_off = 0; }
                else if ((r -= 16 * 48) < 16 * 112) { W = w_in; ldw = NIN_SRC; col0 = 1544; K = DM; nblk = 112; WT = Win_t; row_off = 1536; }
                else if ((r -= 16 * 112) < 8 * 32) { W = w_bf; ldw = DM; col0 = 0; K = 512; nblk = 32; WT = Wbf_t; row_off = 0; }
                else if ((r -= 8 * 32) < 8 * 32) { W = w_bs; ldw = DM; col0 = 0; K = 512; nblk = 32; WT = Wbs_t; row_off = 0; }
                else if ((r -= 8 * 32) < 16 * 32) { W = w_out; ldw = DM; col0 = 0; K = DM; nblk = 32; WT = Wout_t; row_off = 0; }
                else if ((r -= 16 * 32) < 16 * 128) { W = w_up; ldw = DFF; col0 = 0; K = DM; nblk = 128; WT = Wup_t; row_off = 0; gs = g_mlp; }
                else if ((r -= 16 * 128) < 64 * 32) { W = w_dn; ldw = DM; col0 = 0; K = DFF; nblk = 32; WT = Wdn_t; row_off = 0; }
                else if ((r -= 64 * 32) < 16 * 32) { W = w_pg; ldw = DM; col0 = 0; K = DM; nblk = 32; WT = Wpg_t; row_off = 0; gs = g_ple; }
                else if ((r -= 16 * 32) < 4 * 32) { W = w_ple; ldw = DM; col0 = 0; K = DPLE; nblk = 32; WT = Wple_t; row_off = 0; }
                else break;
                tr_item(W, ldw, col0, K, WT, row_off, scr, r / nblk, r % nblk, lane, gs);
                (void)base; (void)NSEG;
            }
        }
        {
            f32x4 gm[4]; f32x4 wf[4][4][2];
#pragma unroll
            for (int j = 0; j < 4; ++j) { gm[j] = *((const f32x4*)g_mix + lane + 64 * j);
#pragma unroll
                for (int e = 0; e < 4; ++e) { const float* wp = w_in + (size_t)(4 * lane + 256 * j + e) * NIN_SRC + 1536; wf[j][e][0] = *(const f32x4*)wp * gm[j][e]; wf[j][e][1] = *(const f32x4*)(wp + 4) * gm[j][e]; } }
            const float bfv = b_forget[lane & 7];
            for (int m = gw; m < M; m += NGW) {
                const f32x4* xr = (const f32x4*)(x + (size_t)m * DM) + lane;
                f32x4 v[4]; float s = 0.f;
#pragma unroll
                for (int j = 0; j < 4; ++j) { v[j] = xr[64 * j]; s += (v[j][0] * v[j][0] + v[j][1] * v[j][1]) + (v[j][2] * v[j][2] + v[j][3] * v[j][3]); }
                const float rstd = __builtin_amdgcn_rsqf(wave_sum(s) * (1.0f / DM) + EPS);
                f32x4 f0 = {0.f, 0.f, 0.f, 0.f}, f1 = {0.f, 0.f, 0.f, 0.f};
#pragma unroll
                for (int j = 0; j < 4; ++j)
#pragma unroll
                    for (int e = 0; e < 4; ++e) { f0 += wf[j][e][0] * v[j][e]; f1 += wf[j][e][1] * v[j][e]; }
                unsigned long long* o8 = (unsigned long long*)(BUFA + (size_t)m * DM) + lane;
#pragma unroll
                for (int j = 0; j < 4; ++j) { const f32x4 y = v[j] * gm[j] * rstd; o8[64 * j] = (unsigned long long)cvt_pk_bf16(y[0], y[1]) | ((unsigned long long)cvt_pk_bf16(y[2], y[3]) << 32); }
                float fl[8];
#pragma unroll
                for (int e = 0; e < 4; ++e) { fl[e] = wave_sum(f0[e]); fl[4 + e] = wave_sum(f1[e]); }
                float mine = fl[0];
#pragma unroll
                for (int e = 1; e < 8; ++e) mine = ((lane & 7) == e) ? fl[e] : mine;
                const float y2 = (mine * rstd + bfv) * LOG2E;
                const float lf = -(fmaxf(-y2, 0.f) + __builtin_amdgcn_logf(1.0f + __builtin_amdgcn_exp2f(-fabsf(y2))));
                if (lane < 8) LOGF[(size_t)((m / SEQ) * NH + lane) * SEQ + (m % SEQ)] = lf;
            }
        }
        {
            const size_t n8 = (size_t)M * DPLE / 8;
            for (size_t i = (size_t)bx * 512 + tid; i < n8; i += (size_t)G * 512) { const f32x4 a = *((const f32x4*)p_in + 2 * i), c = *((const f32x4*)p_in + 2 * i + 1);
                u32x4 w; w.x = cvt_pk_bf16(a[0], a[1]); w.y = cvt_pk_bf16(a[2], a[3]); w.z = cvt_pk_bf16(c[0], c[1]); w.w = cvt_pk_bf16(c[2], c[3]); *((u32x4*)PB + i) = w; }
        }
    }
    SEAM(0);

    if (IN(1)) {
        if (gw < BATCH * NH) {
            const float* src = LOGF + (size_t)gw * SEQ + lane * 32; float* dst = CC + (size_t)gw * SEQ + lane * 32;
            f32x4 v[8]; float run = 0.f;
#pragma unroll
            for (int j = 0; j < 8; ++j) { v[j] = *((const f32x4*)src + j);
#pragma unroll
                for (int e = 0; e < 4; ++e) { run += v[j][e]; v[j][e] = run; } }
            float incl = run;
#pragma unroll
            for (int o = 1; o < 64; o <<= 1) { const float tv = __shfl_up(incl, o); if (lane >= o) incl += tv; }
            const float excl = incl - run;
#pragma unroll
            for (int j = 0; j < 8; ++j) *((f32x4*)dst + j) = v[j] + excl;
        }
        pg8::Gemm g{DM, DM, DM};
        pg8::PlainSched S; S.T.init(M, NIN, G, bx); S.A = (const char*)BUFA; S.B = (const char*)Win_t; S.astep = (size_t)256 * DM * 2; S.bstep = (size_t)256 * DM * 2;
        pg8::EpiQKVG E{QKV, SG, b_gate};
        pg8::gemm_phase<pg8::EpiQKVG, pg8::PlainSched>(lds, g, S, E);
    }
    SEAM(1);

    if (IN(2)) {
        for (int i = 0; i < 8; ++i) {
            const int j = i & 3, kind = i >> 2;
            for (int bh = (vcu >> 1); bh < BATCH * NH; bh += (G >> 1)) {
                const int s = (vcu & 1) * 2 + (j >> 1); const int qb = (j & 1) ? 7 - s : s;
                if (kind == 0) att::attn_unit<0>(bh / NH, bh % NH, qb, QKV, CC, BUFB, lds);
                else att::attn_unit<1>(bh / NH, bh % NH, qb, QKV, CC, BUFB, lds);
            }
        }
    }
    SEAM(2);

    if (IN(3)) {
        pg8::Gemm g{DM, 512, 512};
        pg8::PairSched S; S.T.init(M, DM, G, bx); S.A0 = (const char*)BUFB; S.A1 = (const char*)(BUFB + 512); S.B0 = (const char*)Wbf_t; S.B1 = (const char*)Wbs_t; S.astep = (size_t)256 * DM * 2; S.bstep = (size_t)256 * 512 * 2;
        pg8::EpiBranch E{SG, BUFA};
        pg8::gemm_phase<pg8::EpiBranch, pg8::PairSched>(lds, g, S, E);
    }
    SEAM(3);

    if (IN(4)) {
        {
            pg8::Gemm g{DM, DM, DM};
            pg8::PlainSched S; S.T.init(M, DM, G, bx); S.A = (const char*)BUFA; S.B = (const char*)Wout_t; S.astep = (size_t)256 * DM * 2; S.bstep = (size_t)256 * DM * 2;
            pg8::EpiRes4 E{x, BUFB, SSQ1};
            pg8::gemm_phase<pg8::EpiRes4, pg8::PlainSched>(lds, g, S, E);
        }
        {
            pg8::Gemm g{DPLE, DPLE, DPLE};
            pg8::PlainSched S; S.T.init(M, DM, G, bx); S.A = (const char*)PB; S.B = (const char*)Wple_t; S.astep = (size_t)256 * DPLE * 2; S.bstep = (size_t)256 * DPLE * 2;
            pg8::EpiBf16 E{EB, DM};
            pg8::gemm_phase<pg8::EpiBf16, pg8::PlainSched>(lds, g, S, E);
        }
    }
    SEAM(4);

    if (IN(5)) {
        pg8::Gemm g{DM, DM, DM};
        pg8::PlainSched S; S.T.init(M, DFF, G, bx); S.A = (const char*)BUFB; S.B = (const char*)Wup_t; S.astep = (size_t)256 * DM * 2; S.bstep = (size_t)256 * DM * 2;
        pg8::EpiUp E{HB, SSQ1};
        pg8::gemm_phase<pg8::EpiUp, pg8::PlainSched>(lds, g, S, E);
    }
    SEAM(5);

    if (IN(6)) {
        pg8::Gemm g{DFF, DFF, DFF};
        pg8::PlainSched S; S.T.init(M, DM, G, bx); S.A = (const char*)HB; S.B = (const char*)Wdn_t; S.astep = (size_t)256 * DFF * 2; S.bstep = (size_t)256 * DFF * 2;
        pg8::EpiRes6 E{BUFB, BUFA, SSQ2};
        pg8::gemm_phase<pg8::EpiRes6, pg8::PlainSched>(lds, g, S, E);
    }
    SEAM(6);

    if (IN(7)) {
        pg8::Gemm g{DM, DM, DM};
        pg8::PlainSched S; S.T.init(M, DM, G, bx); S.A = (const char*)BUFA; S.B = (const char*)Wpg_t; S.astep = (size_t)256 * DM * 2; S.bstep = (size_t)256 * DM * 2;
        pg8::EpiPle E{BUFA, BUFB, EB, SSQ2};
        pg8::gemm_phase<pg8::EpiPle, pg8::PlainSched>(lds, g, S, E);
    }
    SEAM(7);

    if (IN(8)) {
        f32x4 gf[4];
#pragma unroll
        for (int j = 0; j < 2; ++j) { gf[2 * j] = *((const f32x4*)g_final + 2 * lane + 128 * j); gf[2 * j + 1] = *((const f32x4*)g_final + 2 * lane + 128 * j + 1); }
        for (int m = gw; m < M; m += 2 * NGW) {
            u32x4 w[2][2];
#pragma unroll
            for (int q = 0; q < 2; ++q)
#pragma unroll
                for (int j = 0; j < 2; ++j) w[q][j] = *((const u32x4*)(BUFB + (size_t)(m + q * NGW) * DM) + lane + 64 * j);
#pragma unroll
            for (int q = 0; q < 2; ++q) {
                f32x4 v[4]; float s = 0.f;
#pragma unroll
                for (int j = 0; j < 2; ++j) { v[2 * j] = pg8::bf4_lo(w[q][j]); v[2 * j + 1] = pg8::bf4_hi(w[q][j]); }
#pragma unroll
                for (int j = 0; j < 4; ++j) s += (v[j][0] * v[j][0] + v[j][1] * v[j][1]) + (v[j][2] * v[j][2] + v[j][3] * v[j][3]);
                const float rstd = __builtin_amdgcn_rsqf(wave_sum(s) * (1.0f / DM) + EPS);
                f32x4* orow = (f32x4*)(out + (size_t)(m + q * NGW) * DM);
#pragma unroll
                for (int j = 0; j < 2; ++j) { orow[2 * lane + 128 * j] = v[2 * j] * gf[2 * j] * rstd; orow[2 * lane + 128 * j + 1] = v[2 * j + 1] * gf[2 * j + 1] * rstd; }
            }
        }
    }
#undef IN
#undef SEAM
}

extern "C" void kernel_launch(void* const* d_in, const int* in_sizes, int n_in, void* d_out, int out_size, void* d_ws, size_t ws_size, hipStream_t stream) {
    static int grid = 0;
    if (grid == 0) {
        if (n_in != 16 || in_sizes[0] != M * DM || out_size != M * DM || ws_size < WS_END) { fprintf(stderr, "kernel_launch: unexpected shapes (n_in %d, in0 %d, out %d, ws %zu); nothing launched\n", n_in, n_in > 0 ? in_sizes[0] : -1, out_size, ws_size); grid = -1; return; }
        int dev = 0, cus = 0, per_cu = 0;
        if (hipGetDevice(&dev) != hipSuccess || hipDeviceGetAttribute(&cus, hipDeviceAttributeMultiprocessorCount, dev) != hipSuccess) { grid = -1; return; }
        if (hipFuncSetAttribute((const void*)fwd_megakernel, hipFuncAttributeMaxDynamicSharedMemorySize, LDS_BYTES) != hipSuccess) { fprintf(stderr, "kernel_launch: hipFuncSetAttribute failed\n"); grid = -1; return; }
        if (hipOccupancyMaxActiveBlocksPerMultiprocessor(&per_cu, (const void*)fwd_megakernel, NWAVES * 64, LDS_BYTES) != hipSuccess || per_cu < 1) { fprintf(stderr, "kernel_launch: occupancy query says %d\n", per_cu); per_cu = 1; }
        (void)hipGetLastError();
        grid = cus;
        if (grid != 256) fprintf(stderr, "kernel_launch: %d CUs; built for 256\n", grid);
    }
    if (grid < 0) return;
    if (hipMemsetAsync(d_ws, 0, 16384, stream) != hipSuccess) { fprintf(stderr, "kernel_launch: memset failed\n"); return; }
    Args a{};
    for (int i = 0; i < 16; ++i) a.in[i] = (const float*)d_in[i];
    a.out = (float*)d_out; a.ws = (unsigned char*)d_ws;
#if MK_N_LAUNCHES == 1
    a.ph_lo = 0; a.ph_hi = N_PHASES;
    void* kargs[] = {&a};
    hipError_t e = hipLaunchCooperativeKernel((const void*)fwd_megakernel, dim3(grid), dim3(NWAVES * 64), kargs, LDS_BYTES, stream);
    if (e != hipSuccess) fprintf(stderr, "kernel_launch: cooperative launch failed: %s (grid %d)\n", hipGetErrorString(e), grid);
#else
    for (int li = 0; li < N_PHASES; ++li) { a.ph_lo = li; a.ph_hi = li + 1; hipLaunchKernelGGL(fwd_megakernel, dim3(grid), dim3(NWAVES * 64), LDS_BYTES, stream, a); }
#endif
}
```

```cpp
#include <hip/hip_runtime.h>
#include <hip/hip_cooperative_groups.h>
#include <cstdio>
#include <cstdint>
namespace cg = cooperative_groups;

#ifndef MK_N_LAUNCHES
#define MK_N_LAUNCHES 1
#endif
constexpr int N_PHASES = 9;

#define LAS __attribute__((address_space(3)))
typedef unsigned short bf16_t;
typedef short bf16x8 __attribute__((ext_vector_type(8)));
typedef short s16x4 __attribute__((ext_vector_type(4)));
typedef float f32x4 __attribute__((ext_vector_type(4)));
typedef float f32x2 __attribute__((ext_vector_type(2)));
typedef float f32x16 __attribute__((ext_vector_type(16)));
typedef unsigned u32x4 __attribute__((ext_vector_type(4)));
typedef unsigned u32x2 __attribute__((ext_vector_type(2)));
typedef __bf16 bf16x2_t __attribute__((ext_vector_type(2)));

constexpr int BATCH = 16, SEQ = 2048, DM = 1024, M = BATCH * SEQ, NH = 8, HD = 64, DFF = 4096, DPLE = 256;
constexpr int NIN_SRC = 5128, NQKV = 3072, NGATE = 2048, NIN = NQKV + NGATE;
constexpr float EPS = 1e-6f;
constexpr float LOG2E = 1.4426950408889634f;
constexpr float C2 = 0.125f * LOG2E;

constexpr size_t MiB = 1u << 20;
constexpr size_t WS_WIN = 2 * MiB, WS_WBF = 12 * MiB, WS_WBS = 13 * MiB, WS_WOUT = 14 * MiB, WS_WUP = 16 * MiB, WS_WDN = 24 * MiB, WS_WPG = 32 * MiB, WS_WPLE = 34 * MiB;
constexpr size_t WS_LOGF = 36 * MiB, WS_CC = 37 * MiB, WS_SSQ1 = 38 * MiB, WS_SSQ2 = 40 * MiB;
constexpr size_t WS_PB = 42 * MiB, WS_BUFA = 58 * MiB, WS_BUFB = 122 * MiB, WS_QKV = 186 * MiB, WS_SG = 378 * MiB, WS_H = 186 * MiB, WS_E = 442 * MiB, WS_END = 506 * MiB;

__device__ __forceinline__ unsigned cvt_pk_bf16(float lo, float hi) { f32x2 v = {lo, hi}; bf16x2_t b = __builtin_convertvector(v, bf16x2_t); return __builtin_bit_cast(unsigned, b); }
__device__ __forceinline__ float bf_lo(unsigned w) { return __uint_as_float(w << 16); }
__device__ __forceinline__ float bf_hi(unsigned w) { return __uint_as_float(w & 0xffff0000u); }
__device__ __forceinline__ float fast_sigmoid(float v) { return __builtin_amdgcn_rcpf(1.0f + __builtin_amdgcn_exp2f(-v * LOG2E)); }

__device__ __forceinline__ const char* uni_ptr(const char* p) { const unsigned long long v = (unsigned long long)p; const unsigned lo = __builtin_amdgcn_readfirstlane((unsigned)v), hi = __builtin_amdgcn_readfirstlane((unsigned)(v >> 32)); return (const char*)(((unsigned long long)hi << 32) | lo); }
namespace pg8 {
constexpr int BM = 256, BK = 64, HALF = 128, HTB = HALF * BK * 2, STAGE_BYTES = 8 * HTB, NXCD = 8, WGM = 8;
__host__ __device__ __forceinline__ int lds_byte(int r, int c) { const int st = (r >> 4) * 2 + (c >> 5), rr = r & 15, cc = c & 31, ob = rr * 64 + cc * 2; return st * 1024 + (ob ^ (((ob >> 9) & 1) << 5)); }
__host__ __device__ __forceinline__ void stage_rc(int b, int& R, int& C) { const int st = b / 1024, sb = b % 1024, swz = sb ^ (((sb >> 9) & 1) << 5); R = (st >> 1) * 16 + swz / 64; C = (st & 1) * 32 + (swz % 64) / 2; }
__host__ __device__ __forceinline__ int perm32(int rho) { const int n = rho >> 4, i = rho & 15; return 8 * (i >> 2) + 4 * n + (i & 3); }

struct Unit { int pm, pn; const char* A; const char* B; int chain; };
struct Gemm { int lda, ldb, K; };

struct TileOrder {
    int nM, nN, nwg, G, c;
    __device__ void init(int Mrows, int N, int G_, int c_) { nM = Mrows / BM; nN = N / BM; nwg = nM * nN; G = G_; c = c_; }
    __device__ bool tile(int i, int& pm, int& pn) const {
        const long L = (long)i * G + c; if (L >= nwg) return false;
        int wgid = (int)L; { const int q = nwg / NXCD, r = nwg % NXCD, xcd = wgid % NXCD, off = wgid / NXCD; wgid = (xcd < r ? xcd * (q + 1) : r * (q + 1) + (xcd - r) * q) + off; }
        const int nig = WGM * nN, gid = wgid / nig, fm = gid * WGM, gsz = (nM - fm) < WGM ? (nM - fm) : WGM;
        pm = fm + ((wgid % nig) % gsz); pn = (wgid % nig) / gsz; return true;
    }
};
struct PlainSched {
    TileOrder T; const char* A; const char* B; size_t astep, bstep;
    __device__ bool next(int i, Unit& u) const { int pm, pn; if (!T.tile(i, pm, pn)) return false; u.pm = pm; u.pn = pn; u.A = A + (size_t)pm * astep; u.B = B + (size_t)pn * bstep; u.chain = 0; return true; }
};
struct PairSched {
    TileOrder T; const char* A0; const char* A1; const char* B0; const char* B1; size_t astep, bstep;
    __device__ bool next(int i, Unit& u) const { int pm, pn; if (!T.tile(i >> 1, pm, pn)) return false; const int s = i & 1; u.pm = pm; u.pn = pn;
        u.A = (s ? A1 : A0) + (size_t)pm * astep; u.B = (s ? B1 : B0) + (size_t)pn * bstep; u.chain = s ? 0 : 1; return true; }
};

typedef f32x4 Acc[2][2][4][2];

struct EpiQKVG {
    static constexpr bool PERM = true;
    bf16_t* QKV; bf16_t* SG; const float* bgate;
    __device__ __forceinline__ void operator()(Acc& acc, const Unit& u, int wr, int wc, int fr, int fq, LAS float* tab, int tid) const {
        const int row0 = u.pm * BM + wr * 64 + fr;
        if (u.pn < 12) {
            const float sc = (u.pn < 2 || (u.pn >= 6 && u.pn < 8)) ? C2 : 1.0f;
            const int col0 = u.pn * BM + wc * 32 + 8 * fq;
#pragma unroll
            for (int ai = 0; ai < 2; ++ai)
#pragma unroll
                for (int m = 0; m < 4; ++m) { bf16_t* rowp = QKV + (size_t)(row0 + ai * HALF + m * 16) * NQKV + col0;
#pragma unroll
                    for (int bj = 0; bj < 2; ++bj) { const f32x4 v0 = acc[ai][bj][m][0] * sc, v1 = acc[ai][bj][m][1] * sc;
                        u32x4 w; w.x = cvt_pk_bf16(v0[0], v0[1]); w.y = cvt_pk_bf16(v0[2], v0[3]); w.z = cvt_pk_bf16(v1[0], v1[1]); w.w = cvt_pk_bf16(v1[2], v1[3]);
                        *(u32x4*)(rowp + bj * HALF) = w; } }
        } else {
            const int col0 = (u.pn - 12) * BM + wc * 32 + 8 * fq;
            f32x4 bv[2][2];
#pragma unroll
            for (int bj = 0; bj < 2; ++bj)
#pragma unroll
                for (int n = 0; n < 2; ++n) bv[bj][n] = *(const f32x4*)(bgate + col0 + bj * HALF + 4 * n);
#pragma unroll
            for (int ai = 0; ai < 2; ++ai)
#pragma unroll
                for (int m = 0; m < 4; ++m) { bf16_t* rowp = SG + (size_t)(row0 + ai * HALF + m * 16) * NGATE + col0;
#pragma unroll
                    for (int bj = 0; bj < 2; ++bj) { const f32x4 a0 = acc[ai][bj][m][0] + bv[bj][0], a1 = acc[ai][bj][m][1] + bv[bj][1];
                        u32x4 w; w.x = cvt_pk_bf16(fast_sigmoid(a0[0]), fast_sigmoid(a0[1])); w.y = cvt_pk_bf16(fast_sigmoid(a0[2]), fast_sigmoid(a0[3]));
                        w.z = cvt_pk_bf16(fast_sigmoid(a1[0]), fast_sigmoid(a1[1])); w.w = cvt_pk_bf16(fast_sigmoid(a1[2]), fast_sigmoid(a1[3]));
                        *(u32x4*)(rowp + bj * HALF) = w; } }
        }
    }
};
struct EpiBf16 {
    static constexpr bool PERM = true;
    bf16_t* O; int ldc;
    __device__ __forceinline__ void operator()(Acc& acc, const Unit& u, int wr, int wc, int fr, int fq, LAS float* tab, int tid) const {
        const int row0 = u.pm * BM + wr * 64 + fr, col0 = u.pn * BM + wc * 32 + 8 * fq;
#pragma unroll
        for (int ai = 0; ai < 2; ++ai)
#pragma unroll
            for (int m = 0; m < 4; ++m) { bf16_t* rowp = O + (size_t)(row0 + ai * HALF + m * 16) * ldc + col0;
#pragma unroll
                for (int bj = 0; bj < 2; ++bj) { const f32x4 v0 = acc[ai][bj][m][0], v1 = acc[ai][bj][m][1];
                    u32x4 w; w.x = cvt_pk_bf16(v0[0], v0[1]); w.y = cvt_pk_bf16(v0[2], v0[3]); w.z = cvt_pk_bf16(v1[0], v1[1]); w.w = cvt_pk_bf16(v1[2], v1[3]);
                    *(u32x4*)(rowp + bj * HALF) = w; } }
    }
};
__device__ __forceinline__ f32x4 bf4_lo(const u32x4 w) { return (f32x4){bf_lo(w.x), bf_hi(w.x), bf_lo(w.y), bf_hi(w.y)}; }
__device__ __forceinline__ f32x4 bf4_hi(const u32x4 w) { return (f32x4){bf_lo(w.z), bf_hi(w.z), bf_lo(w.w), bf_hi(w.w)}; }
__device__ __forceinline__ u32x4 pack8(const f32x4 v0, const f32x4 v1) { u32x4 w; w.x = cvt_pk_bf16(v0[0], v0[1]); w.y = cvt_pk_bf16(v0[2], v0[3]); w.z = cvt_pk_bf16(v1[0], v1[1]); w.w = cvt_pk_bf16(v1[2], v1[3]); return w; }
struct EpiBranch {
    static constexpr bool PERM = true;
    const bf16_t* SG; bf16_t* MG;
    __device__ __forceinline__ void operator()(Acc& acc, const Unit& u, int wr, int wc, int fr, int fq, LAS float* tab, int tid) const {
        const int row0 = u.pm * BM + wr * 64 + fr, col0 = u.pn * BM + wc * 32 + 8 * fq;
#pragma unroll
        for (int ai = 0; ai < 2; ++ai) {
            u32x4 ga[4][2], gb[4][2];
#pragma unroll
            for (int m = 0; m < 4; ++m)
#pragma unroll
                for (int bj = 0; bj < 2; ++bj) { const bf16_t* p = SG + (size_t)(row0 + ai * HALF + m * 16) * NGATE + col0 + bj * HALF; gb[m][bj] = *(const u32x4*)(p + DM); if (u.chain) ga[m][bj] = *(const u32x4*)p; }
#pragma unroll
            for (int m = 0; m < 4; ++m)
#pragma unroll
                for (int bj = 0; bj < 2; ++bj) { const f32x4 b0 = bf4_lo(gb[m][bj]), b1 = bf4_hi(gb[m][bj]);
                    if (u.chain) { const f32x4 a0 = bf4_lo(ga[m][bj]), a1 = bf4_hi(ga[m][bj]);
#pragma unroll
                        for (int e = 0; e < 4; ++e) { acc[ai][bj][m][0][e] *= a0[e] * __builtin_amdgcn_rcpf(fmaxf(b0[e], 1e-30f)); acc[ai][bj][m][1][e] *= a1[e] * __builtin_amdgcn_rcpf(fmaxf(b1[e], 1e-30f)); }
                    } else *(u32x4*)(MG + (size_t)(row0 + ai * HALF + m * 16) * DM + col0 + bj * HALF) = pack8(acc[ai][bj][m][0] * b0, acc[ai][bj][m][1] * b1); }
            asm volatile("" ::: "memory");
        }
    }
};
__device__ __forceinline__ void ssq_publish(LAS float* tab, float* ssq, const Unit& u, int tid) {
    asm volatile("s_waitcnt lgkmcnt(0)" ::: "memory"); __builtin_amdgcn_s_barrier(); asm volatile("" ::: "memory");
    if (tid < 256) { const f32x4 t = *(const LAS f32x4*)(tab + tid * 4); ssq[(size_t)(u.pm * BM + tid) * 4 + u.pn] = (t[0] + t[1]) + (t[2] + t[3]); }
}
struct EpiRes4 {
    static constexpr bool PERM = true;
    const float* base; bf16_t* xb; float* ssq;
    __device__ __forceinline__ void operator()(Acc& acc, const Unit& u, int wr, int wc, int fr, int fq, LAS float* tab, int tid) const {
        const int row0 = u.pm * BM + wr * 64 + fr, col0 = u.pn * BM + wc * 32 + 8 * fq;
#pragma unroll
        for (int ai = 0; ai < 2; ++ai) {
            f32x4 bs[4][2][2];
#pragma unroll
            for (int m = 0; m < 4; ++m)
#pragma unroll
                for (int bj = 0; bj < 2; ++bj)
#pragma unroll
                    for (int n = 0; n < 2; ++n) bs[m][bj][n] = *(const f32x4*)(base + (size_t)(row0 + ai * HALF + m * 16) * DM + col0 + bj * HALF + 4 * n);
#pragma unroll
            for (int m = 0; m < 4; ++m) { float s = 0.f;
#pragma unroll
                for (int bj = 0; bj < 2; ++bj) { const f32x4 x0 = bs[m][bj][0] + acc[ai][bj][m][0], x1 = bs[m][bj][1] + acc[ai][bj][m][1];
                    s += ((x0[0] * x0[0] + x0[1] * x0[1]) + (x0[2] * x0[2] + x0[3] * x0[3])) + ((x1[0] * x1[0] + x1[1] * x1[1]) + (x1[2] * x1[2] + x1[3] * x1[3]));
                    *(u32x4*)(xb + (size_t)(row0 + ai * HALF + m * 16) * DM + col0 + bj * HALF) = pack8(x0, x1); }
                s += __shfl_xor(s, 16); s += __shfl_xor(s, 32);
                if (fq == 0) tab[(ai * HALF + wr * 64 + m * 16 + fr) * 4 + wc] = s; }
            asm volatile("" ::: "memory");
        }
        ssq_publish(tab, ssq, u, tid);
    }
};
struct EpiRes6 {
    static constexpr bool PERM = true;
    const bf16_t* xin; bf16_t* xb; float* ssq;
    __device__ __forceinline__ void operator()(Acc& acc, const Unit& u, int wr, int wc, int fr, int fq, LAS float* tab, int tid) const {
        const int row0 = u.pm * BM + wr * 64 + fr, col0 = u.pn * BM + wc * 32 + 8 * fq;
        u32x4 xi[2][4][2];
#pragma unroll
        for (int ai = 0; ai < 2; ++ai)
#pragma unroll
            for (int m = 0; m < 4; ++m)
#pragma unroll
                for (int bj = 0; bj < 2; ++bj) xi[ai][m][bj] = *(const u32x4*)(xin + (size_t)(row0 + ai * HALF + m * 16) * DM + col0 + bj * HALF);
#pragma unroll
        for (int ai = 0; ai < 2; ++ai)
#pragma unroll
            for (int m = 0; m < 4; ++m) { float s = 0.f;
#pragma unroll
                for (int bj = 0; bj < 2; ++bj) { const f32x4 x0 = bf4_lo(xi[ai][m][bj]) + acc[ai][bj][m][0], x1 = bf4_hi(xi[ai][m][bj]) + acc[ai][bj][m][1];
                    s += ((x0[0] * x0[0] + x0[1] * x0[1]) + (x0[2] * x0[2] + x0[3] * x0[3])) + ((x1[0] * x1[0] + x1[1] * x1[1]) + (x1[2] * x1[2] + x1[3] * x1[3]));
                    *(u32x4*)(xb + (size_t)(row0 + ai * HALF + m * 16) * DM + col0 + bj * HALF) = pack8(x0, x1); }
                s += __shfl_xor(s, 16); s += __shfl_xor(s, 32);
                if (fq == 0) tab[(ai * HALF + wr * 64 + m * 16 + fr) * 4 + wc] = s; }
        ssq_publish(tab, ssq, u, tid);
    }
};
__device__ __forceinline__ float rstd_of(const f32x4 q) { return __builtin_amdgcn_rsqf(((q[0] + q[1]) + (q[2] + q[3])) * (1.0f / DM) + EPS); }
struct EpiUp {
    static constexpr bool PERM = true;
    bf16_t* H; const float* ssq;
    __device__ __forceinline__ void operator()(Acc& acc, const Unit& u, int wr, int wc, int fr, int fq, LAS float* tab, int tid) const {
        const int row0 = u.pm * BM + wr * 64 + fr, col0 = u.pn * BM + wc * 32 + 8 * fq;
        f32x4 sq[2][4];
#pragma unroll
        for (int ai = 0; ai < 2; ++ai)
#pragma unroll
            for (int m = 0; m < 4; ++m) sq[ai][m] = *(const f32x4*)(ssq + (size_t)(row0 + ai * HALF + m * 16) * 4);
#pragma unroll
        for (int ai = 0; ai < 2; ++ai)
#pragma unroll
            for (int m = 0; m < 4; ++m) { const float r = rstd_of(sq[ai][m]); bf16_t* rowp = H + (size_t)(row0 + ai * HALF + m * 16) * DFF + col0;
#pragma unroll
                for (int bj = 0; bj < 2; ++bj) { f32x4 v0 = acc[ai][bj][m][0] * r, v1 = acc[ai][bj][m][1] * r;
#pragma unroll
                    for (int e = 0; e < 4; ++e) { const float a = fmaxf(v0[e], 0.f), b = fmaxf(v1[e], 0.f); v0[e] = a * a; v1[e] = b * b; }
                    *(u32x4*)(rowp + bj * HALF) = pack8(v0, v1); } }
    }
};
struct EpiPle {
    static constexpr bool PERM = true;
    const bf16_t* xin; bf16_t* xb; const bf16_t* E; const float* ssq;
    __device__ __forceinline__ void operator()(Acc& acc, const Unit& u, int wr, int wc, int fr, int fq, LAS float* tab, int tid) const {
        const int row0 = u.pm * BM + wr * 64 + fr, col0 = u.pn * BM + wc * 32 + 8 * fq;
#pragma unroll
        for (int ai = 0; ai < 2; ++ai)
#pragma unroll
            for (int mh = 0; mh < 2; ++mh) {
                u32x4 xi[2][2], ei[2][2]; f32x4 sq[2];
#pragma unroll
                for (int mm = 0; mm < 2; ++mm) { const int row = row0 + ai * HALF + (2 * mh + mm) * 16; sq[mm] = *(const f32x4*)(ssq + (size_t)row * 4);
#pragma unroll
                    for (int bj = 0; bj < 2; ++bj) { const size_t off = (size_t)row * DM + col0 + bj * HALF; xi[mm][bj] = *(const u32x4*)(xin + off); ei[mm][bj] = *(const u32x4*)(E + off); } }
#pragma unroll
                for (int mm = 0; mm < 2; ++mm) { const int m = 2 * mh + mm; const float r = rstd_of(sq[mm]);
#pragma unroll
                    for (int bj = 0; bj < 2; ++bj) { const f32x4 a0 = acc[ai][bj][m][0] * r, a1 = acc[ai][bj][m][1] * r, e0 = bf4_lo(ei[mm][bj]), e1 = bf4_hi(ei[mm][bj]); f32x4 o0 = bf4_lo(xi[mm][bj]), o1 = bf4_hi(xi[mm][bj]);
#pragma unroll
                        for (int e = 0; e < 4; ++e) { o0[e] += fast_sigmoid(a0[e]) * e0[e]; o1[e] += fast_sigmoid(a1[e]) * e1[e]; }
                        *(u32x4*)(xb + (size_t)(row0 + ai * HALF + m * 16) * DM + col0 + bj * HALF) = pack8(o0, o1); } }
                asm volatile("" ::: "memory");
            }
    }
};

template <class Epi, class Sched>
__device__ __forceinline__ void gemm_phase(LAS unsigned char* lds, const Gemm g, const Sched& S, const Epi& E) {
    const int tid = threadIdx.x, wid = __builtin_amdgcn_readfirstlane(tid >> 6), lane = tid & 63, wr = wid >> 2, wc = wid & 3, fr = lane & 15, fq = lane >> 4;
    const int K = g.K, nt = K / BK;
    unsigned voffA[2], voffB[2];
#pragma unroll
    for (int i = 0; i < 2; ++i) { int R, C; stage_rc(tid * 16 + i * 8192, R, C); const int Rb = Epi::PERM ? ((R & ~31) + perm32(R & 31)) : R;
        voffA[i] = (unsigned)(R * g.lda + C) * 2u; voffB[i] = (unsigned)(Rb * g.ldb + C) * 2u; }
    const size_t kstep = (size_t)(BK * 2);
    const size_t hA = (size_t)HALF * g.lda * 2, hB = (size_t)HALF * g.ldb * 2;
    const unsigned ldsw = (unsigned)wid * 1024u;
    const int aoff = lds_byte(wr * 64 + fr, fq * 8), boff = lds_byte(wc * 32 + fr, fq * 8);
#define PG8_SA(b, h) (((b) * 2 + (h)) * HTB)
#define PG8_SB(b, h) ((4 + (b) * 2 + (h)) * HTB)
#define PG8_STAGE(bufoff, gbase, voff) do { _Pragma("unroll") for (int _i = 0; _i < 2; ++_i) \
        __builtin_amdgcn_global_load_lds((const unsigned*)((const char*)(gbase) + (voff)[_i]), (LAS unsigned*)(lds + (bufoff) + ldsw + _i * 8192), 16, 0, 0); } while (0)
#define PG8_LDA(dst, b, h) do { _Pragma("unroll") for (int m = 0; m < 4; ++m) _Pragma("unroll") for (int k = 0; k < 2; ++k) dst[m][k] = *(const LAS bf16x8*)(lds + PG8_SA(b, h) + aoff + m * 2048 + k * 1024); } while (0)
#define PG8_LDB(dst, b, h) do { _Pragma("unroll") for (int n = 0; n < 2; ++n) _Pragma("unroll") for (int k = 0; k < 2; ++k) dst[n][k] = *(const LAS bf16x8*)(lds + PG8_SB(b, h) + boff + n * 2048 + k * 1024); } while (0)
#define PG8_MMA(ai, bj, At, Bt) do { __builtin_amdgcn_s_setprio(1); _Pragma("unroll") for (int m = 0; m < 4; ++m) _Pragma("unroll") for (int n = 0; n < 2; ++n) _Pragma("unroll") for (int k = 0; k < 2; ++k) \
        acc[ai][bj][m][n] = __builtin_amdgcn_mfma_f32_16x16x32_bf16(Bt[n][k], At[m][k], acc[ai][bj][m][n], 0, 0, 0); __builtin_amdgcn_s_setprio(0); } while (0)
#define PG8_WAIT_V(n) asm volatile("s_waitcnt vmcnt(" #n ")" ::: "memory")
#define PG8_WAIT_L(n) asm volatile("s_waitcnt lgkmcnt(" #n ")" ::: "memory")
#define PG8_BAR __builtin_amdgcn_s_barrier()
#define PG8_SCHED __builtin_amdgcn_sched_barrier(0)
#define PG8_ZERO() do { _Pragma("unroll") for (int a = 0; a < 2; ++a) _Pragma("unroll") for (int b = 0; b < 2; ++b) _Pragma("unroll") for (int m = 0; m < 4; ++m) _Pragma("unroll") for (int n = 0; n < 2; ++n) acc[a][b][m][n] = (f32x4){0.f, 0.f, 0.f, 0.f}; } while (0)
    Unit cur, nxt; int ui = 0;
    if (!S.next(0, cur)) return;
    Acc acc;
    PG8_ZERO();
    bf16x8 At[4][2], B0[2][2], B1[2][2];
    const char* cA = uni_ptr(cur.A); const char* cB = uni_ptr(cur.B);
    PG8_STAGE(PG8_SB(0, 0), cB, voffB); PG8_STAGE(PG8_SB(0, 1), cB + hB, voffB); PG8_STAGE(PG8_SA(0, 0), cA, voffA); PG8_STAGE(PG8_SA(0, 1), cA + hA, voffA);
    if (wr == 1) PG8_BAR;
    PG8_WAIT_V(2); PG8_BAR;
    PG8_STAGE(PG8_SB(1, 0), cB + kstep, voffB); PG8_STAGE(PG8_SA(1, 0), cA + kstep, voffA); PG8_STAGE(PG8_SB(1, 1), cB + hB + kstep, voffB);
    PG8_WAIT_V(6); PG8_BAR;
    for (;;) {
        const bool has_next = S.next(ui + 1, nxt);
        const char* nA = uni_ptr(has_next ? nxt.A : cA); const char* nB = uni_ptr(has_next ? nxt.B : cB);
#pragma nounroll
        for (int t = 0; t < nt; t += 2) {
            const bool last = (t == nt - 2);
            const char* a1 = cA + (size_t)(t + 1) * kstep;
            const char* a2 = last ? nA : cA + (size_t)(t + 2) * kstep; const char* b2 = last ? nB : cB + (size_t)(t + 2) * kstep;
            const char* a3 = a2 + kstep; const char* b3 = b2 + kstep;
            PG8_LDB(B0, 0, 0); PG8_LDB(B1, 0, 1); PG8_SCHED; PG8_LDA(At, 0, 0); PG8_STAGE(PG8_SA(1, 1), a1 + hA, voffA);
            PG8_WAIT_V(8); PG8_WAIT_L(0); PG8_BAR; PG8_MMA(0, 0, At, B0); PG8_MMA(0, 1, At, B1); PG8_BAR; PG8_SCHED;
            PG8_LDA(At, 0, 1); PG8_STAGE(PG8_SB(0, 0), b2, voffB); PG8_STAGE(PG8_SB(0, 1), b2 + hB, voffB); PG8_STAGE(PG8_SA(0, 0), a2, voffA);
            PG8_WAIT_V(8); PG8_WAIT_L(0); PG8_BAR; PG8_MMA(1, 0, At, B0); PG8_MMA(1, 1, At, B1); PG8_BAR; PG8_SCHED;
            PG8_LDB(B0, 1, 0); PG8_LDB(B1, 1, 1); PG8_SCHED; PG8_LDA(At, 1, 0); PG8_STAGE(PG8_SA(0, 1), a2 + hA, voffA);
            PG8_WAIT_V(8); PG8_WAIT_L(0); PG8_BAR; PG8_MMA(0, 0, At, B0); PG8_MMA(0, 1, At, B1); PG8_BAR; PG8_SCHED;
            PG8_LDA(At, 1, 1); PG8_STAGE(PG8_SB(1, 0), b3, voffB); PG8_STAGE(PG8_SB(1, 1), b3 + hB, voffB); PG8_STAGE(PG8_SA(1, 0), a3, voffA);
            PG8_WAIT_V(8); PG8_WAIT_L(0); PG8_BAR; PG8_MMA(1, 0, At, B0); PG8_MMA(1, 1, At, B1); PG8_BAR; PG8_SCHED;
        }
        if (wr == 0) PG8_BAR;
        E(acc, cur, wr, wc, fr, fq, (LAS float*)(lds + STAGE_BYTES + 64), tid);
        if (!has_next) break;
        if (!cur.chain) PG8_ZERO();
        cur = nxt; cA = nA; cB = nB; ++ui;
        if (wr == 1) PG8_BAR;
    }
    PG8_WAIT_V(0);
    PG8_BAR;
#undef PG8_SA
#undef PG8_SB
#undef PG8_STAGE
#undef PG8_LDA
#undef PG8_LDB
#undef PG8_MMA
#undef PG8_WAIT_V
#undef PG8_WAIT_L
#undef PG8_BAR
#undef PG8_SCHED
#undef PG8_ZERO
}
}

namespace att {
constexpr int PITCH = NQKV, OPITCH = DM;
constexpr int NSLOT = 4, SLOT = 16384, L_K = 0, L_V = 8192;
constexpr int L_CB = NSLOT * SLOT, L_WS = L_CB + SEQ * 4, L_OST = L_WS + 8 * 256, L_FLAG = L_OST + 8 * 4096, L_END = L_FLAG + 64;
constexpr float SB_THR = -160.0f;
__device__ __forceinline__ int crow(int r, int hi) { return (r & 3) + 8 * (r >> 2) + 4 * hi; }
__device__ __forceinline__ s16x4 vtr(const LAS unsigned char* p) { typedef short v4i16_t __attribute__((ext_vector_type(4))); return __builtin_bit_cast(s16x4, __builtin_amdgcn_ds_read_tr16_b64_v4i16((LAS v4i16_t*)p)); }
__device__ __forceinline__ void swap_halves(float v, float& lo, float& hi_) { auto rr = __builtin_amdgcn_permlane32_swap(__float_as_uint(v), __float_as_uint(v), false, false); lo = __uint_as_float(rr[0]); hi_ = __uint_as_float(rr[1]); }

template <int KIND>
__device__ __forceinline__ void attn_unit(int b, int h, int qb, const bf16_t* QKV, const float* cc, bf16_t* O, LAS unsigned char* lds) {
    const int tid = threadIdx.x, lane = tid & 63, r32 = lane & 31, hi = lane >> 5; const int wid = __builtin_amdgcn_readfirstlane(tid >> 6);
    const size_t rowbase = (size_t)b * SEQ; const int q0 = qb * 256, qw = q0 + wid * 32, qabs = qw + r32;
    const int colq = KIND * 1536 + h * HD;
    const bf16_t* ksrc = QKV + rowbase * PITCH + colq + 512 + (size_t)lane * PITCH + wid * 8;
    const bf16_t* vsrc = QKV + rowbase * PITCH + colq + 1024 + (size_t)(16 * (wid & 3) + (lane >> 2)) * PITCH + (wid >> 2) * 32 + (lane & 3) * 8;
    const int wdst = wid * 1024;
    const int nIter = qb * 4 + 4, T_last = nIter - 1, td = qw >> 6;
#define ATT_DMA(itx) do { const int t_ = T_last - (itx); LAS unsigned char* sl_ = lds + ((itx) & (NSLOT - 1)) * SLOT + wdst; \
        __builtin_amdgcn_global_load_lds((const unsigned*)(ksrc + (size_t)t_ * 64 * PITCH), (LAS unsigned*)(sl_ + L_K), 16, 0, 0); \
        __builtin_amdgcn_global_load_lds((const unsigned*)(vsrc + (size_t)t_ * 64 * PITCH), (LAS unsigned*)(sl_ + L_V), 16, 0, 0); } while (0)
    ATT_DMA(0); ATT_DMA(1); ATT_DMA(2);
    const bf16_t* Qw = QKV + (rowbase + qw) * PITCH + colq;
    bf16x8 qr[4];
#pragma unroll
    for (int d0 = 0; d0 < 4; ++d0) qr[d0] = *(const bf16x8*)(Qw + (size_t)r32 * PITCH + d0 * 16 + hi * 8);
    LAS float* wsf = (LAS float*)(lds + L_WS) + wid * 64;
    LAS unsigned* flags = (LAS unsigned*)(lds + L_FLAG);
    LAS float* cbl = (LAS float*)(lds + L_CB);
    if (KIND == 0) { const float* ccb = cc + (size_t)(b * NH + h) * SEQ; const float cref = ccb[q0 + 255]; const f32x4 c4 = *((const f32x4*)ccb + tid); *((LAS f32x4*)cbl + tid) = cref - c4; }
    f32x16 o[2]; o[0] = (f32x16){}; o[1] = (f32x16){};
    float mrun = -INFINITY, lrun = 0.f, R = 0.f; bool mydone = false;
    for (int it = 0; it < nIter; ++it) {
        const int t = T_last - it; const int ahead = nIter - 1 - it;
        if (ahead >= 2) asm volatile("s_waitcnt vmcnt(4) lgkmcnt(0)" ::: "memory"); else if (ahead == 1) asm volatile("s_waitcnt vmcnt(2) lgkmcnt(0)" ::: "memory"); else asm volatile("s_waitcnt vmcnt(0) lgkmcnt(0)" ::: "memory");
        __builtin_amdgcn_s_barrier(); asm volatile("" ::: "memory");
        if (KIND == 1 && it > 0) { const u32x4 fa = *(const LAS u32x4*)(flags + ((it - 1) & 1) * 8), fb = *(const LAS u32x4*)(flags + ((it - 1) & 1) * 8 + 4);
            if ((fa.x & fa.y & fa.z & fa.w & fb.x & fb.y & fb.z & fb.w) != 0u) break; }
        if (it + 3 < nIter) ATT_DMA(it + 3);
        if (t <= td && !mydone) {
            const LAS unsigned char* slot = lds + (it & (NSLOT - 1)) * SLOT;
            f32x16 p0, p1;
            if (KIND == 0) {
                const LAS f32x4* cb4 = (const LAS f32x4*)(cbl + t * 64 + 4 * hi);
#pragma unroll
                for (int g = 0; g < 4; ++g) { const f32x4 c0 = cb4[2 * g], c1 = cb4[8 + 2 * g];
#pragma unroll
                    for (int i = 0; i < 4; ++i) { p0[4 * g + i] = c0[i]; p1[4 * g + i] = c1[i]; } }
            } else { p0 = (f32x16){}; p1 = (f32x16){}; }
            const LAS unsigned char* kb = slot + L_K + hi * 1024 + r32 * 16;
#pragma unroll
            for (int d0 = 0; d0 < 4; ++d0) { const bf16x8 b0 = *(const LAS bf16x8*)(kb + d0 * 2048), b1 = *(const LAS bf16x8*)(kb + d0 * 2048 + 512);
                p0 = __builtin_amdgcn_mfma_f32_32x32x16_bf16(b0, qr[d0], p0, 0, 0, 0); p1 = __builtin_amdgcn_mfma_f32_32x32x16_bf16(b1, qr[d0], p1, 0, 0, 0); }
            const bool diag = (t == td); const int kv0 = t * 64 + 4 * hi;
            if (KIND == 0) {
                if (diag) {
#pragma unroll
                    for (int r = 0; r < 16; ++r) { const int kv = kv0 + (r & 3) + 8 * (r >> 2); if (kv > qabs) p0[r] = -INFINITY; if (kv + 32 > qabs) p1[r] = -INFINITY; }
                }
                float rm = fmaxf(p0[0], p1[0]);
#pragma unroll
                for (int r = 1; r < 16; ++r) rm = fmaxf(rm, fmaxf(p0[r], p1[r]));
                { float a, c; swap_halves(rm, a, c); rm = fmaxf(a, c); }
                const float mnew = fmaxf(mrun, rm); const float f = __builtin_amdgcn_exp2f(mrun - mnew); mrun = mnew;
                float ls = 0.f;
#pragma unroll
                for (int r = 0; r < 16; ++r) { p0[r] = __builtin_amdgcn_exp2f(p0[r] - mnew); p1[r] = __builtin_amdgcn_exp2f(p1[r] - mnew); ls += p0[r] + p1[r]; }
                lrun = lrun * f + ls;
                if (__any(f != 1.0f)) {
                    if (hi == 0) wsf[r32] = f;
                    asm volatile("s_waitcnt lgkmcnt(0)" ::: "memory");
#pragma unroll
                    for (int r = 0; r < 16; ++r) { const float fr_ = wsf[crow(r, hi)]; o[0][r] *= fr_; o[1][r] *= fr_; }
                    asm volatile("s_waitcnt lgkmcnt(0)" ::: "memory");
                }
            } else {
                f32x16 l0, l1;
#pragma unroll
                for (int r = 0; r < 16; ++r) {
                    const int kv = kv0 + (r & 3) + 8 * (r >> 2);
                    { const float z = p0[r]; const float tt = __builtin_amdgcn_logf(1.0f + __builtin_amdgcn_exp2f(-fabsf(z))); float L = -(fmaxf(z, 0.f) + tt); if (diag && !(kv < qabs)) L = 0.f; l0[r] = L; }
                    { const float z = p1[r]; const float tt = __builtin_amdgcn_logf(1.0f + __builtin_amdgcn_exp2f(-fabsf(z))); float L = -(fmaxf(z, 0.f) + tt); if (diag && !(kv + 32 < qabs)) L = 0.f; l1[r] = L; }
                }
                float G[8], Gp[8];
#pragma unroll
                for (int g = 0; g < 4; ++g) { G[g] = (l0[4 * g] + l0[4 * g + 1]) + (l0[4 * g + 2] + l0[4 * g + 3]); G[4 + g] = (l1[4 * g] + l1[4 * g + 1]) + (l1[4 * g + 2] + l1[4 * g + 3]); }
#pragma unroll
                for (int c = 0; c < 8; ++c) { float a, d; swap_halves(G[c], a, d); Gp[c] = hi ? a : d; }
                float cs = 0.f;
#pragma unroll
                for (int c = 7; c >= 0; --c) {
                    const float ex = cs + (hi ? 0.f : Gp[c]);
                    const int g = c & 3;
                    if (c >= 4) { float s3 = l1[4 * g + 3] + ex, s2 = l1[4 * g + 2] + s3, s1 = l1[4 * g + 1] + s2, s0 = l1[4 * g] + s1; l1[4 * g + 3] = s3; l1[4 * g + 2] = s2; l1[4 * g + 1] = s1; l1[4 * g] = s0; }
                    else        { float s3 = l0[4 * g + 3] + ex, s2 = l0[4 * g + 2] + s3, s1 = l0[4 * g + 1] + s2, s0 = l0[4 * g] + s1; l0[4 * g + 3] = s3; l0[4 * g + 2] = s2; l0[4 * g + 1] = s1; l0[4 * g] = s0; }
                    cs += G[c] + Gp[c];
                }
#pragma unroll
                for (int r = 0; r < 16; ++r) {
                    const int kv = kv0 + (r & 3) + 8 * (r >> 2);
                    float w0 = __builtin_amdgcn_exp2f(p0[r] + l0[r] + R), w1 = __builtin_amdgcn_exp2f(p1[r] + l1[r] + R);
                    if (diag && !(kv < qabs)) w0 = 0.f; if (diag && !(kv + 32 < qabs)) w1 = 0.f;
                    p0[r] = w0; p1[r] = w1;
                }
                R += cs;
                mydone = __all(R < SB_THR);
            }
            u32x4 pw[4];
            pw[0] = (u32x4){cvt_pk_bf16(p0[0], p0[1]), cvt_pk_bf16(p0[2], p0[3]), cvt_pk_bf16(p0[4], p0[5]), cvt_pk_bf16(p0[6], p0[7])};
            pw[1] = (u32x4){cvt_pk_bf16(p0[8], p0[9]), cvt_pk_bf16(p0[10], p0[11]), cvt_pk_bf16(p0[12], p0[13]), cvt_pk_bf16(p0[14], p0[15])};
            pw[2] = (u32x4){cvt_pk_bf16(p1[0], p1[1]), cvt_pk_bf16(p1[2], p1[3]), cvt_pk_bf16(p1[4], p1[5]), cvt_pk_bf16(p1[6], p1[7])};
            pw[3] = (u32x4){cvt_pk_bf16(p1[8], p1[9]), cvt_pk_bf16(p1[10], p1[11]), cvt_pk_bf16(p1[12], p1[13]), cvt_pk_bf16(p1[14], p1[15])};
            const LAS unsigned char* vp = slot + L_V + ((lane >> 4) & 1) * 32 + (lane & 3) * 8 + (4 * hi + ((lane & 15) >> 2)) * 64;
#pragma unroll
            for (int d0 = 0; d0 < 2; ++d0)
#pragma unroll
                for (int ks = 0; ks < 4; ++ks) { const s16x4 lo = vtr(vp + d0 * 4096 + ks * 1024), hh = vtr(vp + d0 * 4096 + ks * 1024 + 512);
                    const bf16x8 vf = {lo[0], lo[1], lo[2], lo[3], hh[0], hh[1], hh[2], hh[3]};
                    o[d0] = __builtin_amdgcn_mfma_f32_32x32x16_bf16(__builtin_bit_cast(bf16x8, pw[ks]), vf, o[d0], 0, 0, 0); }
        }
        if (KIND == 1) { if (lane == 0) flags[(it & 1) * 8 + wid] = mydone ? 1u : 0u; }
    }
#undef ATT_DMA
    float inv = 1.0f;
    if (KIND == 0) { float a, c; swap_halves(lrun, a, c); inv = 1.0f / (a + c); }
    if (hi == 0) wsf[32 + r32] = inv;
    asm volatile("s_waitcnt lgkmcnt(0)" ::: "memory");
    LAS bf16_t* stg = (LAS bf16_t*)(lds + L_OST) + wid * 2048;
#pragma unroll
    for (int r = 0; r < 16; ++r) { const int orow = crow(r, hi); const float rl = wsf[32 + orow];
        const unsigned w = cvt_pk_bf16(o[0][r] * rl, o[1][r] * rl);
        stg[orow * 64 + r32] = (bf16_t)(w & 0xffffu); stg[orow * 64 + 32 + r32] = (bf16_t)(w >> 16); }
    asm volatile("s_waitcnt lgkmcnt(0)" ::: "memory");
    bf16_t* Ow = O + (rowbase + qw) * OPITCH + KIND * 512 + h * HD;
#pragma unroll
    for (int i = 0; i < 4; ++i) { const int row = i * 8 + (lane >> 3), ch = lane & 7; const u32x4 v = *(const LAS u32x4*)(stg + row * 64 + ch * 8); *(u32x4*)(Ow + (size_t)row * OPITCH + ch * 8) = v; }
    asm volatile("s_waitcnt vmcnt(0) lgkmcnt(0)" ::: "memory");
    __builtin_amdgcn_s_barrier(); asm volatile("" ::: "memory");
}
}

#define XB_TMO      128
#define XB_XCNT(j)  (256  + 64 * (j))
#define XB_XSUB(j)  (1280 + 64 * (j))
#define XB_XGEN(j)  (2304 + 64 * (j))
#define XB_TOP      3328
#define XB_TOPGEN   3392
#define XCD_BAR_WORDS 3456
#define XB_SPIN_CAP (1u << 18)
__device__ __forceinline__ unsigned xb_ld(unsigned* p)              { return __hip_atomic_load(p, __ATOMIC_RELAXED, __HIP_MEMORY_SCOPE_AGENT); }
__device__ __forceinline__ unsigned xb_add(unsigned* p, unsigned v) { return __hip_atomic_fetch_add(p, v, __ATOMIC_RELAXED, __HIP_MEMORY_SCOPE_AGENT); }
__device__ __forceinline__ unsigned xb_xcc_id() { return (unsigned)__builtin_amdgcn_s_getreg((3 << 11) | 20) & 0xFu; }
#define XB_SPIN(cond, bar) do { unsigned _sp = 0; while (cond) { __builtin_amdgcn_s_sleep(1); \
    if ((++_sp & 255u) == 0u) { if (xb_ld(&(bar)[XB_TMO])) break; if (_sp > XB_SPIN_CAP) { atomicAdd(&(bar)[XB_TMO], 1u); break; } } } } while (0)
struct XcdBarrier { unsigned* bar; unsigned x; volatile LAS unsigned* st; };
__device__ __forceinline__ XcdBarrier xcd_barrier_post(unsigned* bar, volatile LAS unsigned* st) {
    XcdBarrier b; b.bar = bar; b.x = xb_xcc_id(); b.st = st;
    if (threadIdx.x == 0) (void)xb_add(&bar[XB_XCNT(b.x)], 1u);
    return b;
}
__device__ __forceinline__ void xcd_barrier_complete(unsigned* bar, unsigned x, unsigned& nloc, unsigned& nx) {
    const unsigned G = gridDim.x * gridDim.y * gridDim.z;
    unsigned sum, cnt, mine, sp = 0u;
    for (;;) {
        sum = 0u; cnt = 0u; mine = 0u;
#pragma unroll
        for (unsigned j = 0; j < 16; ++j) { const unsigned c = xb_ld(&bar[XB_XCNT(j)]); sum += c; cnt += (c > 0u) ? 1u : 0u; mine = (j == x) ? c : mine; }
        if (sum == G) break;
        __builtin_amdgcn_s_sleep(1);
        if ((++sp & 255u) == 0u) { if (xb_ld(&bar[XB_TMO])) break; if (sp > XB_SPIN_CAP) { atomicAdd(&bar[XB_TMO], 1u); break; } }
    }
    nloc = mine > 0u ? mine : 1u; nx = cnt > 0u ? cnt : 1u;
}
__device__ __forceinline__ void xcd_barrier(const XcdBarrier& b) {
    asm volatile("s_waitcnt vmcnt(0)" ::: "memory");
    __syncthreads();
    if (threadIdx.x == 0) {
        unsigned* bar = b.bar;
        __builtin_amdgcn_s_waitcnt(0);
        unsigned nloc = b.st[0], nx = b.st[1];
        if (nloc == 0u) { xcd_barrier_complete(bar, b.x, nloc, nx); b.st[0] = nloc; b.st[1] = nx; }
        const unsigned old = xb_add(&bar[XB_XSUB(b.x)], 1u);
        const unsigned gen = old / nloc;
        if (old + 1u == (gen + 1u) * nloc) {
            __builtin_amdgcn_fence(__ATOMIC_RELEASE, "agent");
            asm volatile("s_waitcnt vmcnt(0)" ::: "memory");
            const unsigned og = xb_add(&bar[XB_TOP], 1u);
            const unsigned tg = og / nx;
            if (og + 1u == (tg + 1u) * nx) xb_add(&bar[XB_TOPGEN], 1u);
            else XB_SPIN(xb_ld(&bar[XB_TOPGEN]) == tg, bar);
            __builtin_amdgcn_fence(__ATOMIC_ACQUIRE, "agent");
            xb_add(&bar[XB_XGEN(b.x)], 1u);
            asm volatile("s_waitcnt vmcnt(0)" ::: "memory");
        } else {
            XB_SPIN(xb_ld(&bar[XB_XGEN(b.x)]) == gen, bar);
            __builtin_amdgcn_fence(__ATOMIC_ACQUIRE, "agent");
            asm volatile("s_waitcnt vmcnt(0)" ::: "memory");
        }
    }
    __syncthreads();
}

constexpr int NWAVES = 8;
constexpr int RING_BYTES = 131072, LDS_BYTES = 147456;
static_assert(att::L_END <= RING_BYTES, "attention scratch fits the ring region");

__device__ __forceinline__ float wave_sum(float v) {
#pragma unroll
    for (int o = 1; o < 64; o <<= 1) v += __shfl_xor(v, o);
    return v;
}
__device__ __forceinline__ void tr_item(const float* W, int ldw, int col0, int K, bf16_t* WT, int row_off, LAS float* scr, int kb, int nb, int lane, const float* gs) {
    const int k0 = 64 * kb, n0 = 32 * nb;
#pragma unroll 8
    for (int i = 0; i < 32; ++i) { const int kk = 2 * i + (lane >> 5); scr[kk * 33 + (lane & 31)] = W[(size_t)(k0 + kk) * ldw + col0 + n0 + (lane & 31)] * (gs ? gs[k0 + kk] : 1.0f); }
    asm volatile("s_waitcnt lgkmcnt(0)" ::: "memory");
    const int c = lane & 7;
#pragma unroll
    for (int j = 0; j < 4; ++j) { const int n = (lane >> 3) + 8 * j; const LAS float* s = scr + (8 * c) * 33 + n;
        u32x4 o; o.x = cvt_pk_bf16(s[0 * 33], s[1 * 33]); o.y = cvt_pk_bf16(s[2 * 33], s[3 * 33]); o.z = cvt_pk_bf16(s[4 * 33], s[5 * 33]); o.w = cvt_pk_bf16(s[6 * 33], s[7 * 33]);
        *(u32x4*)(WT + (size_t)(row_off + n0 + n) * K + k0 + 8 * c) = o; }
    asm volatile("s_waitcnt lgkmcnt(0)" ::: "memory");
}

struct Args { const float* in[16]; float* out; unsigned char* ws; int ph_lo, ph_hi; };

__global__ void __launch_bounds__(NWAVES * 64, 2) fwd_megakernel(Args args) {
    __builtin_assume(__builtin_amdgcn_workitem_id_y() == 0); __builtin_assume(__builtin_amdgcn_workitem_id_z() == 0);
    extern __shared__ __attribute__((aligned(16))) unsigned char lds_raw[];
    LAS unsigned char* lds = (LAS unsigned char*)lds_raw;
    const int tid = threadIdx.x, lane = tid & 63, wave = __builtin_amdgcn_readfirstlane(tid >> 6);
    const int G = gridDim.x, bx = blockIdx.x, vcu = (G % 8 == 0) ? (bx % 8) * (G / 8) + bx / 8 : bx;
    const int gw = vcu * NWAVES + wave, NGW = G * NWAVES;
    unsigned char* ws = args.ws;
    const float* x = args.in[0]; const float* p_in = args.in[1]; const float* g_mix = args.in[2]; const float* w_in = args.in[3]; const float* b_forget = args.in[4]; const float* b_gate = args.in[5];
    const float* w_bf = args.in[6]; const float* w_bs = args.in[7]; const float* w_out = args.in[8]; const float* g_mlp = args.in[9]; const float* w_up = args.in[10]; const float* w_dn = args.in[11];
    const float* g_ple = args.in[12]; const float* w_pg = args.in[13]; const float* w_ple = args.in[14]; const float* g_final = args.in[15];
    float* out = args.out;
    bf16_t* Win_t = (bf16_t*)(ws + WS_WIN); bf16_t* Wbf_t = (bf16_t*)(ws + WS_WBF); bf16_t* Wbs_t = (bf16_t*)(ws + WS_WBS); bf16_t* Wout_t = (bf16_t*)(ws + WS_WOUT);
    bf16_t* Wup_t = (bf16_t*)(ws + WS_WUP); bf16_t* Wdn_t = (bf16_t*)(ws + WS_WDN); bf16_t* Wpg_t = (bf16_t*)(ws + WS_WPG); bf16_t* Wple_t = (bf16_t*)(ws + WS_WPLE);
    float* LOGF = (float*)(ws + WS_LOGF); float* CC = (float*)(ws + WS_CC); float* SSQ1 = (float*)(ws + WS_SSQ1); float* SSQ2 = (float*)(ws + WS_SSQ2);
    bf16_t* PB = (bf16_t*)(ws + WS_PB); bf16_t* BUFA = (bf16_t*)(ws + WS_BUFA); bf16_t* BUFB = (bf16_t*)(ws + WS_BUFB); bf16_t* QKV = (bf16_t*)(ws + WS_QKV); bf16_t* SG = (bf16_t*)(ws + WS_SG);
    bf16_t* HB = (bf16_t*)(ws + WS_H); bf16_t* EB = (bf16_t*)(ws + WS_E);
    const int lo = args.ph_lo, hi = args.ph_hi;
#define IN(k) (lo <= (k) && (k) < hi)
    volatile LAS unsigned* bst = (volatile LAS unsigned*)(lds + RING_BYTES);
    if (tid < 2) bst[tid] = 0u;
    __syncthreads();
    XcdBarrier xbar; xbar.bar = (unsigned*)ws; xbar.x = 0; xbar.st = bst;
    if (hi - lo > 1) xbar = xcd_barrier_post((unsigned*)ws, bst);
#define SEAM(k) do { if (IN(k) && IN((k) + 1)) { if ((k) == 0) cg::this_grid().sync(); else xcd_barrier(xbar); } } while (0)

    if (IN(0)) {
        LAS float* scr = (LAS float*)(lds + wave * 16384);
        {
            constexpr int NSEG = 9;
            int base = 0;
            for (int it = gw; ; it += NGW) {
                int r = it; const float* W; int ldw, col0, K, nblk, row_off; bf16_t* WT; const float* gs = nullptr;
                if (r < 16 * 48) { W = w_in; ldw = NIN_SRC; col0 = 0; K = DM; nblk = 48; WT = Win_t; row_off = 0; }
                else if ((r -= 16 * 48) < 16 * 112) { W = w_in; ldw = NIN_SRC; col0 = 1544; K = DM; nblk = 112; WT = Win_t; row_off = 1536; }
                else if ((r -= 16 * 112) < 8 * 32) { W = w_bf; ldw = DM; col0 = 0; K = 512; nblk = 32; WT = Wbf_t; row_off = 0; }
                else if ((r -= 8 * 32) < 8 * 32) { W = w_bs; ldw = DM; col0 = 0; K = 512; nblk = 32; WT = Wbs_t; row_off = 0; }
                else if ((r -= 8 * 32) < 16 * 32) { W = w_out; ldw = DM; col0 = 0; K = DM; nblk = 32; WT = Wout_t; row_off = 0; }
                else if ((r -= 16 * 32) < 16 * 128) { W = w_up; ldw = DFF; col0 = 0; K = DM; nblk = 128; WT = Wup_t; row_off = 0; gs = g_mlp; }
                else if ((r -= 16 * 128) < 64 * 32) { W = w_dn; ldw = DM; col0 = 0; K = DFF; nblk = 32; WT = Wdn_t; row_off = 0; }
                else if ((r -= 64 * 32) < 16 * 32) { W = w_pg; ldw = DM; col0 = 0; K = DM; nblk = 32; WT = Wpg_t; row_off = 0; gs = g_ple; }
                else if ((r -= 16 * 32) < 4 * 32) { W = w_ple; ldw = DM; col0 = 0; K = DPLE; nblk = 32; WT = Wple_t; row_off = 0; }
                else break;
                tr_item(W, ldw, col0, K, WT, row_off, scr, r / nblk, r % nblk, lane, gs);
                (void)base; (void)NSEG;
            }
        }
        {
            f32x4 gm[4]; f32x4 wf[4][4][2];
#pragma unroll
            for (int j = 0; j < 4; ++j) { gm[j] = *((const f32x4*)g_mix + lane + 64 * j);
#pragma unroll
                for (int e = 0; e < 4; ++e) { const float* wp = w_in + (size_t)(4 * lane + 256 * j + e) * NIN_SRC + 1536; wf[j][e][0] = *(const f32x4*)wp * gm[j][e]; wf[j][e][1] = *(const f32x4*)(wp + 4) * gm[j][e]; } }
            const float bfv = b_forget[lane & 7];
            for (int m = gw; m < M; m += NGW) {
                const f32x4* xr = (const f32x4*)(x + (size_t)m * DM) + lane;
                f32x4 v[4]; float s = 0.f;
#pragma unroll
                for (int j = 0; j < 4; ++j) { v[j] = xr[64 * j]; s += (v[j][0] * v[j][0] + v[j][1] * v[j][1]) + (v[j][2] * v[j][2] + v[j][3] * v[j][3]); }
                const float rstd = __builtin_amdgcn_rsqf(wave_sum(s) * (1.0f / DM) + EPS);
                f32x4 f0 = {0.f, 0.f, 0.f, 0.f}, f1 = {0.f, 0.f, 0.f, 0.f};
#pragma unroll
                for (int j = 0; j < 4; ++j)
#pragma unroll
                    for (int e = 0; e < 4; ++e) { f0 += wf[j][e][0] * v[j][e]; f1 += wf[j][e][1] * v[j][e]; }
                unsigned long long* o8 = (unsigned long long*)(BUFA + (size_t)m * DM) + lane;
#pragma unroll
                for (int j = 0; j < 4; ++j) { const f32x4 y = v[j] * gm[j] * rstd; o8[64 * j] = (unsigned long long)cvt_pk_bf16(y[0], y[1]) | ((unsigned long long)cvt_pk_bf16(y[2], y[3]) << 32); }
                float fl[8];
#pragma unroll
                for (int e = 0; e < 4; ++e) { fl[e] = wave_sum(f0[e]); fl[4 + e] = wave_sum(f1[e]); }
                float mine = fl[0];
#pragma unroll
                for (int e = 1; e < 8; ++e) mine = ((lane & 7) == e) ? fl[e] : mine;
                const float y2 = (mine * rstd + bfv) * LOG2E;
                const float lf = -(fmaxf(-y2, 0.f) + __builtin_amdgcn_logf(1.0f + __builtin_amdgcn_exp2f(-fabsf(y2))));
                if (lane < 8) LOGF[(size_t)((m / SEQ) * NH + lane) * SEQ + (m % SEQ)] = lf;
            }
        }
        {
            const size_t n8 = (size_t)M * DPLE / 8;
            for (size_t i = (size_t)bx * 512 + tid; i < n8; i += (size_t)G * 512) { const f32x4 a = *((const f32x4*)p_in + 2 * i), c = *((const f32x4*)p_in + 2 * i + 1);
                u32x4 w; w.x = cvt_pk_bf16(a[0], a[1]); w.y = cvt_pk_bf16(a[2], a[3]); w.z = cvt_pk_bf16(c[0], c[1]); w.w = cvt_pk_bf16(c[2], c[3]); *((u32x4*)PB + i) = w; }
        }
    }
    SEAM(0);

    if (IN(1)) {
        if (gw < BATCH * NH) {
            const float* src = LOGF + (size_t)gw * SEQ + lane * 32; float* dst = CC + (size_t)gw * SEQ + lane * 32;
            f32x4 v[8]; float run = 0.f;
#pragma unroll
            for (int j = 0; j < 8; ++j) { v[j] = *((const f32x4*)src + j);
#pragma unroll
                for (int e = 0; e < 4; ++e) { run += v[j][e]; v[j][e] = run; } }
            float incl = run;
#pragma unroll
            for (int o = 1; o < 64; o <<= 1) { const float tv = __shfl_up(incl, o); if (lane >= o) incl += tv; }
            const float excl = incl - run;
#pragma unroll
            for (int j = 0; j < 8; ++j) *((f32x4*)dst + j) = v[j] + excl;
        }
        pg8::Gemm g{DM, DM, DM};
        pg8::PlainSched S; S.T.init(M, NIN, G, bx); S.A = (const char*)BUFA; S.B = (const char*)Win_t; S.astep = (size_t)256 * DM * 2; S.bstep = (size_t)256 * DM * 2;
        pg8::EpiQKVG E{QKV, SG, b_gate};
        pg8::gemm_phase<pg8::EpiQKVG, pg8::PlainSched>(lds, g, S, E);
    }
    SEAM(1);

    if (IN(2)) {
        for (int i = 0; i < 8; ++i) {
            const int j = i & 3, kind = i >> 2;
            for (int bh = (vcu >> 1); bh < BATCH * NH; bh += (G >> 1)) {
                const int s = (vcu & 1) * 2 + (j >> 1); const int qb = (j & 1) ? 7 - s : s;
                if (kind == 0) att::attn_unit<0>(bh / NH, bh % NH, qb, QKV, CC, BUFB, lds);
                else att::attn_unit<1>(bh / NH, bh % NH, qb, QKV, CC, BUFB, lds);
            }
        }
    }
    SEAM(2);

    if (IN(3)) {
        pg8::Gemm g{DM, 512, 512};
        pg8::PairSched S; S.T.init(M, DM, G, bx); S.A0 = (const char*)BUFB; S.A1 = (const char*)(BUFB + 512); S.B0 = (const char*)Wbf_t; S.B1 = (const char*)Wbs_t; S.astep = (size_t)256 * DM * 2; S.bstep = (size_t)256 * 512 * 2;
        pg8::EpiBranch E{SG, BUFA};
        pg8::gemm_phase<pg8::EpiBranch, pg8::PairSched>(lds, g, S, E);
    }
    SEAM(3);

    if (IN(4)) {
        {
            pg8::Gemm g{DM, DM, DM};
            pg8::PlainSched S; S.T.init(M, DM, G, bx); S.A = (const char*)BUFA; S.B = (const char*)Wout_t; S.astep = (size_t)256 * DM * 2; S.bstep = (size_t)256 * DM * 2;
            pg8::EpiRes4 E{x, BUFB, SSQ1};
            pg8::gemm_phase<pg8::EpiRes4, pg8::PlainSched>(lds, g, S, E);
        }
        {
            pg8::Gemm g{DPLE, DPLE, DPLE};
            pg8::PlainSched S; S.T.init(M, DM, G, bx); S.A = (const char*)PB; S.B = (const char*)Wple_t; S.astep = (size_t)256 * DPLE * 2; S.bstep = (size_t)256 * DPLE * 2;
            pg8::EpiBf16 E{EB, DM};
            pg8::gemm_phase<pg8::EpiBf16, pg8::PlainSched>(lds, g, S, E);
        }
    }
    SEAM(4);

    if (IN(5)) {
        pg8::Gemm g{DM, DM, DM};
        pg8::PlainSched S; S.T.init(M, DFF, G, bx); S.A = (const char*)BUFB; S.B = (const char*)Wup_t; S.astep = (size_t)256 * DM * 2; S.bstep = (size_t)256 * DM * 2;
        pg8::EpiUp E{HB, SSQ1};
        pg8::gemm_phase<pg8::EpiUp, pg8::PlainSched>(lds, g, S, E);
    }
    SEAM(5);

    if (IN(6)) {
        pg8::Gemm g{DFF, DFF, DFF};
        pg8::PlainSched S; S.T.init(M, DM, G, bx); S.A = (const char*)HB; S.B = (const char*)Wdn_t; S.astep = (size_t)256 * DFF * 2; S.bstep = (size_t)256 * DFF * 2;
        pg8::EpiRes6 E{BUFB, BUFA, SSQ2};
        pg8::gemm_phase<pg8::EpiRes6, pg8::PlainSched>(lds, g, S, E);
    }
    SEAM(6);

    if (IN(7)) {
        pg8::Gemm g{DM, DM, DM};
        pg8::PlainSched S; S.T.init(M, DM, G, bx); S.A = (const char*)BUFA; S.B = (const char*)Wpg_t; S.astep = (size_t)256 * DM * 2; S.bstep = (size_t)256 * DM * 2;
        pg8::EpiPle E{BUFA, BUFB, EB, SSQ2};
        pg8::gemm_phase<pg8::EpiPle, pg8::PlainSched>(lds, g, S, E);
    }
    SEAM(7);

    if (IN(8)) {
        f32x4 gf[4];
#pragma unroll
        for (int j = 0; j < 2; ++j) { gf[2 * j] = *((const f32x4*)g_final + 2 * lane + 128 * j); gf[2 * j + 1] = *((const f32x4*)g_final + 2 * lane + 128 * j + 1); }
        for (int m = gw; m < M; m += 2 * NGW) {
            u32x4 w[2][2];
#pragma unroll
            for (int q = 0; q < 2; ++q)
#pragma unroll
                for (int j = 0; j < 2; ++j) w[q][j] = *((const u32x4*)(BUFB + (size_t)(m + q * NGW) * DM) + lane + 64 * j);
#pragma unroll
            for (int q = 0; q < 2; ++q) {
                f32x4 v[4]; float s = 0.f;
#pragma unroll
                for (int j = 0; j < 2; ++j) { v[2 * j] = pg8::bf4_lo(w[q][j]); v[2 * j + 1] = pg8::bf4_hi(w[q][j]); }
#pragma unroll
                for (int j = 0; j < 4; ++j) s += (v[j][0] * v[j][0] + v[j][1] * v[j][1]) + (v[j][2] * v[j][2] + v[j][3] * v[j][3]);
                const float rstd = __builtin_amdgcn_rsqf(wave_sum(s) * (1.0f / DM) + EPS);
                f32x4* orow = (f32x4*)(out + (size_t)(m + q * NGW) * DM);
#pragma unroll
                for (int j = 0; j < 2; ++j) { orow[2 * lane + 128 * j] = v[2 * j] * gf[2 * j] * rstd; orow[2 * lane + 128 * j + 1] = v[2 * j + 1] * gf[2 * j + 1] * rstd; }
            }
        }
    }
#undef IN
#undef SEAM
}

extern "C" void kernel_launch(void* const* d_in, const int* in_sizes, int n_in, void* d_out, int out_size, void* d_ws, size_t ws_size, hipStream_t stream) {
    static int grid = 0;
    if (grid == 0) {
        if (n_in != 16 || in_sizes[0] != M * DM || out_size != M * DM || ws_size < WS_END) { fprintf(stderr, "kernel_launch: unexpected shapes (n_in %d, in0 %d, out %d, ws %zu); nothing launched\n", n_in, n_in > 0 ? in_sizes[0] : -1, out_size, ws_size); grid = -1; return; }
        int dev = 0, cus = 0, per_cu = 0;
        if (hipGetDevice(&dev) != hipSuccess || hipDeviceGetAttribute(&cus, hipDeviceAttributeMultiprocessorCount, dev) != hipSuccess) { grid = -1; return; }
        if (hipFuncSetAttribute((const void*)fwd_megakernel, hipFuncAttributeMaxDynamicSharedMemorySize, LDS_BYTES) != hipSuccess) { fprintf(stderr, "kernel_launch: hipFuncSetAttribute failed\n"); grid = -1; return; }
        if (hipOccupancyMaxActiveBlocksPerMultiprocessor(&per_cu, (const void*)fwd_megakernel, NWAVES * 64, LDS_BYTES) != hipSuccess || per_cu < 1) { fprintf(stderr, "kernel_launch: occupancy query says %d\n", per_cu); per_cu = 1; }
        (void)hipGetLastError();
        grid = cus;
        if (grid != 256) fprintf(stderr, "kernel_launch: %d CUs; built for 256\n", grid);
    }
    if (grid < 0) return;
    if (hipMemsetAsync(d_ws, 0, 16384, stream) != hipSuccess) { fprintf(stderr, "kernel_launch: memset failed\n"); return; }
    Args a{};
    for (int i = 0; i < 16; ++i) a.in[i] = (const float*)d_in[i];
    a.out = (float*)d_out; a.ws = (unsigned char*)d_ws;
#if MK_N_LAUNCHES == 1
    a.ph_lo = 0; a.ph_hi = N_PHASES;
    void* kargs[] = {&a};
    hipError_t e = hipLaunchCooperativeKernel((const void*)fwd_megakernel, dim3(grid), dim3(NWAVES * 64), kargs, LDS_BYTES, stream);
    if (e != hipSuccess) fprintf(stderr, "kernel_launch: cooperative launch failed: %s (grid %d)\n", hipGetErrorString(e), grid);
#else
    for (int li = 0; li < N_PHASES; ++li) { a.ph_lo = li; a.ph_hi = li + 1; hipLaunchKernelGGL(fwd_megakernel, dim3(grid), dim3(NWAVES * 64), LDS_BYTES, stream, a); }
#endif
}
```

```cpp
#include <hip/hip_runtime.h>
#include <hip/hip_cooperative_groups.h>
#include <cstdio>
#include <cstdint>
namespace cg = cooperative_groups;

#ifndef MK_N_LAUNCHES
#define MK_N_LAUNCHES 1
#endif
constexpr int N_PHASES = 9;

#define LAS __attribute__((address_space(3)))
typedef unsigned short bf16_t;
typedef short bf16x8 __attribute__((ext_vector_type(8)));
typedef short s16x4 __attribute__((ext_vector_type(4)));
typedef float f32x4 __attribute__((ext_vector_type(4)));
typedef float f32x2 __attribute__((ext_vector_type(2)));
typedef float f32x16 __attribute__((ext_vector_type(16)));
typedef unsigned u32x4 __attribute__((ext_vector_type(4)));
typedef unsigned u32x2 __attribute__((ext_vector_type(2)));
typedef __bf16 bf16x2_t __attribute__((ext_vector_type(2)));

constexpr int BATCH = 16, SEQ = 2048, DM = 1024, M = BATCH * SEQ, NH = 8, HD = 64, DFF = 4096, DPLE = 256;
constexpr int NIN_SRC = 5128, NQKV = 3072, NGATE = 2048, NIN = NQKV + NGATE;
constexpr float EPS = 1e-6f;
constexpr float LOG2E = 1.4426950408889634f;
constexpr float C2 = 0.125f * LOG2E;

constexpr size_t MiB = 1u << 20;
constexpr size_t WS_WIN = 2 * MiB, WS_WBF = 12 * MiB, WS_WBS = 13 * MiB, WS_WOUT = 14 * MiB, WS_WUP = 16 * MiB, WS_WDN = 24 * MiB, WS_WPG = 32 * MiB, WS_WPLE = 34 * MiB;
constexpr size_t WS_LOGF = 36 * MiB, WS_CC = 37 * MiB, WS_SSQ1 = 38 * MiB, WS_SSQ2 = 40 * MiB;
constexpr size_t WS_PB = 42 * MiB, WS_BUFA = 58 * MiB, WS_BUFB = 122 * MiB, WS_QKV = 186 * MiB, WS_SG = 378 * MiB, WS_H = 186 * MiB, WS_E = 442 * MiB, WS_END = 506 * MiB;

__device__ __forceinline__ unsigned cvt_pk_bf16(float lo, float hi) { f32x2 v = {lo, hi}; bf16x2_t b = __builtin_convertvector(v, bf16x2_t); return __builtin_bit_cast(unsigned, b); }
__device__ __forceinline__ float bf_lo(unsigned w) { return __uint_as_float(w << 16); }
__device__ __forceinline__ float bf_hi(unsigned w) { return __uint_as_float(w & 0xffff0000u); }
__device__ __forceinline__ float fast_sigmoid(float v) { return __builtin_amdgcn_rcpf(1.0f + __builtin_amdgcn_exp2f(-v * LOG2E)); }

__device__ __forceinline__ const char* uni_ptr(const char* p) { const unsigned long long v = (unsigned long long)p; const unsigned lo = __builtin_amdgcn_readfirstlane((unsigned)v), hi = __builtin_amdgcn_readfirstlane((unsigned)(v >> 32)); return (const char*)(((unsigned long long)hi << 32) | lo); }
namespace pg8 {
constexpr int BM = 256, BK = 64, HALF = 128, HTB = HALF * BK * 2, STAGE_BYTES = 8 * HTB, NXCD = 8, WGM = 8;
__host__ __device__ __forceinline__ int lds_byte(int r, int c) { const int st = (r >> 4) * 2 + (c >> 5), rr = r & 15, cc = c & 31, ob = rr * 64 + cc * 2; return st * 1024 + (ob ^ (((ob >> 9) & 1) << 5)); }
__host__ __device__ __forceinline__ void stage_rc(int b, int& R, int& C) { const int st = b / 1024, sb = b % 1024, swz = sb ^ (((sb >> 9) & 1) << 5); R = (st >> 1) * 16 + swz / 64; C = (st & 1) * 32 + (swz % 64) / 2; }
__host__ __device__ __forceinline__ int perm32(int rho) { const int n = rho >> 4, i = rho & 15; return 8 * (i >> 2) + 4 * n + (i & 3); }

struct Unit { int pm, pn; const char* A; const char* B; int chain; };
struct Gemm { int lda, ldb, K; };

struct TileOrder {
    int nM, nN, nwg, G, c;
    __device__ void init(int Mrows, int N, int G_, int c_) { nM = Mrows / BM; nN = N / BM; nwg = nM * nN; G = G_; c = c_; }
    __device__ bool tile(int i, int& pm, int& pn) const {
        const long L = (long)i * G + c; if (L >= nwg) return false;
        int wgid = (int)L; { const int q = nwg / NXCD, r = nwg % NXCD, xcd = wgid % NXCD, off = wgid / NXCD; wgid = (xcd < r ? xcd * (q + 1) : r * (q + 1) + (xcd - r) * q) + off; }
        const int nig = WGM * nN, gid = wgid / nig, fm = gid * WGM, gsz = (nM - fm) < WGM ? (nM - fm) : WGM;
        pm = fm + ((wgid % nig) % gsz); pn = (wgid % nig) / gsz; return true;
    }
};
struct PlainSched {
    TileOrder T; const char* A; const char* B; size_t astep, bstep;
    __device__ bool next(int i, Unit& u) const { int pm, pn; if (!T.tile(i, pm, pn)) return false; u.pm = pm; u.pn = pn; u.A = A + (size_t)pm * astep; u.B = B + (size_t)pn * bstep; u.chain = 0; return true; }
};
struct PairSched {
    TileOrder T; const char* A0; const char* A1; const char* B0; const char* B1; size_t astep, bstep;
    __device__ bool next(int i, Unit& u) const { int pm, pn; if (!T.tile(i >> 1, pm, pn)) return false; const int s = i & 1; u.pm = pm; u.pn = pn;
        u.A = (s ? A1 : A0) + (size_t)pm * astep; u.B = (s ? B1 : B0) + (size_t)pn * bstep; u.chain = s ? 0 : 1; return true; }
};

typedef f32x4 Acc[2][2][4][2];

struct EpiQKVG {
    static constexpr bool PERM = true;
    bf16_t* QKV; bf16_t* SG; const float* bgate;
    __device__ __forceinline__ void operator()(Acc& acc, const Unit& u, int wr, int wc, int fr, int fq, LAS float* tab, int tid) const {
        const int row0 = u.pm * BM + wr * 64 + fr;
        if (u.pn < 12) {
            const float sc = (u.pn < 2 || (u.pn >= 6 && u.pn < 8)) ? C2 : 1.0f;
            const int col0 = u.pn * BM + wc * 32 + 8 * fq;
#pragma unroll
            for (int ai = 0; ai < 2; ++ai)
#pragma unroll
                for (int m = 0; m < 4; ++m) { bf16_t* rowp = QKV + (size_t)(row0 + ai * HALF + m * 16) * NQKV + col0;
#pragma unroll
                    for (int bj = 0; bj < 2; ++bj) { const f32x4 v0 = acc[ai][bj][m][0] * sc, v1 = acc[ai][bj][m][1] * sc;
                        u32x4 w; w.x = cvt_pk_bf16(v0[0], v0[1]); w.y = cvt_pk_bf16(v0[2], v0[3]); w.z = cvt_pk_bf16(v1[0], v1[1]); w.w = cvt_pk_bf16(v1[2], v1[3]);
                        *(u32x4*)(rowp + bj * HALF) = w; } }
        } else {
            const int col0 = (u.pn - 12) * BM + wc * 32 + 8 * fq;
            f32x4 bv[2][2];
#pragma unroll
            for (int bj = 0; bj < 2; ++bj)
#pragma unroll
                for (int n = 0; n < 2; ++n) bv[bj][n] = *(const f32x4*)(bgate + col0 + bj * HALF + 4 * n);
#pragma unroll
            for (int ai = 0; ai < 2; ++ai)
#pragma unroll
                for (int m = 0; m < 4; ++m) { bf16_t* rowp = SG + (size_t)(row0 + ai * HALF + m * 16) * NGATE + col0;
#pragma unroll
                    for (int bj = 0; bj < 2; ++bj) { const f32x4 a0 = acc[ai][bj][m][0] + bv[bj][0], a1 = acc[ai][bj][m][1] + bv[bj][1];
                        u32x4 w; w.x = cvt_pk_bf16(fast_sigmoid(a0[0]), fast_sigmoid(a0[1])); w.y = cvt_pk_bf16(fast_sigmoid(a0[2]), fast_sigmoid(a0[3]));
                        w.z = cvt_pk_bf16(fast_sigmoid(a1[0]), fast_sigmoid(a1[1])); w.w = cvt_pk_bf16(fast_sigmoid(a1[2]), fast_sigmoid(a1[3]));
                        *(u32x4*)(rowp + bj * HALF) = w; } }
        }
    }
};
struct EpiBf16 {
    static constexpr bool PERM = true;
    bf16_t* O; int ldc;
    __device__ __forceinline__ void operator()(Acc& acc, const Unit& u, int wr, int wc, int fr, int fq, LAS float* tab, int tid) const {
        const int row0 = u.pm * BM + wr * 64 + fr, col0 = u.pn * BM + wc * 32 + 8 * fq;
#pragma unroll
        for (int ai = 0; ai < 2; ++ai)
#pragma unroll
            for (int m = 0; m < 4; ++m) { bf16_t* rowp = O + (size_t)(row0 + ai * HALF + m * 16) * ldc + col0;
#pragma unroll
                for (int bj = 0; bj < 2; ++bj) { const f32x4 v0 = acc[ai][bj][m][0], v1 = acc[ai][bj][m][1];
                    u32x4 w; w.x = cvt_pk_bf16(v0[0], v0[1]); w.y = cvt_pk_bf16(v0[2], v0[3]); w.z = cvt_pk_bf16(v1[0], v1[1]); w.w = cvt_pk_bf16(v1[2], v1[3]);
                    *(u32x4*)(rowp + bj * HALF) = w; } }
    }
};
__device__ __forceinline__ f32x4 bf4_lo(const u32x4 w) { return (f32x4){bf_lo(w.x), bf_hi(w.x), bf_lo(w.y), bf_hi(w.y)}; }
__device__ __forceinline__ f32x4 bf4_hi(const u32x4 w) { return (f32x4){bf_lo(w.z), bf_hi(w.z), bf_lo(w.w), bf_hi(w.w)}; }
__device__ __forceinline__ u32x4 pack8(const f32x4 v0, const f32x4 v1) { u32x4 w; w.x = cvt_pk_bf16(v0[0], v0[1]); w.y = cvt_pk_bf16(v0[2], v0[3]); w.z = cvt_pk_bf16(v1[0], v1[1]); w.w = cvt_pk_bf16(v1[2], v1[3]); return w; }
struct EpiBranch {
    static constexpr bool PERM = true;
    const bf16_t* SG; bf16_t* MG;
    __device__ __forceinline__ void operator()(Acc& acc, const Unit& u, int wr, int wc, int fr, int fq, LAS float* tab, int tid) const {
        const int row0 = u.pm * BM + wr * 64 + fr, col0 = u.pn * BM + wc * 32 + 8 * fq;
#pragma unroll
        for (int ai = 0; ai < 2; ++ai) {
            u32x4 ga[4][2], gb[4][2];
#pragma unroll
            for (int m = 0; m < 4; ++m)
#pragma unroll
                for (int bj = 0; bj < 2; ++bj) { const bf16_t* p = SG + (size_t)(row0 + ai * HALF + m * 16) * NGATE + col0 + bj * HALF; gb[m][bj] = *(const u32x4*)(p + DM); if (u.chain) ga[m][bj] = *(const u32x4*)p; }
#pragma unroll
            for (int m = 0; m < 4; ++m)
#pragma unroll
                for (int bj = 0; bj < 2; ++bj) { const f32x4 b0 = bf4_lo(gb[m][bj]), b1 = bf4_hi(gb[m][bj]);
                    if (u.chain) { const f32x4 a0 = bf4_lo(ga[m][bj]), a1 = bf4_hi(ga[m][bj]);
#pragma unroll
                        for (int e = 0; e < 4; ++e) { acc[ai][bj][m][0][e] *= a0[e] * __builtin_amdgcn_rcpf(fmaxf(b0[e], 1e-30f)); acc[ai][bj][m][1][e] *= a1[e] * __builtin_amdgcn_rcpf(fmaxf(b1[e], 1e-30f)); }
                    } else *(u32x4*)(MG + (size_t)(row0 + ai * HALF + m * 16) * DM + col0 + bj * HALF) = pack8(acc[ai][bj][m][0] * b0, acc[ai][bj][m][1] * b1); }
            asm volatile("" ::: "memory");
        }
    }
};
__device__ __forceinline__ void ssq_publish(LAS float* tab, float* ssq, const Unit& u, int tid) {
    asm volatile("s_waitcnt lgkmcnt(0)" ::: "memory"); __builtin_amdgcn_s_barrier(); asm volatile("" ::: "memory");
    if (tid < 256) { const f32x4 t = *(const LAS f32x4*)(tab + tid * 4); ssq[(size_t)(u.pm * BM + tid) * 4 + u.pn] = (t[0] + t[1]) + (t[2] + t[3]); }
}
struct EpiRes4 {
    static constexpr bool PERM = true;
    const float* base; bf16_t* xb; float* ssq;
    __device__ __forceinline__ void operator()(Acc& acc, const Unit& u, int wr, int wc, int fr, int fq, LAS float* tab, int tid) const {
        const int row0 = u.pm * BM + wr * 64 + fr, col0 = u.pn * BM + wc * 32 + 8 * fq;
#pragma unroll
        for (int ai = 0; ai < 2; ++ai) {
            f32x4 bs[4][2][2];
#pragma unroll
            for (int m = 0; m < 4; ++m)
#pragma unroll
                for (int bj = 0; bj < 2; ++bj)
#pragma unroll
                    for (int n = 0; n < 2; ++n) bs[m][bj][n] = *(const f32x4*)(base + (size_t)(row0 + ai * HALF + m * 16) * DM + col0 + bj * HALF + 4 * n);
#pragma unroll
            for (int m = 0; m < 4; ++m) { float s = 0.f;
#pragma unroll
                for (int bj = 0; bj < 2; ++bj) { const f32x4 x0 = bs[m][bj][0] + acc[ai][bj][m][0], x1 = bs[m][bj][1] + acc[ai][bj][m][1];
                    s += ((x0[0] * x0[0] + x0[1] * x0[1]) + (x0[2] * x0[2] + x0[3] * x0[3])) + ((x1[0] * x1[0] + x1[1] * x1[1]) + (x1[2] * x1[2] + x1[3] * x1[3]));
                    *(u32x4*)(xb + (size_t)(row0 + ai * HALF + m * 16) * DM + col0 + bj * HALF) = pack8(x0, x1); }
                s += __shfl_xor(s, 16); s += __shfl_xor(s, 32);
                if (fq == 0) tab[(ai * HALF + wr * 64 + m * 16 + fr) * 4 + wc] = s; }
            asm volatile("" ::: "memory");
        }
        ssq_publish(tab, ssq, u, tid);
    }
};
struct EpiRes6 {
    static constexpr bool PERM = true;
    const bf16_t* xin; bf16_t* xb; float* ssq;
    __device__ __forceinline__ void operator()(Acc& acc, const Unit& u, int wr, int wc, int fr, int fq, LAS float* tab, int tid) const {
        const int row0 = u.pm * BM + wr * 64 + fr, col0 = u.pn * BM + wc * 32 + 8 * fq;
        u32x4 xi[2][4][2];
#pragma unroll
        for (int ai = 0; ai < 2; ++ai)
#pragma unroll
            for (int m = 0; m < 4; ++m)
#pragma unroll
                for (int bj = 0; bj < 2; ++bj) xi[ai][m][bj] = *(const u32x4*)(xin + (size_t)(row0 + ai * HALF + m * 16) * DM + col0 + bj * HALF);
#pragma unroll
        for (int ai = 0; ai < 2; ++ai)
#pragma unroll
            for (int m = 0; m < 4; ++m) { float s = 0.f;
#pragma unroll
                for (int bj = 0; bj < 2; ++bj) { const f32x4 x0 = bf4_lo(xi[ai][m][bj]) + acc[ai][bj][m][0], x1 = bf4_hi(xi[ai][m][bj]) + acc[ai][bj][m][1];
                    s += ((x0[0] * x0[0] + x0[1] * x0[1]) + (x0[2] * x0[2] + x0[3] * x0[3])) + ((x1[0] * x1[0] + x1[1] * x1[1]) + (x1[2] * x1[2] + x1[3] * x1[3]));
                    *(u32x4*)(xb + (size_t)(row0 + ai * HALF + m * 16) * DM + col0 + bj * HALF) = pack8(x0, x1); }
                s += __shfl_xor(s, 16); s += __shfl_xor(s, 32);
                if (fq == 0) tab[(ai * HALF + wr * 64 + m * 16 + fr) * 4 + wc] = s; }
        ssq_publish(tab, ssq, u, tid);
    }
};
__device__ __forceinline__ float rstd_of(const f32x4 q) { return __builtin_amdgcn_rsqf(((q[0] + q[1]) + (q[2] + q[3])) * (1.0f / DM) + EPS); }
struct EpiUp {
    static constexpr bool PERM = true;
    bf16_t* H; const float* ssq;
    __device__ __forceinline__ void operator()(Acc& acc, const Unit& u, int wr, int wc, int fr, int fq, LAS float* tab, int tid) const {
        const int row0 = u.pm * BM + wr * 64 + fr, col0 = u.pn * BM + wc * 32 + 8 * fq;
        f32x4 sq[2][4];
#pragma unroll
        for (int ai = 0; ai < 2; ++ai)
#pragma unroll
            for (int m = 0; m < 4; ++m) sq[ai][m] = *(const f32x4*)(ssq + (size_t)(row0 + ai * HALF + m * 16) * 4);
#pragma unroll
        for (int ai = 0; ai < 2; ++ai)
#pragma unroll
            for (int m = 0; m < 4; ++m) { const float r = rstd_of(sq[ai][m]); bf16_t* rowp = H + (size_t)(row0 + ai * HALF + m * 16) * DFF + col0;
#pragma unroll
                for (int bj = 0; bj < 2; ++bj) { f32x4 v0 = acc[ai][bj][m][0] * r, v1 = acc[ai][bj][m][1] * r;
#pragma unroll
                    for (int e = 0; e < 4; ++e) { const float a = fmaxf(v0[e], 0.f), b = fmaxf(v1[e], 0.f); v0[e] = a * a; v1[e] = b * b; }
                    *(u32x4*)(rowp + bj * HALF) = pack8(v0, v1); } }
    }
};
struct EpiPle {
    static constexpr bool PERM = true;
    const bf16_t* xin; bf16_t* xb; const bf16_t* E; const float* ssq;
    __device__ __forceinline__ void operator()(Acc& acc, const Unit& u, int wr, int wc, int fr, int fq, LAS float* tab, int tid) const {
        const int row0 = u.pm * BM + wr * 64 + fr, col0 = u.pn * BM + wc * 32 + 8 * fq;
#pragma unroll
        for (int ai = 0; ai < 2; ++ai)
#pragma unroll
            for (int mh = 0; mh < 2; ++mh) {
                u32x4 xi[2][2], ei[2][2]; f32x4 sq[2];
#pragma unroll
                for (int mm = 0; mm < 2; ++mm) { const int row = row0 + ai * HALF + (2 * mh + mm) * 16; sq[mm] = *(const f32x4*)(ssq + (size_t)row * 4);
#pragma unroll
                    for (int bj = 0; bj < 2; ++bj) { const size_t off = (size_t)row * DM + col0 + bj * HALF; xi[mm][bj] = *(const u32x4*)(xin + off); ei[mm][bj] = *(const u32x4*)(E + off); } }
#pragma unroll
                for (int mm = 0; mm < 2; ++mm) { const int m = 2 * mh + mm; const float r = rstd_of(sq[mm]);
#pragma unroll
                    for (int bj = 0; bj < 2; ++bj) { const f32x4 a0 = acc[ai][bj][m][0] * r, a1 = acc[ai][bj][m][1] * r, e0 = bf4_lo(ei[mm][bj]), e1 = bf4_hi(ei[mm][bj]); f32x4 o0 = bf4_lo(xi[mm][bj]), o1 = bf4_hi(xi[mm][bj]);
#pragma unroll
                        for (int e = 0; e < 4; ++e) { o0[e] += fast_sigmoid(a0[e]) * e0[e]; o1[e] += fast_sigmoid(a1[e]) * e1[e]; }
                        *(u32x4*)(xb + (size_t)(row0 + ai * HALF + m * 16) * DM + col0 + bj * HALF) = pack8(o0, o1); } }
                asm volatile("" ::: "memory");
            }
    }
};

template <class Epi, class Sched>
__device__ __forceinline__ void gemm_phase(LAS unsigned char* lds, const Gemm g, const Sched& S, const Epi& E) {
    const int tid = threadIdx.x, wid = __builtin_amdgcn_readfirstlane(tid >> 6), lane = tid & 63, wr = wid >> 2, wc = wid & 3, fr = lane & 15, fq = lane >> 4;
    const int K = g.K, nt = K / BK;
    unsigned voffA[2], voffB[2];
#pragma unroll
    for (int i = 0; i < 2; ++i) { int R, C; stage_rc(tid * 16 + i * 8192, R, C); const int Rb = Epi::PERM ? ((R & ~31) + perm32(R & 31)) : R;
        voffA[i] = (unsigned)(R * g.lda + C) * 2u; voffB[i] = (unsigned)(Rb * g.ldb + C) * 2u; }
    const size_t kstep = (size_t)(BK * 2);
    const size_t hA = (size_t)HALF * g.lda * 2, hB = (size_t)HALF * g.ldb * 2;
    const unsigned ldsw = (unsigned)wid * 1024u;
    const int aoff = lds_byte(wr * 64 + fr, fq * 8), boff = lds_byte(wc * 32 + fr, fq * 8);
#define PG8_SA(b, h) (((b) * 2 + (h)) * HTB)
#define PG8_SB(b, h) ((4 + (b) * 2 + (h)) * HTB)
#define PG8_STAGE(bufoff, gbase, voff) do { _Pragma("unroll") for (int _i = 0; _i < 2; ++_i) \
        __builtin_amdgcn_global_load_lds((const unsigned*)((const char*)(gbase) + (voff)[_i]), (LAS unsigned*)(lds + (bufoff) + ldsw + _i * 8192), 16, 0, 0); } while (0)
#define PG8_LDA(dst, b, h) do { _Pragma("unroll") for (int m = 0; m < 4; ++m) _Pragma("unroll") for (int k = 0; k < 2; ++k) dst[m][k] = *(const LAS bf16x8*)(lds + PG8_SA(b, h) + aoff + m * 2048 + k * 1024); } while (0)
#define PG8_LDB(dst, b, h) do { _Pragma("unroll") for (int n = 0; n < 2; ++n) _Pragma("unroll") for (int k = 0; k < 2; ++k) dst[n][k] = *(const LAS bf16x8*)(lds + PG8_SB(b, h) + boff + n * 2048 + k * 1024); } while (0)
#define PG8_MMA(ai, bj, At, Bt) do { __builtin_amdgcn_s_setprio(1); _Pragma("unroll") for (int m = 0; m < 4; ++m) _Pragma("unroll") for (int n = 0; n < 2; ++n) _Pragma("unroll") for (int k = 0; k < 2; ++k) \
        acc[ai][bj][m][n] = __builtin_amdgcn_mfma_f32_16x16x32_bf16(Bt[n][k], At[m][k], acc[ai][bj][m][n], 0, 0, 0); __builtin_amdgcn_s_setprio(0); } while (0)
#define PG8_WAIT_V(n) asm volatile("s_waitcnt vmcnt(" #n ")" ::: "memory")
#define PG8_WAIT_L(n) asm volatile("s_waitcnt lgkmcnt(" #n ")" ::: "memory")
#define PG8_BAR __builtin_amdgcn_s_barrier()
#define PG8_SCHED __builtin_amdgcn_sched_barrier(0)
#define PG8_ZERO() do { _Pragma("unroll") for (int a = 0; a < 2; ++a) _Pragma("unroll") for (int b = 0; b < 2; ++b) _Pragma("unroll") for (int m = 0; m < 4; ++m) _Pragma("unroll") for (int n = 0; n < 2; ++n) acc[a][b][m][n] = (f32x4){0.f, 0.f, 0.f, 0.f}; } while (0)
    Unit cur, nxt; int ui = 0;
    if (!S.next(0, cur)) return;
    Acc acc;
    PG8_ZERO();
    bf16x8 At[4][2], B0[2][2], B1[2][2];
    const char* cA = uni_ptr(cur.A); const char* cB = uni_ptr(cur.B);
    PG8_STAGE(PG8_SB(0, 0), cB, voffB); PG8_STAGE(PG8_SB(0, 1), cB + hB, voffB); PG8_STAGE(PG8_SA(0, 0), cA, voffA); PG8_STAGE(PG8_SA(0, 1), cA + hA, voffA);
    if (wr == 1) PG8_BAR;
    PG8_WAIT_V(2); PG8_BAR;
    PG8_STAGE(PG8_SB(1, 0), cB + kstep, voffB); PG8_STAGE(PG8_SA(1, 0), cA + kstep, voffA); PG8_STAGE(PG8_SB(1, 1), cB + hB + kstep, voffB);
    PG8_WAIT_V(6); PG8_BAR;
    for (;;) {
        const bool has_next = S.next(ui + 1, nxt);
        const char* nA = uni_ptr(has_next ? nxt.A : cA); const char* nB = uni_ptr(has_next ? nxt.B : cB);
#pragma nounroll
        for (int t = 0; t < nt; t += 2) {
            const bool last = (t == nt - 2);
            const char* a1 = cA + (size_t)(t + 1) * kstep;
            const char* a2 = last ? nA : cA + (size_t)(t + 2) * kstep; const char* b2 = last ? nB : cB + (size_t)(t + 2) * kstep;
            const char* a3 = a2 + kstep; const char* b3 = b2 + kstep;
            PG8_LDB(B0, 0, 0); PG8_LDB(B1, 0, 1); PG8_SCHED; PG8_LDA(At, 0, 0); PG8_STAGE(PG8_SA(1, 1), a1 + hA, voffA);
            PG8_WAIT_V(8); PG8_WAIT_L(0); PG8_BAR; PG8_MMA(0, 0, At, B0); PG8_MMA(0, 1, At, B1); PG8_BAR; PG8_SCHED;
            PG8_LDA(At, 0, 1); PG8_STAGE(PG8_SB(0, 0), b2, voffB); PG8_STAGE(PG8_SB(0, 1), b2 + hB, voffB); PG8_STAGE(PG8_SA(0, 0), a2, voffA);
            PG8_WAIT_V(8); PG8_WAIT_L(0); PG8_BAR; PG8_MMA(1, 0, At, B0); PG8_MMA(1, 1, At, B1); PG8_BAR; PG8_SCHED;
            PG8_LDB(B0, 1, 0); PG8_LDB(B1, 1, 1); PG8_SCHED; PG8_LDA(At, 1, 0); PG8_STAGE(PG8_SA(0, 1), a2 + hA, voffA);
            PG8_WAIT_V(8); PG8_WAIT_L(0); PG8_BAR; PG8_MMA(0, 0, At, B0); PG8_MMA(0, 1, At, B1); PG8_BAR; PG8_SCHED;
            PG8_LDA(At, 1, 1); PG8_STAGE(PG8_SB(1, 0), b3, voffB); PG8_STAGE(PG8_SB(1, 1), b3 + hB, voffB); PG8_STAGE(PG8_SA(1, 0), a3, voffA);
            PG8_WAIT_V(8); PG8_WAIT_L(0); PG8_BAR; PG8_MMA(1, 0, At, B0); PG8_MMA(1, 1, At, B1); PG8_BAR; PG8_SCHED;
        }
        if (wr == 0) PG8_BAR;
        E(acc, cur, wr, wc, fr, fq, (LAS float*)(lds + STAGE_BYTES + 64), tid);
        if (!has_next) break;
        if (!cur.chain) PG8_ZERO();
        cur = nxt; cA = nA; cB = nB; ++ui;
        if (wr == 1) PG8_BAR;
    }
    PG8_WAIT_V(0);
    PG8_BAR;
#undef PG8_SA
#undef PG8_SB
#undef PG8_STAGE
#undef PG8_LDA
#undef PG8_LDB
#undef PG8_MMA
#undef PG8_WAIT_V
#undef PG8_WAIT_L
#undef PG8_BAR
#undef PG8_SCHED
#undef PG8_ZERO
}
}

namespace att {
constexpr int PITCH = NQKV, OPITCH = DM;
constexpr int NSLOT = 4, SLOT = 16384, L_K = 0, L_V = 8192;
constexpr int L_CB = NSLOT * SLOT, L_WS = L_CB + SEQ * 4, L_OST = L_WS + 8 * 256, L_FLAG = L_OST + 8 * 4096, L_END = L_FLAG + 64;
constexpr float SB_THR = -160.0f;
__device__ __forceinline__ int crow(int r, int hi) { return (r & 3) + 8 * (r >> 2) + 4 * hi; }
__device__ __forceinline__ s16x4 vtr(const LAS unsigned char* p) { typedef short v4i16_t __attribute__((ext_vector_type(4))); return __builtin_bit_cast(s16x4, __builtin_amdgcn_ds_read_tr16_b64_v4i16((LAS v4i16_t*)p)); }
__device__ __forceinline__ void swap_halves(float v, float& lo, float& hi_) { auto rr = __builtin_amdgcn_permlane32_swap(__float_as_uint(v), __float_as_uint(v), false, false); lo = __uint_as_float(rr[0]); hi_ = __uint_as_float(rr[1]); }

template <int KIND>
__device__ __forceinline__ void attn_unit(int b, int h, int qb, const bf16_t* QKV, const float* cc, bf16_t* O, LAS unsigned char* lds) {
    const int tid = threadIdx.x, lane = tid & 63, r32 = lane & 31, hi = lane >> 5; const int wid = __builtin_amdgcn_readfirstlane(tid >> 6);
    const size_t rowbase = (size_t)b * SEQ; const int q0 = qb * 256, qw = q0 + wid * 32, qabs = qw + r32;
    const int colq = KIND * 1536 + h * HD;
    const bf16_t* ksrc = QKV + rowbase * PITCH + colq + 512 + (size_t)lane * PITCH + wid * 8;
    const bf16_t* vsrc = QKV + rowbase * PITCH + colq + 1024 + (size_t)(16 * (wid & 3) + (lane >> 2)) * PITCH + (wid >> 2) * 32 + (lane & 3) * 8;
    const int wdst = wid * 1024;
    const int nIter = qb * 4 + 4, T_last = nIter - 1, td = qw >> 6;
#define ATT_DMA(itx) do { const int t_ = T_last - (itx); LAS unsigned char* sl_ = lds + ((itx) & (NSLOT - 1)) * SLOT + wdst; \
        __builtin_amdgcn_global_load_lds((const unsigned*)(ksrc + (size_t)t_ * 64 * PITCH), (LAS unsigned*)(sl_ + L_K), 16, 0, 0); \
        __builtin_amdgcn_global_load_lds((const unsigned*)(vsrc + (size_t)t_ * 64 * PITCH), (LAS unsigned*)(sl_ + L_V), 16, 0, 0); } while (0)
    ATT_DMA(0); ATT_DMA(1); ATT_DMA(2);
    const bf16_t* Qw = QKV + (rowbase + qw) * PITCH + colq;
    bf16x8 qr[4];
#pragma unroll
    for (int d0 = 0; d0 < 4; ++d0) qr[d0] = *(const bf16x8*)(Qw + (size_t)r32 * PITCH + d0 * 16 + hi * 8);
    LAS float* wsf = (LAS float*)(lds + L_WS) + wid * 64;
    LAS unsigned* flags = (LAS unsigned*)(lds + L_FLAG);
    LAS float* cbl = (LAS float*)(lds + L_CB);
    if (KIND == 0) { const float* ccb = cc + (size_t)(b * NH + h) * SEQ; const float cref = ccb[q0 + 255]; const f32x4 c4 = *((const f32x4*)ccb + tid); *((LAS f32x4*)cbl + tid) = cref - c4; }
    f32x16 o[2]; o[0] = (f32x16){}; o[1] = (f32x16){};
    float mrun = -INFINITY, lrun = 0.f, R = 0.f; bool mydone = false;
    for (int it = 0; it < nIter; ++it) {
        const int t = T_last - it; const int ahead = nIter - 1 - it;
        if (ahead >= 2) asm volatile("s_waitcnt vmcnt(4) lgkmcnt(0)" ::: "memory"); else if (ahead == 1) asm volatile("s_waitcnt vmcnt(2) lgkmcnt(0)" ::: "memory"); else asm volatile("s_waitcnt vmcnt(0) lgkmcnt(0)" ::: "memory");
        __builtin_amdgcn_s_barrier(); asm volatile("" ::: "memory");
        if (KIND == 1 && it > 0) { const u32x4 fa = *(const LAS u32x4*)(flags + ((it - 1) & 1) * 8), fb = *(const LAS u32x4*)(flags + ((it - 1) & 1) * 8 + 4);
            if ((fa.x & fa.y & fa.z & fa.w & fb.x & fb.y & fb.z & fb.w) != 0u) break; }
        if (it + 3 < nIter) ATT_DMA(it + 3);
        if (t <= td && !mydone) {
            const LAS unsigned char* slot = lds + (it & (NSLOT - 1)) * SLOT;
            f32x16 p0, p1;
            if (KIND == 0) {
                const LAS f32x4* cb4 = (const LAS f32x4*)(cbl + t * 64 + 4 * hi);
#pragma unroll
                for (int g = 0; g < 4; ++g) { const f32x4 c0 = cb4[2 * g], c1 = cb4[8 + 2 * g];
#pragma unroll
                    for (int i = 0; i < 4; ++i) { p0[4 * g + i] = c0[i]; p1[4 * g + i] = c1[i]; } }
            } else { p0 = (f32x16){}; p1 = (f32x16){}; }
            const LAS unsigned char* kb = slot + L_K + hi * 1024 + r32 * 16;
#pragma unroll
            for (int d0 = 0; d0 < 4; ++d0) { const bf16x8 b0 = *(const LAS bf16x8*)(kb + d0 * 2048), b1 = *(const LAS bf16x8*)(kb + d0 * 2048 + 512);
                p0 = __builtin_amdgcn_mfma_f32_32x32x16_bf16(b0, qr[d0], p0, 0, 0, 0); p1 = __builtin_amdgcn_mfma_f32_32x32x16_bf16(b1, qr[d0], p1, 0, 0, 0); }
            s16x4 vlo[8], vhi[8];
            { const unsigned vb = (unsigned)(uintptr_t)(slot + L_V + ((lane >> 4) & 1) * 32 + (lane & 3) * 8 + (4 * hi + ((lane & 15) >> 2)) * 64);
#pragma unroll
              for (int i = 0; i < 8; ++i) {
                asm volatile("ds_read_b64_tr_b16 %0, %1 offset:%c2" : "=&v"(vlo[i]) : "v"(vb), "i"((i >> 2) * 4096 + (i & 3) * 1024) : "memory");
                asm volatile("ds_read_b64_tr_b16 %0, %1 offset:%c2" : "=&v"(vhi[i]) : "v"(vb), "i"((i >> 2) * 4096 + (i & 3) * 1024 + 512) : "memory"); } }
            const bool diag = (t == td); const int kv0 = t * 64 + 4 * hi;
            if (KIND == 0) {
                if (diag) {
#pragma unroll
                    for (int r = 0; r < 16; ++r) { const int kv = kv0 + (r & 3) + 8 * (r >> 2); if (kv > qabs) p0[r] = -INFINITY; if (kv + 32 > qabs) p1[r] = -INFINITY; }
                }
                float rm = fmaxf(p0[0], p1[0]);
#pragma unroll
                for (int r = 1; r < 16; ++r) rm = fmaxf(rm, fmaxf(p0[r], p1[r]));
                { float a, c; swap_halves(rm, a, c); rm = fmaxf(a, c); }
                if (__any(rm > mrun + 8.0f)) {
                    const float mnew = fmaxf(mrun, rm); const float f = __builtin_amdgcn_exp2f(mrun - mnew); mrun = mnew; lrun *= f;
                    if (hi == 0) wsf[r32] = f;
                    asm volatile("s_waitcnt lgkmcnt(0)" ::: "memory");
#pragma unroll
                    for (int r = 0; r < 16; ++r) { const float fr_ = wsf[crow(r, hi)]; o[0][r] *= fr_; o[1][r] *= fr_; }
                    asm volatile("s_waitcnt lgkmcnt(0)" ::: "memory");
                }
                float ls = 0.f;
#pragma unroll
                for (int r = 0; r < 16; ++r) { p0[r] = __builtin_amdgcn_exp2f(p0[r] - mrun); p1[r] = __builtin_amdgcn_exp2f(p1[r] - mrun); ls += p0[r] + p1[r]; }
                lrun += ls;
            } else {
                f32x16 l0, l1;
#pragma unroll
                for (int r = 0; r < 16; ++r) {
                    const int kv = kv0 + (r & 3) + 8 * (r >> 2);
                    { const float z = p0[r]; const float tt = __builtin_amdgcn_logf(1.0f + __builtin_amdgcn_exp2f(-fabsf(z))); float L = -(fmaxf(z, 0.f) + tt); if (diag && !(kv < qabs)) L = 0.f; l0[r] = L; }
                    { const float z = p1[r]; const float tt = __builtin_amdgcn_logf(1.0f + __builtin_amdgcn_exp2f(-fabsf(z))); float L = -(fmaxf(z, 0.f) + tt); if (diag && !(kv + 32 < qabs)) L = 0.f; l1[r] = L; }
                }
                float G[8], Gp[8];
#pragma unroll
                for (int g = 0; g < 4; ++g) { G[g] = (l0[4 * g] + l0[4 * g + 1]) + (l0[4 * g + 2] + l0[4 * g + 3]); G[4 + g] = (l1[4 * g] + l1[4 * g + 1]) + (l1[4 * g + 2] + l1[4 * g + 3]); }
#pragma unroll
                for (int c = 0; c < 8; ++c) { float a, d; swap_halves(G[c], a, d); Gp[c] = hi ? a : d; }
                float cs = 0.f;
#pragma unroll
                for (int c = 7; c >= 0; --c) {
                    const float ex = cs + (hi ? 0.f : Gp[c]);
                    const int g = c & 3;
                    if (c >= 4) { float s3 = l1[4 * g + 3] + ex, s2 = l1[4 * g + 2] + s3, s1 = l1[4 * g + 1] + s2, s0 = l1[4 * g] + s1; l1[4 * g + 3] = s3; l1[4 * g + 2] = s2; l1[4 * g + 1] = s1; l1[4 * g] = s0; }
                    else        { float s3 = l0[4 * g + 3] + ex, s2 = l0[4 * g + 2] + s3, s1 = l0[4 * g + 1] + s2, s0 = l0[4 * g] + s1; l0[4 * g + 3] = s3; l0[4 * g + 2] = s2; l0[4 * g + 1] = s1; l0[4 * g] = s0; }
                    cs += G[c] + Gp[c];
                }
#pragma unroll
                for (int r = 0; r < 16; ++r) {
                    const int kv = kv0 + (r & 3) + 8 * (r >> 2);
                    float w0 = __builtin_amdgcn_exp2f(p0[r] + l0[r] + R), w1 = __builtin_amdgcn_exp2f(p1[r] + l1[r] + R);
                    if (diag && !(kv < qabs)) w0 = 0.f; if (diag && !(kv + 32 < qabs)) w1 = 0.f;
                    p0[r] = w0; p1[r] = w1;
                }
                R += cs;
                mydone = __all(R < SB_THR);
            }
            u32x4 pw[4];
            pw[0] = (u32x4){cvt_pk_bf16(p0[0], p0[1]), cvt_pk_bf16(p0[2], p0[3]), cvt_pk_bf16(p0[4], p0[5]), cvt_pk_bf16(p0[6], p0[7])};
            pw[1] = (u32x4){cvt_pk_bf16(p0[8], p0[9]), cvt_pk_bf16(p0[10], p0[11]), cvt_pk_bf16(p0[12], p0[13]), cvt_pk_bf16(p0[14], p0[15])};
            pw[2] = (u32x4){cvt_pk_bf16(p1[0], p1[1]), cvt_pk_bf16(p1[2], p1[3]), cvt_pk_bf16(p1[4], p1[5]), cvt_pk_bf16(p1[6], p1[7])};
            pw[3] = (u32x4){cvt_pk_bf16(p1[8], p1[9]), cvt_pk_bf16(p1[10], p1[11]), cvt_pk_bf16(p1[12], p1[13]), cvt_pk_bf16(p1[14], p1[15])};
            asm volatile("s_waitcnt lgkmcnt(0)" ::: "memory"); __builtin_amdgcn_sched_barrier(0);
#pragma unroll
            for (int ks = 0; ks < 4; ++ks)
#pragma unroll
                for (int d0 = 0; d0 < 2; ++d0) { const int i = d0 * 4 + ks;
                    const bf16x8 vf = {vlo[i][0], vlo[i][1], vlo[i][2], vlo[i][3], vhi[i][0], vhi[i][1], vhi[i][2], vhi[i][3]};
                    o[d0] = __builtin_amdgcn_mfma_f32_32x32x16_bf16(__builtin_bit_cast(bf16x8, pw[ks]), vf, o[d0], 0, 0, 0); }
        }
        if (KIND == 1) { if (lane == 0) flags[(it & 1) * 8 + wid] = mydone ? 1u : 0u; }
    }
#undef ATT_DMA
    float inv = 1.0f;
    if (KIND == 0) { float a, c; swap_halves(lrun, a, c); inv = 1.0f / (a + c); }
    if (hi == 0) wsf[32 + r32] = inv;
    asm volatile("s_waitcnt lgkmcnt(0)" ::: "memory");
    LAS bf16_t* stg = (LAS bf16_t*)(lds + L_OST) + wid * 2048;
#pragma unroll
    for (int r = 0; r < 16; ++r) { const int orow = crow(r, hi); const float rl = wsf[32 + orow];
        const unsigned w = cvt_pk_bf16(o[0][r] * rl, o[1][r] * rl);
        stg[orow * 64 + r32] = (bf16_t)(w & 0xffffu); stg[orow * 64 + 32 + r32] = (bf16_t)(w >> 16); }
    asm volatile("s_waitcnt lgkmcnt(0)" ::: "memory");
    bf16_t* Ow = O + (rowbase + qw) * OPITCH + KIND * 512 + h * HD;
#pragma unroll
    for (int i = 0; i < 4; ++i) { const int row = i * 8 + (lane >> 3), ch = lane & 7; const u32x4 v = *(const LAS u32x4*)(stg + row * 64 + ch * 8); *(u32x4*)(Ow + (size_t)row * OPITCH + ch * 8) = v; }
    asm volatile("s_waitcnt vmcnt(0) lgkmcnt(0)" ::: "memory");
    __builtin_amdgcn_s_barrier(); asm volatile("" ::: "memory");
}
}

#define XB_TMO      128
#define XB_XCNT(j)  (256  + 64 * (j))
#define XB_XSUB(j)  (1280 + 64 * (j))
#define XB_XGEN(j)  (2304 + 64 * (j))
#define XB_TOP      3328
#define XB_TOPGEN   3392
#define XCD_BAR_WORDS 3456
#define XB_SPIN_CAP (1u << 18)
__device__ __forceinline__ unsigned xb_ld(unsigned* p)              { return __hip_atomic_load(p, __ATOMIC_RELAXED, __HIP_MEMORY_SCOPE_AGENT); }
__device__ __forceinline__ unsigned xb_add(unsigned* p, unsigned v) { return __hip_atomic_fetch_add(p, v, __ATOMIC_RELAXED, __HIP_MEMORY_SCOPE_AGENT); }
__device__ __forceinline__ unsigned xb_xcc_id() { return (unsigned)__builtin_amdgcn_s_getreg((3 << 11) | 20) & 0xFu; }
#define XB_SPIN(cond, bar) do { unsigned _sp = 0; while (cond) { __builtin_amdgcn_s_sleep(1); \
    if ((++_sp & 255u) == 0u) { if (xb_ld(&(bar)[XB_TMO])) break; if (_sp > XB_SPIN_CAP) { atomicAdd(&(bar)[XB_TMO], 1u); break; } } } } while (0)
struct XcdBarrier { unsigned* bar; unsigned x; volatile LAS unsigned* st; };
__device__ __forceinline__ XcdBarrier xcd_barrier_post(unsigned* bar, volatile LAS unsigned* st) {
    XcdBarrier b; b.bar = bar; b.x = xb_xcc_id(); b.st = st;
    if (threadIdx.x == 0) (void)xb_add(&bar[XB_XCNT(b.x)], 1u);
    return b;
}
__device__ __forceinline__ void xcd_barrier_complete(unsigned* bar, unsigned x, unsigned& nloc, unsigned& nx) {
    const unsigned G = gridDim.x * gridDim.y * gridDim.z;
    unsigned sum, cnt, mine, sp = 0u;
    for (;;) {
        sum = 0u; cnt = 0u; mine = 0u;
#pragma unroll
        for (unsigned j = 0; j < 16; ++j) { const unsigned c = xb_ld(&bar[XB_XCNT(j)]); sum += c; cnt += (c > 0u) ? 1u : 0u; mine = (j == x) ? c : mine; }
        if (sum == G) break;
        __builtin_amdgcn_s_sleep(1);
        if ((++sp & 255u) == 0u) { if (xb_ld(&bar[XB_TMO])) break; if (sp > XB_SPIN_CAP) { atomicAdd(&bar[XB_TMO], 1u); break; } }
    }
    nloc = mine > 0u ? mine : 1u; nx = cnt > 0u ? cnt : 1u;
}
__device__ __forceinline__ void xcd_barrier(const XcdBarrier& b) {
    asm volatile("s_waitcnt vmcnt(0)" ::: "memory");
    __syncthreads();
    if (threadIdx.x == 0) {
        unsigned* bar = b.bar;
        __builtin_amdgcn_s_waitcnt(0);
        unsigned nloc = b.st[0], nx = b.st[1];
        if (nloc == 0u) { xcd_barrier_complete(bar, b.x, nloc, nx); b.st[0] = nloc; b.st[1] = nx; }
        const unsigned old = xb_add(&bar[XB_XSUB(b.x)], 1u);
        const unsigned gen = old / nloc;
        if (old + 1u == (gen + 1u) * nloc) {
            __builtin_amdgcn_fence(__ATOMIC_RELEASE, "agent");
            asm volatile("s_waitcnt vmcnt(0)" ::: "memory");
            const unsigned og = xb_add(&bar[XB_TOP], 1u);
            const unsigned tg = og / nx;
            if (og + 1u == (tg + 1u) * nx) xb_add(&bar[XB_TOPGEN], 1u);
            else XB_SPIN(xb_ld(&bar[XB_TOPGEN]) == tg, bar);
            __builtin_amdgcn_fence(__ATOMIC_ACQUIRE, "agent");
            xb_add(&bar[XB_XGEN(b.x)], 1u);
            asm volatile("s_waitcnt vmcnt(0)" ::: "memory");
        } else {
            XB_SPIN(xb_ld(&bar[XB_XGEN(b.x)]) == gen, bar);
            __builtin_amdgcn_fence(__ATOMIC_ACQUIRE, "agent");
            asm volatile("s_waitcnt vmcnt(0)" ::: "memory");
        }
    }
    __syncthreads();
}

constexpr int NWAVES = 8;
constexpr int RING_BYTES = 131072, LDS_BYTES = 147456;
static_assert(att::L_END <= RING_BYTES, "attention scratch fits the ring region");

__device__ __forceinline__ float wave_sum(float v) {
#pragma unroll
    for (int o = 1; o < 64; o <<= 1) v += __shfl_xor(v, o);
    return v;
}
__device__ __forceinline__ void tr_item(const float* W, int ldw, int col0, int K, bf16_t* WT, int row_off, LAS float* scr, int kb, int nb, int lane, const float* gs) {
    const int k0 = 64 * kb, n0 = 32 * nb;
#pragma unroll 8
    for (int i = 0; i < 32; ++i) { const int kk = 2 * i + (lane >> 5); scr[kk * 33 + (lane & 31)] = W[(size_t)(k0 + kk) * ldw + col0 + n0 + (lane & 31)] * (gs ? gs[k0 + kk] : 1.0f); }
    asm volatile("s_waitcnt lgkmcnt(0)" ::: "memory");
    const int c = lane & 7;
#pragma unroll
    for (int j = 0; j < 4; ++j) { const int n = (lane >> 3) + 8 * j; const LAS float* s = scr + (8 * c) * 33 + n;
        u32x4 o; o.x = cvt_pk_bf16(s[0 * 33], s[1 * 33]); o.y = cvt_pk_bf16(s[2 * 33], s[3 * 33]); o.z = cvt_pk_bf16(s[4 * 33], s[5 * 33]); o.w = cvt_pk_bf16(s[6 * 33], s[7 * 33]);
        *(u32x4*)(WT + (size_t)(row_off + n0 + n) * K + k0 + 8 * c) = o; }
    asm volatile("s_waitcnt lgkmcnt(0)" ::: "memory");
}

struct Args { const float* in[16]; float* out; unsigned char* ws; int ph_lo, ph_hi; };

__global__ void __launch_bounds__(NWAVES * 64, 2) fwd_megakernel(Args args) {
    __builtin_assume(__builtin_amdgcn_workitem_id_y() == 0); __builtin_assume(__builtin_amdgcn_workitem_id_z() == 0);
    extern __shared__ __attribute__((aligned(16))) unsigned char lds_raw[];
    LAS unsigned char* lds = (LAS unsigned char*)lds_raw;
    const int tid = threadIdx.x, lane = tid & 63, wave = __builtin_amdgcn_readfirstlane(tid >> 6);
    const int G = gridDim.x, bx = blockIdx.x, vcu = (G % 8 == 0) ? (bx % 8) * (G / 8) + bx / 8 : bx;
    const int gw = vcu * NWAVES + wave, NGW = G * NWAVES;
    unsigned char* ws = args.ws;
    const float* x = args.in[0]; const float* p_in = args.in[1]; const float* g_mix = args.in[2]; const float* w_in = args.in[3]; const float* b_forget = args.in[4]; const float* b_gate = args.in[5];
    const float* w_bf = args.in[6]; const float* w_bs = args.in[7]; const float* w_out = args.in[8]; const float* g_mlp = args.in[9]; const float* w_up = args.in[10]; const float* w_dn = args.in[11];
    const float* g_ple = args.in[12]; const float* w_pg = args.in[13]; const float* w_ple = args.in[14]; const float* g_final = args.in[15];
    float* out = args.out;
    bf16_t* Win_t = (bf16_t*)(ws + WS_WIN); bf16_t* Wbf_t = (bf16_t*)(ws + WS_WBF); bf16_t* Wbs_t = (bf16_t*)(ws + WS_WBS); bf16_t* Wout_t = (bf16_t*)(ws + WS_WOUT);
    bf16_t* Wup_t = (bf16_t*)(ws + WS_WUP); bf16_t* Wdn_t = (bf16_t*)(ws + WS_WDN); bf16_t* Wpg_t = (bf16_t*)(ws + WS_WPG); bf16_t* Wple_t = (bf16_t*)(ws + WS_WPLE);
    float* LOGF = (float*)(ws + WS_LOGF); float* CC = (float*)(ws + WS_CC); float* SSQ1 = (float*)(ws + WS_SSQ1); float* SSQ2 = (float*)(ws + WS_SSQ2);
    bf16_t* PB = (bf16_t*)(ws + WS_PB); bf16_t* BUFA = (bf16_t*)(ws + WS_BUFA); bf16_t* BUFB = (bf16_t*)(ws + WS_BUFB); bf16_t* QKV = (bf16_t*)(ws + WS_QKV); bf16_t* SG = (bf16_t*)(ws + WS_SG);
    bf16_t* HB = (bf16_t*)(ws + WS_H); bf16_t* EB = (bf16_t*)(ws + WS_E);
    const int lo = args.ph_lo, hi = args.ph_hi;
#define IN(k) (lo <= (k) && (k) < hi)
    volatile LAS unsigned* bst = (volatile LAS unsigned*)(lds + RING_BYTES);
    if (tid < 2) bst[tid] = 0u;
    __syncthreads();
    XcdBarrier xbar; xbar.bar = (unsigned*)ws; xbar.x = 0; xbar.st = bst;
    if (hi - lo > 1) xbar = xcd_barrier_post((unsigned*)ws, bst);
#define SEAM(k) do { if (IN(k) && IN((k) + 1)) { if (hi > N_PHASES) cg::this_grid().sync(); else xcd_barrier(xbar); } } while (0)

    if (IN(0)) {
        LAS float* scr = (LAS float*)(lds + wave * 16384);
        {
            constexpr int NSEG = 9;
            int base = 0;
            for (int it = gw; ; it += NGW) {
                int r = it; const float* W; int ldw, col0, K, nblk, row_off; bf16_t* WT; const float* gs = nullptr;
                if (r < 16 * 48) { W = w_in; ldw = NIN_SRC; col0 = 0; K = DM; nblk = 48; WT = Win_t; row_off = 0; }
                else if ((r -= 16 * 48) < 16 * 112) { W = w_in; ldw = NIN_SRC; col0 = 1544; K = DM; nblk = 112; WT = Win_t; row_off = 1536; }
                else if ((r -= 16 * 112) < 8 * 32) { W = w_bf; ldw = DM; col0 = 0; K = 512; nblk = 32; WT = Wbf_t; row_off = 0; }
                else if ((r -= 8 * 32) < 8 * 32) { W = w_bs; ldw = DM; col0 = 0; K = 512; nblk = 32; WT = Wbs_t; row_off = 0; }
                else if ((r -= 8 * 32) < 16 * 32) { W = w_out; ldw = DM; col0 = 0; K = DM; nblk = 32; WT = Wout_t; row_off = 0; }
                else if ((r -= 16 * 32) < 16 * 128) { W = w_up; ldw = DFF; col0 = 0; K = DM; nblk = 128; WT = Wup_t; row_off = 0; gs = g_mlp; }
                else if ((r -= 16 * 128) < 64 * 32) { W = w_dn; ldw = DM; col0 = 0; K = DFF; nblk = 32; WT = Wdn_t; row_off = 0; }
                else if ((r -= 64 * 32) < 16 * 32) { W = w_pg; ldw = DM; col0 = 0; K = DM; nblk = 32; WT = Wpg_t; row_off = 0; gs = g_ple; }
                else if ((r -= 16 * 32) < 4 * 32) { W = w_ple; ldw = DM; col0 = 0; K = DPLE; nblk = 32; WT = Wple_t; row_off = 0; }
                else break;
                tr_item(W, ldw, col0, K, WT, row_off, scr, r / nblk, r % nblk, lane, gs);
                (void)base; (void)NSEG;
            }
        }
        {
            f32x4 gm[4]; f32x4 wf[4][4][2];
#pragma unroll
            for (int j = 0; j < 4; ++j) { gm[j] = *((const f32x4*)g_mix + lane + 64 * j);
#pragma unroll
                for (int e = 0; e < 4; ++e) { const float* wp = w_in + (size_t)(4 * lane + 256 * j + e) * NIN_SRC + 1536; wf[j][e][0] = *(const f32x4*)wp * gm[j][e]; wf[j][e][1] = *(const f32x4*)(wp + 4) * gm[j][e]; } }
            const float bfv = b_forget[lane & 7];
            for (int m = gw; m < M; m += NGW) {
                const f32x4* xr = (const f32x4*)(x + (size_t)m * DM) + lane;
                f32x4 v[4]; float s = 0.f;
#pragma unroll
                for (int j = 0; j < 4; ++j) { v[j] = xr[64 * j]; s += (v[j][0] * v[j][0] + v[j][1] * v[j][1]) + (v[j][2] * v[j][2] + v[j][3] * v[j][3]); }
                const float rstd = __builtin_amdgcn_rsqf(wave_sum(s) * (1.0f / DM) + EPS);
                f32x4 f0 = {0.f, 0.f, 0.f, 0.f}, f1 = {0.f, 0.f, 0.f, 0.f};
#pragma unroll
                for (int j = 0; j < 4; ++j)
#pragma unroll
                    for (int e = 0; e < 4; ++e) { f0 += wf[j][e][0] * v[j][e]; f1 += wf[j][e][1] * v[j][e]; }
                unsigned long long* o8 = (unsigned long long*)(BUFA + (size_t)m * DM) + lane;
#pragma unroll
                for (int j = 0; j < 4; ++j) { const f32x4 y = v[j] * gm[j] * rstd; o8[64 * j] = (unsigned long long)cvt_pk_bf16(y[0], y[1]) | ((unsigned long long)cvt_pk_bf16(y[2], y[3]) << 32); }
                float fl[8];
#pragma unroll
                for (int e = 0; e < 4; ++e) { fl[e] = wave_sum(f0[e]); fl[4 + e] = wave_sum(f1[e]); }
                float mine = fl[0];
#pragma unroll
                for (int e = 1; e < 8; ++e) mine = ((lane & 7) == e) ? fl[e] : mine;
                const float y2 = (mine * rstd + bfv) * LOG2E;
                const float lf = -(fmaxf(-y2, 0.f) + __builtin_amdgcn_logf(1.0f + __builtin_amdgcn_exp2f(-fabsf(y2))));
                if (lane < 8) LOGF[(size_t)((m / SEQ) * NH + lane) * SEQ + (m % SEQ)] = lf;
            }
        }
        {
            const size_t n8 = (size_t)M * DPLE / 8;
            for (size_t i = (size_t)bx * 512 + tid; i < n8; i += (size_t)G * 512) { const f32x4 a = *((const f32x4*)p_in + 2 * i), c = *((const f32x4*)p_in + 2 * i + 1);
                u32x4 w; w.x = cvt_pk_bf16(a[0], a[1]); w.y = cvt_pk_bf16(a[2], a[3]); w.z = cvt_pk_bf16(c[0], c[1]); w.w = cvt_pk_bf16(c[2], c[3]); *((u32x4*)PB + i) = w; }
        }
    }
    SEAM(0);

    if (IN(1)) {
        if (gw < BATCH * NH) {
            const float* src = LOGF + (size_t)gw * SEQ + lane * 32; float* dst = CC + (size_t)gw * SEQ + lane * 32;
            f32x4 v[8]; float run = 0.f;
#pragma unroll
            for (int j = 0; j < 8; ++j) { v[j] = *((const f32x4*)src + j);
#pragma unroll
                for (int e = 0; e < 4; ++e) { run += v[j][e]; v[j][e] = run; } }
            float incl = run;
#pragma unroll
            for (int o = 1; o < 64; o <<= 1) { const float tv = __shfl_up(incl, o); if (lane >= o) incl += tv; }
            const float excl = incl - run;
#pragma unroll
            for (int j = 0; j < 8; ++j) *((f32x4*)dst + j) = v[j] + excl;
        }
        pg8::Gemm g{DM, DM, DM};
        pg8::PlainSched S; S.T.init(M, NIN, G, bx); S.A = (const char*)BUFA; S.B = (const char*)Win_t; S.astep = (size_t)256 * DM * 2; S.bstep = (size_t)256 * DM * 2;
        pg8::EpiQKVG E{QKV, SG, b_gate};
        pg8::gemm_phase<pg8::EpiQKVG, pg8::PlainSched>(lds, g, S, E);
    }
    SEAM(1);

    if (IN(2)) {
        for (int i = 0; i < 8; ++i) {
            const int j = i & 3, kind = i >> 2;
            for (int bh = (vcu >> 1); bh < BATCH * NH; bh += (G >> 1)) {
                const int s = (vcu & 1) * 2 + (j >> 1); const int qb = (j & 1) ? 7 - s : s;
                if (kind == 0) att::attn_unit<0>(bh / NH, bh % NH, qb, QKV, CC, BUFB, lds);
                else att::attn_unit<1>(bh / NH, bh % NH, qb, QKV, CC, BUFB, lds);
            }
        }
    }
    SEAM(2);

    if (IN(3)) {
        pg8::Gemm g{DM, 512, 512};
        pg8::PairSched S; S.T.init(M, DM, G, bx); S.A0 = (const char*)BUFB; S.A1 = (const char*)(BUFB + 512); S.B0 = (const char*)Wbf_t; S.B1 = (const char*)Wbs_t; S.astep = (size_t)256 * DM * 2; S.bstep = (size_t)256 * 512 * 2;
        pg8::EpiBranch E{SG, BUFA};
        pg8::gemm_phase<pg8::EpiBranch, pg8::PairSched>(lds, g, S, E);
    }
    SEAM(3);

    if (IN(4)) {
        {
            pg8::Gemm g{DM, DM, DM};
            pg8::PlainSched S; S.T.init(M, DM, G, bx); S.A = (const char*)BUFA; S.B = (const char*)Wout_t; S.astep = (size_t)256 * DM * 2; S.bstep = (size_t)256 * DM * 2;
            pg8::EpiRes4 E{x, BUFB, SSQ1};
            pg8::gemm_phase<pg8::EpiRes4, pg8::PlainSched>(lds, g, S, E);
        }
        {
            pg8::Gemm g{DPLE, DPLE, DPLE};
            pg8::PlainSched S; S.T.init(M, DM, G, bx); S.A = (const char*)PB; S.B = (const char*)Wple_t; S.astep = (size_t)256 * DPLE * 2; S.bstep = (size_t)256 * DPLE * 2;
            pg8::EpiBf16 E{EB, DM};
            pg8::gemm_phase<pg8::EpiBf16, pg8::PlainSched>(lds, g, S, E);
        }
    }
    SEAM(4);

    if (IN(5)) {
        pg8::Gemm g{DM, DM, DM};
        pg8::PlainSched S; S.T.init(M, DFF, G, bx); S.A = (const char*)BUFB; S.B = (const char*)Wup_t; S.astep = (size_t)256 * DM * 2; S.bstep = (size_t)256 * DM * 2;
        pg8::EpiUp E{HB, SSQ1};
        pg8::gemm_phase<pg8::EpiUp, pg8::PlainSched>(lds, g, S, E);
    }
    SEAM(5);

    if (IN(6)) {
        pg8::Gemm g{DFF, DFF, DFF};
        pg8::PlainSched S; S.T.init(M, DM, G, bx); S.A = (const char*)HB; S.B = (const char*)Wdn_t; S.astep = (size_t)256 * DFF * 2; S.bstep = (size_t)256 * DFF * 2;
        pg8::EpiRes6 E{BUFB, BUFA, SSQ2};
        pg8::gemm_phase<pg8::EpiRes6, pg8::PlainSched>(lds, g, S, E);
    }
    SEAM(6);

    if (IN(7)) {
        pg8::Gemm g{DM, DM, DM};
        pg8::PlainSched S; S.T.init(M, DM, G, bx); S.A = (const char*)BUFA; S.B = (const char*)Wpg_t; S.astep = (size_t)256 * DM * 2; S.bstep = (size_t)256 * DM * 2;
        pg8::EpiPle E{BUFA, BUFB, EB, SSQ2};
        pg8::gemm_phase<pg8::EpiPle, pg8::PlainSched>(lds, g, S, E);
    }
    SEAM(7);

    if (IN(8)) {
        f32x4 gf[4];
#pragma unroll
        for (int j = 0; j < 2; ++j) { gf[2 * j] = *((const f32x4*)g_final + 2 * lane + 128 * j); gf[2 * j + 1] = *((const f32x4*)g_final + 2 * lane + 128 * j + 1); }
        for (int m = gw; m < M; m += 2 * NGW) {
            u32x4 w[2][2];
#pragma unroll
            for (int q = 0; q < 2; ++q)
#pragma unroll
                for (int j = 0; j < 2; ++j) w[q][j] = *((const u32x4*)(BUFB + (size_t)(m + q * NGW) * DM) + lane + 64 * j);
#pragma unroll
            for (int q = 0; q < 2; ++q) {
                f32x4 v[4]; float s = 0.f;
#pragma unroll
                for (int j = 0; j < 2; ++j) { v[2 * j] = pg8::bf4_lo(w[q][j]); v[2 * j + 1] = pg8::bf4_hi(w[q][j]); }
#pragma unroll
                for (int j = 0; j < 4; ++j) s += (v[j][0] * v[j][0] + v[j][1] * v[j][1]) + (v[j][2] * v[j][2] + v[j][3] * v[j][3]);
                const float rstd = __builtin_amdgcn_rsqf(wave_sum(s) * (1.0f / DM) + EPS);
                f32x4* orow = (f32x4*)(out + (size_t)(m + q * NGW) * DM);
#pragma unroll
                for (int j = 0; j < 2; ++j) { orow[2 * lane + 128 * j] = v[2 * j] * gf[2 * j] * rstd; orow[2 * lane + 128 * j + 1] = v[2 * j + 1] * gf[2 * j + 1] * rstd; }
            }
        }
    }
#undef IN
#undef SEAM
}

extern "C" void kernel_launch(void* const* d_in, const int* in_sizes, int n_in, void* d_out, int out_size, void* d_ws, size_t ws_size, hipStream_t stream) {
    static int grid = 0;
    if (grid == 0) {
        if (n_in != 16 || in_sizes[0] != M * DM || out_size != M * DM || ws_size < WS_END) { fprintf(stderr, "kernel_launch: unexpected shapes (n_in %d, in0 %d, out %d, ws %zu); nothing launched\n", n_in, n_in > 0 ? in_sizes[0] : -1, out_size, ws_size); grid = -1; return; }
        int dev = 0, cus = 0, per_cu = 0;
        if (hipGetDevice(&dev) != hipSuccess || hipDeviceGetAttribute(&cus, hipDeviceAttributeMultiprocessorCount, dev) != hipSuccess) { grid = -1; return; }
        if (hipFuncSetAttribute((const void*)fwd_megakernel, hipFuncAttributeMaxDynamicSharedMemorySize, LDS_BYTES) != hipSuccess) { fprintf(stderr, "kernel_launch: hipFuncSetAttribute failed\n"); grid = -1; return; }
        if (hipOccupancyMaxActiveBlocksPerMultiprocessor(&per_cu, (const void*)fwd_megakernel, NWAVES * 64, LDS_BYTES) != hipSuccess || per_cu < 1) { fprintf(stderr, "kernel_launch: occupancy query says %d\n", per_cu); per_cu = 1; }
        (void)hipGetLastError();
        grid = cus;
        if (grid != 256) fprintf(stderr, "kernel_launch: %d CUs; built for 256\n", grid);
    }
    if (grid < 0) return;
    if (hipMemsetAsync(d_ws, 0, 16384, stream) != hipSuccess) { fprintf(stderr, "kernel_launch: memset failed\n"); return; }
    Args a{};
    for (int i = 0; i < 16; ++i) a.in[i] = (const float*)d_in[i];
    a.out = (float*)d_out; a.ws = (unsigned char*)d_ws;
#if MK_N_LAUNCHES == 1
    a.ph_lo = 0; a.ph_hi = N_PHASES;
    void* kargs[] = {&a};
    hipError_t e = hipLaunchCooperativeKernel((const void*)fwd_megakernel, dim3(grid), dim3(NWAVES * 64), kargs, LDS_BYTES, stream);
    if (e != hipSuccess) fprintf(stderr, "kernel_launch: cooperative launch failed: %s (grid %d)\n", hipGetErrorString(e), grid);
#else
    for (int li = 0; li < N_PHASES; ++li) { a.ph_lo = li; a.ph_hi = li + 1; hipLaunchKernelGGL(fwd_megakernel, dim3(grid), dim3(NWAVES * 64), LDS_BYTES, stream, a); }
#endif
}
```

```cpp
#include <hip/hip_runtime.h>
#include <hip/hip_cooperative_groups.h>
#include <cstdio>
#include <cstdint>
namespace cg = cooperative_groups;

#ifndef MK_N_LAUNCHES
#define MK_N_LAUNCHES 1
#endif
constexpr int N_PHASES = 9;

#define LAS __attribute__((address_space(3)))
typedef unsigned short bf16_t;
typedef short bf16x8 __attribute__((ext_vector_type(8)));
typedef short s16x4 __attribute__((ext_vector_type(4)));
typedef float f32x4 __attribute__((ext_vector_type(4)));
typedef float f32x2 __attribute__((ext_vector_type(2)));
typedef float f32x16 __attribute__((ext_vector_type(16)));
typedef unsigned u32x4 __attribute__((ext_vector_type(4)));
typedef unsigned u32x2 __attribute__((ext_vector_type(2)));
typedef __bf16 bf16x2_t __attribute__((ext_vector_type(2)));

constexpr int BATCH = 16, SEQ = 2048, DM = 1024, M = BATCH * SEQ, NH = 8, HD = 64, DFF = 4096, DPLE = 256;
constexpr int NIN_SRC = 5128, NQKV = 3072, NGATE = 2048, NIN = NQKV + NGATE;
constexpr float EPS = 1e-6f;
constexpr float LOG2E = 1.4426950408889634f;
constexpr float C2 = 0.125f * LOG2E;

constexpr size_t MiB = 1u << 20;
constexpr size_t WS_WIN = 2 * MiB, WS_WBF = 12 * MiB, WS_WBS = 13 * MiB, WS_WOUT = 14 * MiB, WS_WUP = 16 * MiB, WS_WDN = 24 * MiB, WS_WPG = 32 * MiB, WS_WPLE = 34 * MiB;
constexpr size_t WS_LOGF = 36 * MiB, WS_CC = 37 * MiB, WS_SSQ1 = 38 * MiB, WS_SSQ2 = 40 * MiB;
constexpr size_t WS_PB = 42 * MiB, WS_BUFA = 58 * MiB, WS_BUFB = 122 * MiB, WS_QKV = 186 * MiB, WS_SG = 378 * MiB, WS_H = 186 * MiB, WS_E = 442 * MiB, WS_END = 506 * MiB;

__device__ __forceinline__ unsigned cvt_pk_bf16(float lo, float hi) { f32x2 v = {lo, hi}; bf16x2_t b = __builtin_convertvector(v, bf16x2_t); return __builtin_bit_cast(unsigned, b); }
__device__ __forceinline__ float bf_lo(unsigned w) { return __uint_as_float(w << 16); }
__device__ __forceinline__ float bf_hi(unsigned w) { return __uint_as_float(w & 0xffff0000u); }
__device__ __forceinline__ float fast_sigmoid(float v) { return __builtin_amdgcn_rcpf(1.0f + __builtin_amdgcn_exp2f(-v * LOG2E)); }

__device__ __forceinline__ const char* uni_ptr(const char* p) { const unsigned long long v = (unsigned long long)p; const unsigned lo = __builtin_amdgcn_readfirstlane((unsigned)v), hi = __builtin_amdgcn_readfirstlane((unsigned)(v >> 32)); return (const char*)(((unsigned long long)hi << 32) | lo); }
namespace pg8 {
constexpr int BM = 256, BK = 64, HALF = 128, HTB = HALF * BK * 2, STAGE_BYTES = 8 * HTB, NXCD = 8, WGM = 8;
__host__ __device__ __forceinline__ int lds_byte(int r, int c) { const int st = (r >> 4) * 2 + (c >> 5), rr = r & 15, cc = c & 31, ob = rr * 64 + cc * 2; return st * 1024 + (ob ^ (((ob >> 9) & 1) << 5)); }
__host__ __device__ __forceinline__ void stage_rc(int b, int& R, int& C) { const int st = b / 1024, sb = b % 1024, swz = sb ^ (((sb >> 9) & 1) << 5); R = (st >> 1) * 16 + swz / 64; C = (st & 1) * 32 + (swz % 64) / 2; }
__host__ __device__ __forceinline__ int perm32(int rho) { const int n = rho >> 4, i = rho & 15; return 8 * (i >> 2) + 4 * n + (i & 3); }

struct Unit { int pm, pn; const char* A; const char* B; int chain; };
struct Gemm { int lda, ldb, K; };

struct TileOrder {
    int nM, nN, nwg, G, c;
    __device__ void init(int Mrows, int N, int G_, int c_) { nM = Mrows / BM; nN = N / BM; nwg = nM * nN; G = G_; c = c_; }
    __device__ bool tile(int i, int& pm, int& pn) const {
        const long L = (long)i * G + c; if (L >= nwg) return false;
        int wgid = (int)L; { const int q = nwg / NXCD, r = nwg % NXCD, xcd = wgid % NXCD, off = wgid / NXCD; wgid = (xcd < r ? xcd * (q + 1) : r * (q + 1) + (xcd - r) * q) + off; }
        const int nig = WGM * nN, gid = wgid / nig, fm = gid * WGM, gsz = (nM - fm) < WGM ? (nM - fm) : WGM;
        pm = fm + ((wgid % nig) % gsz); pn = (wgid % nig) / gsz; return true;
    }
};
struct PlainSched {
    TileOrder T; const char* A; const char* B; size_t astep, bstep;
    __device__ bool next(int i, Unit& u) const { int pm, pn; if (!T.tile(i, pm, pn)) return false; u.pm = pm; u.pn = pn; u.A = A + (size_t)pm * astep; u.B = B + (size_t)pn * bstep; u.chain = 0; return true; }
};
struct PairSched {
    TileOrder T; const char* A0; const char* A1; const char* B0; const char* B1; size_t astep, bstep;
    __device__ bool next(int i, Unit& u) const { int pm, pn; if (!T.tile(i >> 1, pm, pn)) return false; const int s = i & 1; u.pm = pm; u.pn = pn;
        u.A = (s ? A1 : A0) + (size_t)pm * astep; u.B = (s ? B1 : B0) + (size_t)pn * bstep; u.chain = s ? 0 : 1; return true; }
};

typedef f32x4 Acc[2][2][4][2];

struct EpiQKVG {
    static constexpr bool PERM = true;
    bf16_t* QKV; bf16_t* SG; const float* bgate;
    __device__ __forceinline__ void operator()(Acc& acc, const Unit& u, int wr, int wc, int fr, int fq, LAS float* tab, int tid) const {
        const int row0 = u.pm * BM + wr * 64 + fr;
        if (u.pn < 12) {
            const float sc = (u.pn < 2 || (u.pn >= 6 && u.pn < 8)) ? C2 : 1.0f;
            const int col0 = u.pn * BM + wc * 32 + 8 * fq;
#pragma unroll
            for (int ai = 0; ai < 2; ++ai)
#pragma unroll
                for (int m = 0; m < 4; ++m) { bf16_t* rowp = QKV + (size_t)(row0 + ai * HALF + m * 16) * NQKV + col0;
#pragma unroll
                    for (int bj = 0; bj < 2; ++bj) { const f32x4 v0 = acc[ai][bj][m][0] * sc, v1 = acc[ai][bj][m][1] * sc;
                        u32x4 w; w.x = cvt_pk_bf16(v0[0], v0[1]); w.y = cvt_pk_bf16(v0[2], v0[3]); w.z = cvt_pk_bf16(v1[0], v1[1]); w.w = cvt_pk_bf16(v1[2], v1[3]);
                        *(u32x4*)(rowp + bj * HALF) = w; } }
        } else {
            const int col0 = (u.pn - 12) * BM + wc * 32 + 8 * fq;
            f32x4 bv[2][2];
#pragma unroll
            for (int bj = 0; bj < 2; ++bj)
#pragma unroll
                for (int n = 0; n < 2; ++n) bv[bj][n] = *(const f32x4*)(bgate + col0 + bj * HALF + 4 * n);
#pragma unroll
            for (int ai = 0; ai < 2; ++ai)
#pragma unroll
                for (int m = 0; m < 4; ++m) { bf16_t* rowp = SG + (size_t)(row0 + ai * HALF + m * 16) * NGATE + col0;
#pragma unroll
                    for (int bj = 0; bj < 2; ++bj) { const f32x4 a0 = acc[ai][bj][m][0] + bv[bj][0], a1 = acc[ai][bj][m][1] + bv[bj][1];
                        u32x4 w; w.x = cvt_pk_bf16(fast_sigmoid(a0[0]), fast_sigmoid(a0[1])); w.y = cvt_pk_bf16(fast_sigmoid(a0[2]), fast_sigmoid(a0[3]));
                        w.z = cvt_pk_bf16(fast_sigmoid(a1[0]), fast_sigmoid(a1[1])); w.w = cvt_pk_bf16(fast_sigmoid(a1[2]), fast_sigmoid(a1[3]));
                        *(u32x4*)(rowp + bj * HALF) = w; } }
        }
    }
};
struct EpiBf16 {
    static constexpr bool PERM = true;
    bf16_t* O; int ldc;
    __device__ __forceinline__ void operator()(Acc& acc, const Unit& u, int wr, int wc, int fr, int fq, LAS float* tab, int tid) const {
        const int row0 = u.pm * BM + wr * 64 + fr, col0 = u.pn * BM + wc * 32 + 8 * fq;
#pragma unroll
        for (int ai = 0; ai < 2; ++ai)
#pragma unroll
            for (int m = 0; m < 4; ++m) { bf16_t* rowp = O + (size_t)(row0 + ai * HALF + m * 16) * ldc + col0;
#pragma unroll
                for (int bj = 0; bj < 2; ++bj) { const f32x4 v0 = acc[ai][bj][m][0], v1 = acc[ai][bj][m][1];
                    u32x4 w; w.x = cvt_pk_bf16(v0[0], v0[1]); w.y = cvt_pk_bf16(v0[2], v0[3]); w.z = cvt_pk_bf16(v1[0], v1[1]); w.w = cvt_pk_bf16(v1[2], v1[3]);
                    *(u32x4*)(rowp + bj * HALF) = w; } }
    }
};
__device__ __forceinline__ f32x4 bf4_lo(const u32x4 w) { return (f32x4){bf_lo(w.x), bf_hi(w.x), bf_lo(w.y), bf_hi(w.y)}; }
__device__ __forceinline__ f32x4 bf4_hi(const u32x4 w) { return (f32x4){bf_lo(w.z), bf_hi(w.z), bf_lo(w.w), bf_hi(w.w)}; }
__device__ __forceinline__ u32x4 pack8(const f32x4 v0, const f32x4 v1) { u32x4 w; w.x = cvt_pk_bf16(v0[0], v0[1]); w.y = cvt_pk_bf16(v0[2], v0[3]); w.z = cvt_pk_bf16(v1[0], v1[1]); w.w = cvt_pk_bf16(v1[2], v1[3]); return w; }
struct EpiBranch {
    static constexpr bool PERM = true;
    const bf16_t* SG; bf16_t* MG;
    __device__ __forceinline__ void operator()(Acc& acc, const Unit& u, int wr, int wc, int fr, int fq, LAS float* tab, int tid) const {
        const int row0 = u.pm * BM + wr * 64 + fr, col0 = u.pn * BM + wc * 32 + 8 * fq;
#pragma unroll
        for (int ai = 0; ai < 2; ++ai) {
            u32x4 ga[4][2], gb[4][2];
#pragma unroll
            for (int m = 0; m < 4; ++m)
#pragma unroll
                for (int bj = 0; bj < 2; ++bj) { const bf16_t* p = SG + (size_t)(row0 + ai * HALF + m * 16) * NGATE + col0 + bj * HALF; gb[m][bj] = *(const u32x4*)(p + DM); if (u.chain) ga[m][bj] = *(const u32x4*)p; }
#pragma unroll
            for (int m = 0; m < 4; ++m)
#pragma unroll
                for (int bj = 0; bj < 2; ++bj) { const f32x4 b0 = bf4_lo(gb[m][bj]), b1 = bf4_hi(gb[m][bj]);
                    if (u.chain) { const f32x4 a0 = bf4_lo(ga[m][bj]), a1 = bf4_hi(ga[m][bj]);
#pragma unroll
                        for (int e = 0; e < 4; ++e) { acc[ai][bj][m][0][e] *= a0[e] * __builtin_amdgcn_rcpf(fmaxf(b0[e], 1e-30f)); acc[ai][bj][m][1][e] *= a1[e] * __builtin_amdgcn_rcpf(fmaxf(b1[e], 1e-30f)); }
                    } else *(u32x4*)(MG + (size_t)(row0 + ai * HALF + m * 16) * DM + col0 + bj * HALF) = pack8(acc[ai][bj][m][0] * b0, acc[ai][bj][m][1] * b1); }
            asm volatile("" ::: "memory");
        }
    }
};
__device__ __forceinline__ void ssq_publish(LAS float* tab, float* ssq, const Unit& u, int tid) {
    asm volatile("s_waitcnt lgkmcnt(0)" ::: "memory"); __builtin_amdgcn_s_barrier(); asm volatile("" ::: "memory");
    if (tid < 256) { const f32x4 t = *(const LAS f32x4*)(tab + tid * 4); ssq[(size_t)(u.pm * BM + tid) * 4 + u.pn] = (t[0] + t[1]) + (t[2] + t[3]); }
}
struct EpiRes4 {
    static constexpr bool PERM = true;
    const float* base; bf16_t* xb; float* ssq;
    __device__ __forceinline__ void operator()(Acc& acc, const Unit& u, int wr, int wc, int fr, int fq, LAS float* tab, int tid) const {
        const int row0 = u.pm * BM + wr * 64 + fr, col0 = u.pn * BM + wc * 32 + 8 * fq;
#pragma unroll
        for (int ai = 0; ai < 2; ++ai) {
            f32x4 bs[4][2][2];
#pragma unroll
            for (int m = 0; m < 4; ++m)
#pragma unroll
                for (int bj = 0; bj < 2; ++bj)
#pragma unroll
                    for (int n = 0; n < 2; ++n) bs[m][bj][n] = *(const f32x4*)(base + (size_t)(row0 + ai * HALF + m * 16) * DM + col0 + bj * HALF + 4 * n);
#pragma unroll
            for (int m = 0; m < 4; ++m) { float s = 0.f;
#pragma unroll
                for (int bj = 0; bj < 2; ++bj) { const f32x4 x0 = bs[m][bj][0] + acc[ai][bj][m][0], x1 = bs[m][bj][1] + acc[ai][bj][m][1];
                    s += ((x0[0] * x0[0] + x0[1] * x0[1]) + (x0[2] * x0[2] + x0[3] * x0[3])) + ((x1[0] * x1[0] + x1[1] * x1[1]) + (x1[2] * x1[2] + x1[3] * x1[3]));
                    *(u32x4*)(xb + (size_t)(row0 + ai * HALF + m * 16) * DM + col0 + bj * HALF) = pack8(x0, x1); }
                s += __shfl_xor(s, 16); s += __shfl_xor(s, 32);
                if (fq == 0) tab[(ai * HALF + wr * 64 + m * 16 + fr) * 4 + wc] = s; }
            asm volatile("" ::: "memory");
        }
        ssq_publish(tab, ssq, u, tid);
    }
};
struct EpiRes6 {
    static constexpr bool PERM = true;
    const bf16_t* xin; bf16_t* xb; float* ssq;
    __device__ __forceinline__ void operator()(Acc& acc, const Unit& u, int wr, int wc, int fr, int fq, LAS float* tab, int tid) const {
        const int row0 = u.pm * BM + wr * 64 + fr, col0 = u.pn * BM + wc * 32 + 8 * fq;
        u32x4 xi[2][4][2];
#pragma unroll
        for (int ai = 0; ai < 2; ++ai)
#pragma unroll
            for (int m = 0; m < 4; ++m)
#pragma unroll
                for (int bj = 0; bj < 2; ++bj) xi[ai][m][bj] = *(const u32x4*)(xin + (size_t)(row0 + ai * HALF + m * 16) * DM + col0 + bj * HALF);
#pragma unroll
        for (int ai = 0; ai < 2; ++ai)
#pragma unroll
            for (int m = 0; m < 4; ++m) { float s = 0.f;
#pragma unroll
                for (int bj = 0; bj < 2; ++bj) { const f32x4 x0 = bf4_lo(xi[ai][m][bj]) + acc[ai][bj][m][0], x1 = bf4_hi(xi[ai][m][bj]) + acc[ai][bj][m][1];
                    s += ((x0[0] * x0[0] + x0[1] * x0[1]) + (x0[2] * x0[2] + x0[3] * x0[3])) + ((x1[0] * x1[0] + x1[1] * x1[1]) + (x1[2] * x1[2] + x1[3] * x1[3]));
                    *(u32x4*)(xb + (size_t)(row0 + ai * HALF + m * 16) * DM + col0 + bj * HALF) = pack8(x0, x1); }
                s += __shfl_xor(s, 16); s += __shfl_xor(s, 32);
                if (fq == 0) tab[(ai * HALF + wr * 64 + m * 16 + fr) * 4 + wc] = s; }
        ssq_publish(tab, ssq, u, tid);
    }
};
__device__ __forceinline__ float rstd_of(const f32x4 q) { return __builtin_amdgcn_rsqf(((q[0] + q[1]) + (q[2] + q[3])) * (1.0f / DM) + EPS); }
struct EpiUp {
    static constexpr bool PERM = true;
    bf16_t* H; const float* ssq;
    __device__ __forceinline__ void operator()(Acc& acc, const Unit& u, int wr, int wc, int fr, int fq, LAS float* tab, int tid) const {
        const int row0 = u.pm * BM + wr * 64 + fr, col0 = u.pn * BM + wc * 32 + 8 * fq;
        f32x4 sq[2][4];
#pragma unroll
        for (int ai = 0; ai < 2; ++ai)
#pragma unroll
            for (int m = 0; m < 4; ++m) sq[ai][m] = *(const f32x4*)(ssq + (size_t)(row0 + ai * HALF + m * 16) * 4);
#pragma unroll
        for (int ai = 0; ai < 2; ++ai)
#pragma unroll
            for (int m = 0; m < 4; ++m) { const float r = rstd_of(sq[ai][m]); bf16_t* rowp = H + (size_t)(row0 + ai * HALF + m * 16) * DFF + col0;
#pragma unroll
                for (int bj = 0; bj < 2; ++bj) { f32x4 v0 = acc[ai][bj][m][0] * r, v1 = acc[ai][bj][m][1] * r;
#pragma unroll
                    for (int e = 0; e < 4; ++e) { const float a = fmaxf(v0[e], 0.f), b = fmaxf(v1[e], 0.f); v0[e] = a * a; v1[e] = b * b; }
                    *(u32x4*)(rowp + bj * HALF) = pack8(v0, v1); } }
    }
};
struct EpiPle {
    static constexpr bool PERM = true;
    const bf16_t* xin; bf16_t* xb; const bf16_t* E; const float* ssq;
    __device__ __forceinline__ void operator()(Acc& acc, const Unit& u, int wr, int wc, int fr, int fq, LAS float* tab, int tid) const {
        const int row0 = u.pm * BM + wr * 64 + fr, col0 = u.pn * BM + wc * 32 + 8 * fq;
#pragma unroll
        for (int ai = 0; ai < 2; ++ai)
#pragma unroll
            for (int mh = 0; mh < 2; ++mh) {
                u32x4 xi[2][2], ei[2][2]; f32x4 sq[2];
#pragma unroll
                for (int mm = 0; mm < 2; ++mm) { const int row = row0 + ai * HALF + (2 * mh + mm) * 16; sq[mm] = *(const f32x4*)(ssq + (size_t)row * 4);
#pragma unroll
                    for (int bj = 0; bj < 2; ++bj) { const size_t off = (size_t)row * DM + col0 + bj * HALF; xi[mm][bj] = *(const u32x4*)(xin + off); ei[mm][bj] = *(const u32x4*)(E + off); } }
#pragma unroll
                for (int mm = 0; mm < 2; ++mm) { const int m = 2 * mh + mm; const float r = rstd_of(sq[mm]);
#pragma unroll
                    for (int bj = 0; bj < 2; ++bj) { const f32x4 a0 = acc[ai][bj][m][0] * r, a1 = acc[ai][bj][m][1] * r, e0 = bf4_lo(ei[mm][bj]), e1 = bf4_hi(ei[mm][bj]); f32x4 o0 = bf4_lo(xi[mm][bj]), o1 = bf4_hi(xi[mm][bj]);
#pragma unroll
                        for (int e = 0; e < 4; ++e) { o0[e] += fast_sigmoid(a0[e]) * e0[e]; o1[e] += fast_sigmoid(a1[e]) * e1[e]; }
                        *(u32x4*)(xb + (size_t)(row0 + ai * HALF + m * 16) * DM + col0 + bj * HALF) = pack8(o0, o1); } }
                asm volatile("" ::: "memory");
            }
    }
};

template <class Epi, class Sched>
__device__ __forceinline__ void gemm_phase(LAS unsigned char* lds, const Gemm g, const Sched& S, const Epi& E) {
    const int tid = threadIdx.x, wid = __builtin_amdgcn_readfirstlane(tid >> 6), lane = tid & 63, wr = wid >> 2, wc = wid & 3, fr = lane & 15, fq = lane >> 4;
    const int K = g.K, nt = K / BK;
    unsigned voffA[2], voffB[2];
#pragma unroll
    for (int i = 0; i < 2; ++i) { int R, C; stage_rc(tid * 16 + i * 8192, R, C); const int Rb = Epi::PERM ? ((R & ~31) + perm32(R & 31)) : R;
        voffA[i] = (unsigned)(R * g.lda + C) * 2u; voffB[i] = (unsigned)(Rb * g.ldb + C) * 2u; }
    const size_t kstep = (size_t)(BK * 2);
    const size_t hA = (size_t)HALF * g.lda * 2, hB = (size_t)HALF * g.ldb * 2;
    const unsigned ldsw = (unsigned)wid * 1024u;
    const int aoff = lds_byte(wr * 64 + fr, fq * 8), boff = lds_byte(wc * 32 + fr, fq * 8);
#define PG8_SA(b, h) (((b) * 2 + (h)) * HTB)
#define PG8_SB(b, h) ((4 + (b) * 2 + (h)) * HTB)
#define PG8_STAGE(bufoff, gbase, voff) do { _Pragma("unroll") for (int _i = 0; _i < 2; ++_i) \
        __builtin_amdgcn_global_load_lds((const unsigned*)((const char*)(gbase) + (voff)[_i]), (LAS unsigned*)(lds + (bufoff) + ldsw + _i * 8192), 16, 0, 0); } while (0)
#define PG8_LDA(dst, b, h) do { _Pragma("unroll") for (int m = 0; m < 4; ++m) _Pragma("unroll") for (int k = 0; k < 2; ++k) dst[m][k] = *(const LAS bf16x8*)(lds + PG8_SA(b, h) + aoff + m * 2048 + k * 1024); } while (0)
#define PG8_LDB(dst, b, h) do { _Pragma("unroll") for (int n = 0; n < 2; ++n) _Pragma("unroll") for (int k = 0; k < 2; ++k) dst[n][k] = *(const LAS bf16x8*)(lds + PG8_SB(b, h) + boff + n * 2048 + k * 1024); } while (0)
#define PG8_MMA(ai, bj, At, Bt) do { __builtin_amdgcn_s_setprio(1); _Pragma("unroll") for (int m = 0; m < 4; ++m) _Pragma("unroll") for (int n = 0; n < 2; ++n) _Pragma("unroll") for (int k = 0; k < 2; ++k) \
        acc[ai][bj][m][n] = __builtin_amdgcn_mfma_f32_16x16x32_bf16(Bt[n][k], At[m][k], acc[ai][bj][m][n], 0, 0, 0); __builtin_amdgcn_s_setprio(0); } while (0)
#define PG8_WAIT_V(n) asm volatile("s_waitcnt vmcnt(" #n ")" ::: "memory")
#define PG8_WAIT_L(n) asm volatile("s_waitcnt lgkmcnt(" #n ")" ::: "memory")
#define PG8_BAR __builtin_amdgcn_s_barrier()
#define PG8_SCHED __builtin_amdgcn_sched_barrier(0)
#define PG8_ZERO() do { _Pragma("unroll") for (int a = 0; a < 2; ++a) _Pragma("unroll") for (int b = 0; b < 2; ++b) _Pragma("unroll") for (int m = 0; m < 4; ++m) _Pragma("unroll") for (int n = 0; n < 2; ++n) acc[a][b][m][n] = (f32x4){0.f, 0.f, 0.f, 0.f}; } while (0)
    Unit cur, nxt; int ui = 0;
    if (!S.next(0, cur)) return;
    Acc acc;
    PG8_ZERO();
    bf16x8 At[4][2], B0[2][2], B1[2][2];
    const char* cA = uni_ptr(cur.A); const char* cB = uni_ptr(cur.B);
    PG8_STAGE(PG8_SB(0, 0), cB, voffB); PG8_STAGE(PG8_SB(0, 1), cB + hB, voffB); PG8_STAGE(PG8_SA(0, 0), cA, voffA); PG8_STAGE(PG8_SA(0, 1), cA + hA, voffA);
    if (wr == 1) PG8_BAR;
    PG8_WAIT_V(2); PG8_BAR;
    PG8_STAGE(PG8_SB(1, 0), cB + kstep, voffB); PG8_STAGE(PG8_SA(1, 0), cA + kstep, voffA); PG8_STAGE(PG8_SB(1, 1), cB + hB + kstep, voffB);
    PG8_WAIT_V(6); PG8_BAR;
    for (;;) {
        const bool has_next = S.next(ui + 1, nxt);
        const char* nA = uni_ptr(has_next ? nxt.A : cA); const char* nB = uni_ptr(has_next ? nxt.B : cB);
#pragma nounroll
        for (int t = 0; t < nt; t += 2) {
            const bool last = (t == nt - 2);
            const char* a1 = cA + (size_t)(t + 1) * kstep;
            const char* a2 = last ? nA : cA + (size_t)(t + 2) * kstep; const char* b2 = last ? nB : cB + (size_t)(t + 2) * kstep;
            const char* a3 = a2 + kstep; const char* b3 = b2 + kstep;
            PG8_LDB(B0, 0, 0); PG8_LDB(B1, 0, 1); PG8_SCHED; PG8_LDA(At, 0, 0); PG8_STAGE(PG8_SA(1, 1), a1 + hA, voffA);
            PG8_WAIT_V(8); PG8_WAIT_L(0); PG8_BAR; PG8_MMA(0, 0, At, B0); PG8_MMA(0, 1, At, B1); PG8_BAR; PG8_SCHED;
            PG8_LDA(At, 0, 1); PG8_STAGE(PG8_SB(0, 0), b2, voffB); PG8_STAGE(PG8_SB(0, 1), b2 + hB, voffB); PG8_STAGE(PG8_SA(0, 0), a2, voffA);
            PG8_WAIT_V(8); PG8_WAIT_L(0); PG8_BAR; PG8_MMA(1, 0, At, B0); PG8_MMA(1, 1, At, B1); PG8_BAR; PG8_SCHED;
            PG8_LDB(B0, 1, 0); PG8_LDB(B1, 1, 1); PG8_SCHED; PG8_LDA(At, 1, 0); PG8_STAGE(PG8_SA(0, 1), a2 + hA, voffA);
            PG8_WAIT_V(8); PG8_WAIT_L(0); PG8_BAR; PG8_MMA(0, 0, At, B0); PG8_MMA(0, 1, At, B1); PG8_BAR; PG8_SCHED;
            PG8_LDA(At, 1, 1); PG8_STAGE(PG8_SB(1, 0), b3, voffB); PG8_STAGE(PG8_SB(1, 1), b3 + hB, voffB); PG8_STAGE(PG8_SA(1, 0), a3, voffA);
            PG8_WAIT_V(8); PG8_WAIT_L(0); PG8_BAR; PG8_MMA(1, 0, At, B0); PG8_MMA(1, 1, At, B1); PG8_BAR; PG8_SCHED;
        }
        if (wr == 0) PG8_BAR;
        E(acc, cur, wr, wc, fr, fq, (LAS float*)(lds + STAGE_BYTES + 64), tid);
        if (!has_next) break;
        if (!cur.chain) PG8_ZERO();
        cur = nxt; cA = nA; cB = nB; ++ui;
        if (wr == 1) PG8_BAR;
    }
    PG8_WAIT_V(0);
    PG8_BAR;
#undef PG8_SA
#undef PG8_SB
#undef PG8_STAGE
#undef PG8_LDA
#undef PG8_LDB
#undef PG8_MMA
#undef PG8_WAIT_V
#undef PG8_WAIT_L
#undef PG8_BAR
#undef PG8_SCHED
#undef PG8_ZERO
}
}

namespace att {
constexpr int PITCH = NQKV, OPITCH = DM;
constexpr int NSLOT = 4, SLOT = 16384, L_K = 0, L_V = 8192;
constexpr int L_CB = NSLOT * SLOT, L_WS = L_CB + SEQ * 4, L_OST = L_WS + 8 * 256, L_FLAG = L_OST + 8 * 4096, L_END = L_FLAG + 64;
constexpr float SB_THR = -160.0f;
__device__ __forceinline__ int crow(int r, int hi) { return (r & 3) + 8 * (r >> 2) + 4 * hi; }
__device__ __forceinline__ s16x4 vtr(const LAS unsigned char* p) { typedef short v4i16_t __attribute__((ext_vector_type(4))); return __builtin_bit_cast(s16x4, __builtin_amdgcn_ds_read_tr16_b64_v4i16((LAS v4i16_t*)p)); }
__device__ __forceinline__ void swap_halves(float v, float& lo, float& hi_) { auto rr = __builtin_amdgcn_permlane32_swap(__float_as_uint(v), __float_as_uint(v), false, false); lo = __uint_as_float(rr[0]); hi_ = __uint_as_float(rr[1]); }

template <int KIND>
__device__ __forceinline__ void attn_unit(int b, int h, int qb, const bf16_t* QKV, const float* cc, bf16_t* O, LAS unsigned char* lds) {
    const int tid = threadIdx.x, lane = tid & 63, r32 = lane & 31, hi = lane >> 5; const int wid = __builtin_amdgcn_readfirstlane(tid >> 6);
    const size_t rowbase = (size_t)b * SEQ; const int q0 = qb * 256, qw = q0 + wid * 32, qabs = qw + r32;
    const int colq = KIND * 1536 + h * HD;
    const bf16_t* ksrc = QKV + rowbase * PITCH + colq + 512 + (size_t)lane * PITCH + wid * 8;
    const bf16_t* vsrc = QKV + rowbase * PITCH + colq + 1024 + (size_t)(16 * (wid & 3) + (lane >> 2)) * PITCH + (wid >> 2) * 32 + (lane & 3) * 8;
    const int wdst = wid * 1024;
    const int nIter = qb * 4 + 4, T_last = nIter - 1, td = qw >> 6;
#define ATT_DMA(itx) do { const int t_ = T_last - (itx); LAS unsigned char* sl_ = lds + ((itx) & (NSLOT - 1)) * SLOT + wdst; \
        __builtin_amdgcn_global_load_lds((const unsigned*)(ksrc + (size_t)t_ * 64 * PITCH), (LAS unsigned*)(sl_ + L_K), 16, 0, 0); \
        __builtin_amdgcn_global_load_lds((const unsigned*)(vsrc + (size_t)t_ * 64 * PITCH), (LAS unsigned*)(sl_ + L_V), 16, 0, 0); } while (0)
    ATT_DMA(0); ATT_DMA(1); ATT_DMA(2);
    const bf16_t* Qw = QKV + (rowbase + qw) * PITCH + colq;
    bf16x8 qr[4];
#pragma unroll
    for (int d0 = 0; d0 < 4; ++d0) qr[d0] = *(const bf16x8*)(Qw + (size_t)r32 * PITCH + d0 * 16 + hi * 8);
    LAS float* wsf = (LAS float*)(lds + L_WS) + wid * 64;
    LAS unsigned* flags = (LAS unsigned*)(lds + L_FLAG);
    LAS float* cbl = (LAS float*)(lds + L_CB);
    if (KIND == 0) { const float* ccb = cc + (size_t)(b * NH + h) * SEQ; const float cref = ccb[q0 + 255]; const f32x4 c4 = *((const f32x4*)ccb + tid); *((LAS f32x4*)cbl + tid) = cref - c4; }
    f32x16 o[2]; o[0] = (f32x16){}; o[1] = (f32x16){};
    float mrun = -INFINITY, lrun = 0.f, R = 0.f; bool mydone = false;
    for (int it = 0; it < nIter; ++it) {
        const int t = T_last - it; const int ahead = nIter - 1 - it;
        if (ahead >= 2) asm volatile("s_waitcnt vmcnt(4) lgkmcnt(0)" ::: "memory"); else if (ahead == 1) asm volatile("s_waitcnt vmcnt(2) lgkmcnt(0)" ::: "memory"); else asm volatile("s_waitcnt vmcnt(0) lgkmcnt(0)" ::: "memory");
        __builtin_amdgcn_s_barrier(); asm volatile("" ::: "memory");
        if (KIND == 1 && it > 0) { const u32x4 fa = *(const LAS u32x4*)(flags + ((it - 1) & 1) * 8), fb = *(const LAS u32x4*)(flags + ((it - 1) & 1) * 8 + 4);
            if ((fa.x & fa.y & fa.z & fa.w & fb.x & fb.y & fb.z & fb.w) != 0u) break; }
        if (it + 3 < nIter) ATT_DMA(it + 3);
        if (t <= td && !mydone) {
            const LAS unsigned char* slot = lds + (it & (NSLOT - 1)) * SLOT;
            f32x16 p0, p1;
            if (KIND == 0) {
                const LAS f32x4* cb4 = (const LAS f32x4*)(cbl + t * 64 + 4 * hi);
#pragma unroll
                for (int g = 0; g < 4; ++g) { const f32x4 c0 = cb4[2 * g], c1 = cb4[8 + 2 * g];
#pragma unroll
                    for (int i = 0; i < 4; ++i) { p0[4 * g + i] = c0[i]; p1[4 * g + i] = c1[i]; } }
            } else { p0 = (f32x16){}; p1 = (f32x16){}; }
            const LAS unsigned char* kb = slot + L_K + hi * 1024 + r32 * 16;
#pragma unroll
            for (int d0 = 0; d0 < 4; ++d0) { const bf16x8 b0 = *(const LAS bf16x8*)(kb + d0 * 2048), b1 = *(const LAS bf16x8*)(kb + d0 * 2048 + 512);
                p0 = __builtin_amdgcn_mfma_f32_32x32x16_bf16(b0, qr[d0], p0, 0, 0, 0); p1 = __builtin_amdgcn_mfma_f32_32x32x16_bf16(b1, qr[d0], p1, 0, 0, 0); }
            s16x4 vlo[8], vhi[8];
#define ATT_VREAD() do { const unsigned vb = (unsigned)(uintptr_t)(slot + L_V + ((lane >> 4) & 1) * 32 + (lane & 3) * 8 + (4 * hi + ((lane & 15) >> 2)) * 64); \
              _Pragma("unroll") for (int i = 0; i < 8; ++i) { \
                asm volatile("ds_read_b64_tr_b16 %0, %1 offset:%c2" : "=&v"(vlo[i]) : "v"(vb), "i"((i >> 2) * 4096 + (i & 3) * 1024) : "memory"); \
                asm volatile("ds_read_b64_tr_b16 %0, %1 offset:%c2" : "=&v"(vhi[i]) : "v"(vb), "i"((i >> 2) * 4096 + (i & 3) * 1024 + 512) : "memory"); } } while (0)
            if (KIND == 0) ATT_VREAD();
            const bool diag = (t == td); const int kv0 = t * 64 + 4 * hi;
            if (KIND == 0) {
                if (diag) {
#pragma unroll
                    for (int r = 0; r < 16; ++r) { const int kv = kv0 + (r & 3) + 8 * (r >> 2); if (kv > qabs) p0[r] = -INFINITY; if (kv + 32 > qabs) p1[r] = -INFINITY; }
                }
                float rm = fmaxf(p0[0], p1[0]);
#pragma unroll
                for (int r = 1; r < 16; ++r) rm = fmaxf(rm, fmaxf(p0[r], p1[r]));
                { float a, c; swap_halves(rm, a, c); rm = fmaxf(a, c); }
                if (__any(rm > mrun + 8.0f)) {
                    const float mnew = fmaxf(mrun, rm); const float f = __builtin_amdgcn_exp2f(mrun - mnew); mrun = mnew; lrun *= f;
                    if (hi == 0) wsf[r32] = f;
                    asm volatile("s_waitcnt lgkmcnt(0)" ::: "memory");
#pragma unroll
                    for (int r = 0; r < 16; ++r) { const float fr_ = wsf[crow(r, hi)]; o[0][r] *= fr_; o[1][r] *= fr_; }
                    asm volatile("s_waitcnt lgkmcnt(0)" ::: "memory");
                }
                float ls = 0.f;
#pragma unroll
                for (int r = 0; r < 16; ++r) { p0[r] = __builtin_amdgcn_exp2f(p0[r] - mrun); p1[r] = __builtin_amdgcn_exp2f(p1[r] - mrun); ls += p0[r] + p1[r]; }
                lrun += ls;
            } else {
                f32x16 l0, l1;
#pragma unroll
                for (int r = 0; r < 16; ++r) {
                    { const float z = p0[r]; const float tt = __builtin_amdgcn_logf(1.0f + __builtin_amdgcn_exp2f(-fabsf(z))); l0[r] = -(fmaxf(z, 0.f) + tt); }
                    { const float z = p1[r]; const float tt = __builtin_amdgcn_logf(1.0f + __builtin_amdgcn_exp2f(-fabsf(z))); l1[r] = -(fmaxf(z, 0.f) + tt); }
                }
                if (diag) {
#pragma unroll
                    for (int r = 0; r < 16; ++r) { const int kv = kv0 + (r & 3) + 8 * (r >> 2); if (!(kv < qabs)) l0[r] = 0.f; if (!(kv + 32 < qabs)) l1[r] = 0.f; }
                }
                float G[8], Gp[8];
#pragma unroll
                for (int g = 0; g < 4; ++g) { G[g] = (l0[4 * g] + l0[4 * g + 1]) + (l0[4 * g + 2] + l0[4 * g + 3]); G[4 + g] = (l1[4 * g] + l1[4 * g + 1]) + (l1[4 * g + 2] + l1[4 * g + 3]); }
#pragma unroll
                for (int c = 0; c < 8; ++c) { float a, d; swap_halves(G[c], a, d); Gp[c] = hi ? a : d; }
                float cs = 0.f;
#pragma unroll
                for (int c = 7; c >= 0; --c) {
                    const float ex = cs + (hi ? 0.f : Gp[c]);
                    const int g = c & 3;
                    if (c >= 4) { float s3 = l1[4 * g + 3] + ex, s2 = l1[4 * g + 2] + s3, s1 = l1[4 * g + 1] + s2, s0 = l1[4 * g] + s1; l1[4 * g + 3] = s3; l1[4 * g + 2] = s2; l1[4 * g + 1] = s1; l1[4 * g] = s0; }
                    else        { float s3 = l0[4 * g + 3] + ex, s2 = l0[4 * g + 2] + s3, s1 = l0[4 * g + 1] + s2, s0 = l0[4 * g] + s1; l0[4 * g + 3] = s3; l0[4 * g + 2] = s2; l0[4 * g + 1] = s1; l0[4 * g] = s0; }
                    cs += G[c] + Gp[c];
                }
                ATT_VREAD();
#pragma unroll
                for (int r = 0; r < 16; ++r) { p0[r] = __builtin_amdgcn_exp2f(p0[r] + l0[r] + R); p1[r] = __builtin_amdgcn_exp2f(p1[r] + l1[r] + R); }
                if (diag) {
#pragma unroll
                    for (int r = 0; r < 16; ++r) { const int kv = kv0 + (r & 3) + 8 * (r >> 2); if (!(kv < qabs)) p0[r] = 0.f; if (!(kv + 32 < qabs)) p1[r] = 0.f; }
                }
                R += cs;
                mydone = __all(R < SB_THR);
            }
            u32x4 pw[4];
            pw[0] = (u32x4){cvt_pk_bf16(p0[0], p0[1]), cvt_pk_bf16(p0[2], p0[3]), cvt_pk_bf16(p0[4], p0[5]), cvt_pk_bf16(p0[6], p0[7])};
            pw[1] = (u32x4){cvt_pk_bf16(p0[8], p0[9]), cvt_pk_bf16(p0[10], p0[11]), cvt_pk_bf16(p0[12], p0[13]), cvt_pk_bf16(p0[14], p0[15])};
            pw[2] = (u32x4){cvt_pk_bf16(p1[0], p1[1]), cvt_pk_bf16(p1[2], p1[3]), cvt_pk_bf16(p1[4], p1[5]), cvt_pk_bf16(p1[6], p1[7])};
            pw[3] = (u32x4){cvt_pk_bf16(p1[8], p1[9]), cvt_pk_bf16(p1[10], p1[11]), cvt_pk_bf16(p1[12], p1[13]), cvt_pk_bf16(p1[14], p1[15])};
            asm volatile("s_waitcnt lgkmcnt(0)" ::: "memory"); __builtin_amdgcn_sched_barrier(0);
#pragma unroll
            for (int ks = 0; ks < 4; ++ks)
#pragma unroll
                for (int d0 = 0; d0 < 2; ++d0) { const int i = d0 * 4 + ks;
                    const bf16x8 vf = {vlo[i][0], vlo[i][1], vlo[i][2], vlo[i][3], vhi[i][0], vhi[i][1], vhi[i][2], vhi[i][3]};
                    o[d0] = __builtin_amdgcn_mfma_f32_32x32x16_bf16(__builtin_bit_cast(bf16x8, pw[ks]), vf, o[d0], 0, 0, 0); }
        }
        if (KIND == 1) { if (lane == 0) flags[(it & 1) * 8 + wid] = mydone ? 1u : 0u; }
    }
#undef ATT_DMA
#undef ATT_VREAD
    float inv = 1.0f;
    if (KIND == 0) { float a, c; swap_halves(lrun, a, c); inv = 1.0f / (a + c); }
    if (hi == 0) wsf[32 + r32] = inv;
    asm volatile("s_waitcnt lgkmcnt(0)" ::: "memory");
    LAS bf16_t* stg = (LAS bf16_t*)(lds + L_OST) + wid * 2048;
#pragma unroll
    for (int r = 0; r < 16; ++r) { const int orow = crow(r, hi); const float rl = wsf[32 + orow];
        const unsigned w = cvt_pk_bf16(o[0][r] * rl, o[1][r] * rl);
        stg[orow * 64 + r32] = (bf16_t)(w & 0xffffu); stg[orow * 64 + 32 + r32] = (bf16_t)(w >> 16); }
    asm volatile("s_waitcnt lgkmcnt(0)" ::: "memory");
    bf16_t* Ow = O + (rowbase + qw) * OPITCH + KIND * 512 + h * HD;
#pragma unroll
    for (int i = 0; i < 4; ++i) { const int row = i * 8 + (lane >> 3), ch = lane & 7; const u32x4 v = *(const LAS u32x4*)(stg + row * 64 + ch * 8); *(u32x4*)(Ow + (size_t)row * OPITCH + ch * 8) = v; }
    asm volatile("s_waitcnt vmcnt(0) lgkmcnt(0)" ::: "memory");
    __builtin_amdgcn_s_barrier(); asm volatile("" ::: "memory");
}
}

#define XB_TMO      128
#define XB_XCNT(j)  (256  + 64 * (j))
#define XB_XSUB(j)  (1280 + 64 * (j))
#define XB_XGEN(j)  (2304 + 64 * (j))
#define XB_TOP      3328
#define XB_TOPGEN   3392
#define XCD_BAR_WORDS 3456
#define XB_SPIN_CAP (1u << 18)
__device__ __forceinline__ unsigned xb_ld(unsigned* p)              { return __hip_atomic_load(p, __ATOMIC_RELAXED, __HIP_MEMORY_SCOPE_AGENT); }
__device__ __forceinline__ unsigned xb_add(unsigned* p, unsigned v) { return __hip_atomic_fetch_add(p, v, __ATOMIC_RELAXED, __HIP_MEMORY_SCOPE_AGENT); }
__device__ __forceinline__ unsigned xb_xcc_id() { return (unsigned)__builtin_amdgcn_s_getreg((3 << 11) | 20) & 0xFu; }
#define XB_SPIN(cond, bar) do { unsigned _sp = 0; while (cond) { __builtin_amdgcn_s_sleep(1); \
    if ((++_sp & 255u) == 0u) { if (xb_ld(&(bar)[XB_TMO])) break; if (_sp > XB_SPIN_CAP) { atomicAdd(&(bar)[XB_TMO], 1u); break; } } } } while (0)
struct XcdBarrier { unsigned* bar; unsigned x; volatile LAS unsigned* st; };
__device__ __forceinline__ XcdBarrier xcd_barrier_post(unsigned* bar, volatile LAS unsigned* st) {
    XcdBarrier b; b.bar = bar; b.x = xb_xcc_id(); b.st = st;
    if (threadIdx.x == 0) (void)xb_add(&bar[XB_XCNT(b.x)], 1u);
    return b;
}
__device__ __forceinline__ void xcd_barrier_complete(unsigned* bar, unsigned x, unsigned& nloc, unsigned& nx) {
    const unsigned G = gridDim.x * gridDim.y * gridDim.z;
    unsigned sum, cnt, mine, sp = 0u;
    for (;;) {
        sum = 0u; cnt = 0u; mine = 0u;
#pragma unroll
        for (unsigned j = 0; j < 16; ++j) { const unsigned c = xb_ld(&bar[XB_XCNT(j)]); sum += c; cnt += (c > 0u) ? 1u : 0u; mine = (j == x) ? c : mine; }
        if (sum == G) break;
        __builtin_amdgcn_s_sleep(1);
        if ((++sp & 255u) == 0u) { if (xb_ld(&bar[XB_TMO])) break; if (sp > XB_SPIN_CAP) { atomicAdd(&bar[XB_TMO], 1u); break; } }
    }
    nloc = mine > 0u ? mine : 1u; nx = cnt > 0u ? cnt : 1u;
}
__device__ __forceinline__ void xcd_barrier(const XcdBarrier& b) {
    asm volatile("s_waitcnt vmcnt(0)" ::: "memory");
    __syncthreads();
    if (threadIdx.x == 0) {
        unsigned* bar = b.bar;
        __builtin_amdgcn_s_waitcnt(0);
        unsigned nloc = b.st[0], nx = b.st[1];
        if (nloc == 0u) { xcd_barrier_complete(bar, b.x, nloc, nx); b.st[0] = nloc; b.st[1] = nx; }
        const unsigned old = xb_add(&bar[XB_XSUB(b.x)], 1u);
        const unsigned gen = old / nloc;
        if (old + 1u == (gen + 1u) * nloc) {
            __builtin_amdgcn_fence(__ATOMIC_RELEASE, "agent");
            asm volatile("s_waitcnt vmcnt(0)" ::: "memory");
            const unsigned og = xb_add(&bar[XB_TOP], 1u);
            const unsigned tg = og / nx;
            if (og + 1u == (tg + 1u) * nx) xb_add(&bar[XB_TOPGEN], 1u);
            else XB_SPIN(xb_ld(&bar[XB_TOPGEN]) == tg, bar);
            __builtin_amdgcn_fence(__ATOMIC_ACQUIRE, "agent");
            xb_add(&bar[XB_XGEN(b.x)], 1u);
            asm volatile("s_waitcnt vmcnt(0)" ::: "memory");
        } else {
            XB_SPIN(xb_ld(&bar[XB_XGEN(b.x)]) == gen, bar);
            __builtin_amdgcn_fence(__ATOMIC_ACQUIRE, "agent");
            asm volatile("s_waitcnt vmcnt(0)" ::: "memory");
        }
    }
    __syncthreads();
}

constexpr int NWAVES = 8;
constexpr int RING_BYTES = 131072, LDS_BYTES = 147456;
static_assert(att::L_END <= RING_BYTES, "attention scratch fits the ring region");

__device__ __forceinline__ float wave_sum(float v) {
#pragma unroll
    for (int o = 1; o < 64; o <<= 1) v += __shfl_xor(v, o);
    return v;
}
__device__ __forceinline__ void tr_item(const float* W, int ldw, int col0, int K, bf16_t* WT, int row_off, LAS float* scr, int kb, int nb, int lane, const float* gs) {
    const int k0 = 64 * kb, n0 = 32 * nb;
    float wv[32];
#pragma unroll
    for (int i = 0; i < 32; ++i) { const int kk = 2 * i + (lane >> 5); wv[i] = W[(size_t)(k0 + kk) * ldw + col0 + n0 + (lane & 31)]; }
    if (gs) {
#pragma unroll
        for (int i = 0; i < 32; ++i) wv[i] *= gs[k0 + 2 * i + (lane >> 5)];
    }
#pragma unroll
    for (int i = 0; i < 32; ++i) { const int kk = 2 * i + (lane >> 5); scr[kk * 33 + (lane & 31)] = wv[i]; }
    asm volatile("s_waitcnt lgkmcnt(0)" ::: "memory");
    const int c = lane & 7;
#pragma unroll
    for (int j = 0; j < 4; ++j) { const int n = (lane >> 3) + 8 * j; const LAS float* s = scr + (8 * c) * 33 + n;
        u32x4 o; o.x = cvt_pk_bf16(s[0 * 33], s[1 * 33]); o.y = cvt_pk_bf16(s[2 * 33], s[3 * 33]); o.z = cvt_pk_bf16(s[4 * 33], s[5 * 33]); o.w = cvt_pk_bf16(s[6 * 33], s[7 * 33]);
        *(u32x4*)(WT + (size_t)(row_off + n0 + n) * K + k0 + 8 * c) = o; }
    asm volatile("s_waitcnt lgkmcnt(0)" ::: "memory");
}

struct Args { const float* in[16]; float* out; unsigned char* ws; int ph_lo, ph_hi; };

__global__ void __launch_bounds__(NWAVES * 64, 2) fwd_megakernel(Args args) {
    __builtin_assume(__builtin_amdgcn_workitem_id_y() == 0); __builtin_assume(__builtin_amdgcn_workitem_id_z() == 0);
    extern __shared__ __attribute__((aligned(16))) unsigned char lds_raw[];
    LAS unsigned char* lds = (LAS unsigned char*)lds_raw;
    const int tid = threadIdx.x, lane = tid & 63, wave = __builtin_amdgcn_readfirstlane(tid >> 6);
    const int G = gridDim.x, bx = blockIdx.x, vcu = (G % 8 == 0) ? (bx % 8) * (G / 8) + bx / 8 : bx;
    const int gw = vcu * NWAVES + wave, NGW = G * NWAVES;
    unsigned char* ws = args.ws;
    const float* x = args.in[0]; const float* p_in = args.in[1]; const float* g_mix = args.in[2]; const float* w_in = args.in[3]; const float* b_forget = args.in[4]; const float* b_gate = args.in[5];
    const float* w_bf = args.in[6]; const float* w_bs = args.in[7]; const float* w_out = args.in[8]; const float* g_mlp = args.in[9]; const float* w_up = args.in[10]; const float* w_dn = args.in[11];
    const float* g_ple = args.in[12]; const float* w_pg = args.in[13]; const float* w_ple = args.in[14]; const float* g_final = args.in[15];
    float* out = args.out;
    bf16_t* Win_t = (bf16_t*)(ws + WS_WIN); bf16_t* Wbf_t = (bf16_t*)(ws + WS_WBF); bf16_t* Wbs_t = (bf16_t*)(ws + WS_WBS); bf16_t* Wout_t = (bf16_t*)(ws + WS_WOUT);
    bf16_t* Wup_t = (bf16_t*)(ws + WS_WUP); bf16_t* Wdn_t = (bf16_t*)(ws + WS_WDN); bf16_t* Wpg_t = (bf16_t*)(ws + WS_WPG); bf16_t* Wple_t = (bf16_t*)(ws + WS_WPLE);
    float* LOGF = (float*)(ws + WS_LOGF); float* CC = (float*)(ws + WS_CC); float* SSQ1 = (float*)(ws + WS_SSQ1); float* SSQ2 = (float*)(ws + WS_SSQ2);
    bf16_t* PB = (bf16_t*)(ws + WS_PB); bf16_t* BUFA = (bf16_t*)(ws + WS_BUFA); bf16_t* BUFB = (bf16_t*)(ws + WS_BUFB); bf16_t* QKV = (bf16_t*)(ws + WS_QKV); bf16_t* SG = (bf16_t*)(ws + WS_SG);
    bf16_t* HB = (bf16_t*)(ws + WS_H); bf16_t* EB = (bf16_t*)(ws + WS_E);
    const int lo = args.ph_lo, hi = args.ph_hi;
#define IN(k) (lo <= (k) && (k) < hi)
    volatile LAS unsigned* bst = (volatile LAS unsigned*)(lds + RING_BYTES);
    if (tid < 2) bst[tid] = 0u;
    __syncthreads();
    XcdBarrier xbar; xbar.bar = (unsigned*)ws; xbar.x = 0; xbar.st = bst;
    if (hi - lo > 1) xbar = xcd_barrier_post((unsigned*)ws, bst);
#define SEAM(k) do { if (IN(k) && IN((k) + 1)) { if (hi > N_PHASES) cg::this_grid().sync(); else xcd_barrier(xbar); } } while (0)

    if (IN(0)) {
        LAS float* scr = (LAS float*)(lds + wave * 8448);
        LAS f32x4* wtab = (LAS f32x4*)(lds + 69632);
        {
            constexpr int NSEG = 9;
            int base = 0;
            for (int it = gw; ; it += NGW) {
                int r = it; const float* W; int ldw, col0, K, nblk, row_off; bf16_t* WT; const float* gs = nullptr;
                if (r < 16 * 48) { W = w_in; ldw = NIN_SRC; col0 = 0; K = DM; nblk = 48; WT = Win_t; row_off = 0; }
                else if ((r -= 16 * 48) < 16 * 112) { W = w_in; ldw = NIN_SRC; col0 = 1544; K = DM; nblk = 112; WT = Win_t; row_off = 1536; }
                else if ((r -= 16 * 112) < 8 * 32) { W = w_bf; ldw = DM; col0 = 0; K = 512; nblk = 32; WT = Wbf_t; row_off = 0; }
                else if ((r -= 8 * 32) < 8 * 32) { W = w_bs; ldw = DM; col0 = 0; K = 512; nblk = 32; WT = Wbs_t; row_off = 0; }
                else if ((r -= 8 * 32) < 16 * 32) { W = w_out; ldw = DM; col0 = 0; K = DM; nblk = 32; WT = Wout_t; row_off = 0; }
                else if ((r -= 16 * 32) < 16 * 128) { W = w_up; ldw = DFF; col0 = 0; K = DM; nblk = 128; WT = Wup_t; row_off = 0; gs = g_mlp; }
                else if ((r -= 16 * 128) < 64 * 32) { W = w_dn; ldw = DM; col0 = 0; K = DFF; nblk = 32; WT = Wdn_t; row_off = 0; }
                else if ((r -= 64 * 32) < 16 * 32) { W = w_pg; ldw = DM; col0 = 0; K = DM; nblk = 32; WT = Wpg_t; row_off = 0; gs = g_ple; }
                else if ((r -= 16 * 32) < 4 * 32) { W = w_ple; ldw = DM; col0 = 0; K = DPLE; nblk = 32; WT = Wple_t; row_off = 0; }
                else break;
                tr_item(W, ldw, col0, K, WT, row_off, scr, r / nblk, r % nblk, lane, gs);
                (void)base; (void)NSEG;
            }
        }
        {
            f32x4 gm[4];
#pragma unroll
            for (int j = 0; j < 4; ++j) gm[j] = *((const f32x4*)g_mix + lane + 64 * j);
#pragma unroll
            for (int q = 0; q < 2; ++q) { const int k = tid + 512 * q; const float gk = g_mix[k]; const float* wp = w_in + (size_t)k * NIN_SRC + 1536;
                const int ln = (k & 255) >> 2, e = k & 3, j = k >> 8;
                wtab[((j * 4 + e) * 2 + 0) * 64 + ln] = *(const f32x4*)wp * gk; wtab[((j * 4 + e) * 2 + 1) * 64 + ln] = *(const f32x4*)(wp + 4) * gk; }
            __syncthreads();
            const float bfv = b_forget[lane & 7];
            for (int m0 = gw; m0 < M; m0 += 2 * NGW) {
                f32x4 va[2][4];
#pragma unroll
                for (int q = 0; q < 2; ++q)
#pragma unroll
                    for (int j = 0; j < 4; ++j) va[q][j] = *((const f32x4*)(x + (size_t)(m0 + q * NGW) * DM) + lane + 64 * j);
#pragma unroll
                for (int q = 0; q < 2; ++q) {
                    const int m = m0 + q * NGW;
                    f32x4 v[4]; float s = 0.f;
#pragma unroll
                    for (int j = 0; j < 4; ++j) { v[j] = va[q][j]; s += (v[j][0] * v[j][0] + v[j][1] * v[j][1]) + (v[j][2] * v[j][2] + v[j][3] * v[j][3]); }
                    const float rstd = __builtin_amdgcn_rsqf(wave_sum(s) * (1.0f / DM) + EPS);
                    f32x4 f0 = {0.f, 0.f, 0.f, 0.f}, f1 = {0.f, 0.f, 0.f, 0.f};
#pragma unroll
                    for (int j = 0; j < 4; ++j)
#pragma unroll
                        for (int e = 0; e < 4; ++e) { f0 += wtab[((j * 4 + e) * 2 + 0) * 64 + lane] * v[j][e]; f1 += wtab[((j * 4 + e) * 2 + 1) * 64 + lane] * v[j][e]; }
                    unsigned long long* o8 = (unsigned long long*)(BUFA + (size_t)m * DM) + lane;
#pragma unroll
                    for (int j = 0; j < 4; ++j) { const f32x4 y = v[j] * gm[j] * rstd; o8[64 * j] = (unsigned long long)cvt_pk_bf16(y[0], y[1]) | ((unsigned long long)cvt_pk_bf16(y[2], y[3]) << 32); }
                    float fl[8];
#pragma unroll
                    for (int e = 0; e < 4; ++e) { fl[e] = wave_sum(f0[e]); fl[4 + e] = wave_sum(f1[e]); }
                    float mine = fl[0];
#pragma unroll
                    for (int e = 1; e < 8; ++e) mine = ((lane & 7) == e) ? fl[e] : mine;
                    const float y2 = (mine * rstd + bfv) * LOG2E;
                    const float lf = -(fmaxf(-y2, 0.f) + __builtin_amdgcn_logf(1.0f + __builtin_amdgcn_exp2f(-fabsf(y2))));
                    if (lane < 8) LOGF[(size_t)((m / SEQ) * NH + lane) * SEQ + (m % SEQ)] = lf;
                }
            }
        }
        {
            const size_t n8 = (size_t)M * DPLE / 8;
            for (size_t i = (size_t)bx * 512 + tid; i < n8; i += (size_t)G * 512) { const f32x4 a = *((const f32x4*)p_in + 2 * i), c = *((const f32x4*)p_in + 2 * i + 1);
                u32x4 w; w.x = cvt_pk_bf16(a[0], a[1]); w.y = cvt_pk_bf16(a[2], a[3]); w.z = cvt_pk_bf16(c[0], c[1]); w.w = cvt_pk_bf16(c[2], c[3]); *((u32x4*)PB + i) = w; }
        }
    }
    SEAM(0);

    if (IN(1)) {
        if (gw < BATCH * NH) {
            const float* src = LOGF + (size_t)gw * SEQ + lane * 32; float* dst = CC + (size_t)gw * SEQ + lane * 32;
            f32x4 v[8]; float run = 0.f;
#pragma unroll
            for (int j = 0; j < 8; ++j) { v[j] = *((const f32x4*)src + j);
#pragma unroll
                for (int e = 0; e < 4; ++e) { run += v[j][e]; v[j][e] = run; } }
            float incl = run;
#pragma unroll
            for (int o = 1; o < 64; o <<= 1) { const float tv = __shfl_up(incl, o); if (lane >= o) incl += tv; }
            const float excl = incl - run;
#pragma unroll
            for (int j = 0; j < 8; ++j) *((f32x4*)dst + j) = v[j] + excl;
        }
        pg8::Gemm g{DM, DM, DM};
        pg8::PlainSched S; S.T.init(M, NIN, G, bx); S.A = (const char*)BUFA; S.B = (const char*)Win_t; S.astep = (size_t)256 * DM * 2; S.bstep = (size_t)256 * DM * 2;
        pg8::EpiQKVG E{QKV, SG, b_gate};
        pg8::gemm_phase<pg8::EpiQKVG, pg8::PlainSched>(lds, g, S, E);
    }
    SEAM(1);

    if (IN(2)) {
        for (int i = 0; i < 8; ++i) {
            const int j = i & 3, kind = i >> 2;
            for (int bh = (vcu >> 1); bh < BATCH * NH; bh += (G >> 1)) {
                const int s = (vcu & 1) * 2 + (j >> 1); const int qb = (j & 1) ? 7 - s : s;
                if (kind == 0) att::attn_unit<0>(bh / NH, bh % NH, qb, QKV, CC, BUFB, lds);
                else att::attn_unit<1>(bh / NH, bh % NH, qb, QKV, CC, BUFB, lds);
            }
        }
    }
    SEAM(2);

    if (IN(3)) {
        pg8::Gemm g{DM, 512, 512};
        pg8::PairSched S; S.T.init(M, DM, G, bx); S.A0 = (const char*)BUFB; S.A1 = (const char*)(BUFB + 512); S.B0 = (const char*)Wbf_t; S.B1 = (const char*)Wbs_t; S.astep = (size_t)256 * DM * 2; S.bstep = (size_t)256 * 512 * 2;
        pg8::EpiBranch E{SG, BUFA};
        pg8::gemm_phase<pg8::EpiBranch, pg8::PairSched>(lds, g, S, E);
    }
    SEAM(3);

    if (IN(4)) {
        {
            pg8::Gemm g{DM, DM, DM};
            pg8::PlainSched S; S.T.init(M, DM, G, bx); S.A = (const char*)BUFA; S.B = (const char*)Wout_t; S.astep = (size_t)256 * DM * 2; S.bstep = (size_t)256 * DM * 2;
            pg8::EpiRes4 E{x, BUFB, SSQ1};
            pg8::gemm_phase<pg8::EpiRes4, pg8::PlainSched>(lds, g, S, E);
        }
        {
            pg8::Gemm g{DPLE, DPLE, DPLE};
            pg8::PlainSched S; S.T.init(M, DM, G, bx); S.A = (const char*)PB; S.B = (const char*)Wple_t; S.astep = (size_t)256 * DPLE * 2; S.bstep = (size_t)256 * DPLE * 2;
            pg8::EpiBf16 E{EB, DM};
            pg8::gemm_phase<pg8::EpiBf16, pg8::PlainSched>(lds, g, S, E);
        }
    }
    SEAM(4);

    if (IN(5)) {
        pg8::Gemm g{DM, DM, DM};
        pg8::PlainSched S; S.T.init(M, DFF, G, bx); S.A = (const char*)BUFB; S.B = (const char*)Wup_t; S.astep = (size_t)256 * DM * 2; S.bstep = (size_t)256 * DM * 2;
        pg8::EpiUp E{HB, SSQ1};
        pg8::gemm_phase<pg8::EpiUp, pg8::PlainSched>(lds, g, S, E);
    }
    SEAM(5);

    if (IN(6)) {
        pg8::Gemm g{DFF, DFF, DFF};
        pg8::PlainSched S; S.T.init(M, DM, G, bx); S.A = (const char*)HB; S.B = (const char*)Wdn_t; S.astep = (size_t)256 * DFF * 2; S.bstep = (size_t)256 * DFF * 2;
        pg8::EpiRes6 E{BUFB, BUFA, SSQ2};
        pg8::gemm_phase<pg8::EpiRes6, pg8::PlainSched>(lds, g, S, E);
    }
    SEAM(6);

    if (IN(7)) {
        pg8::Gemm g{DM, DM, DM};
        pg8::PlainSched S; S.T.init(M, DM, G, bx); S.A = (const char*)BUFA; S.B = (const char*)Wpg_t; S.astep = (size_t)256 * DM * 2; S.bstep = (size_t)256 * DM * 2;
        pg8::EpiPle E{BUFA, BUFB, EB, SSQ2};
        pg8::gemm_phase<pg8::EpiPle, pg8::PlainSched>(lds, g, S, E);
    }
    SEAM(7);

    if (IN(8)) {
        f32x4 gf[4];
#pragma unroll
        for (int j = 0; j < 2; ++j) { gf[2 * j] = *((const f32x4*)g_final + 2 * lane + 128 * j); gf[2 * j + 1] = *((const f32x4*)g_final + 2 * lane + 128 * j + 1); }
        for (int m = gw; m < M; m += 2 * NGW) {
            u32x4 w[2][2];
#pragma unroll
            for (int q = 0; q < 2; ++q)
#pragma unroll
                for (int j = 0; j < 2; ++j) w[q][j] = *((const u32x4*)(BUFB + (size_t)(m + q * NGW) * DM) + lane + 64 * j);
#pragma unroll
            for (int q = 0; q < 2; ++q) {
                f32x4 v[4]; float s = 0.f;
#pragma unroll
                for (int j = 0; j < 2; ++j) { v[2 * j] = pg8::bf4_lo(w[q][j]); v[2 * j + 1] = pg8::bf4_hi(w[q][j]); }
#pragma unroll
                for (int j = 0; j < 4; ++j) s += (v[j][0] * v[j][0] + v[j][1] * v[j][1]) + (v[j][2] * v[j][2] + v[j][3] * v[j][3]);
                const float rstd = __builtin_amdgcn_rsqf(wave_sum(s) * (1.0f / DM) + EPS);
                f32x4* orow = (f32x4*)(out + (size_t)(m + q * NGW) * DM);
#pragma unroll
                for (int j = 0; j < 2; ++j) { orow[2 * lane + 128 * j] = v[2 * j] * gf[2 * j] * rstd; orow[2 * lane + 128 * j + 1] = v[2 * j + 1] * gf[2 * j + 1] * rstd; }
            }
        }
    }
#undef IN
#undef SEAM
}

extern "C" void kernel_launch(void* const* d_in, const int* in_sizes, int n_in, void* d_out, int out_size, void* d_ws, size_t ws_size, hipStream_t stream) {
    static int grid = 0;
    if (grid == 0) {
        if (n_in != 16 || in_sizes[0] != M * DM || out_size != M * DM || ws_size < WS_END) { fprintf(stderr, "kernel_launch: unexpected shapes (n_in %d, in0 %d, out %d, ws %zu); nothing launched\n", n_in, n_in > 0 ? in_sizes[0] : -1, out_size, ws_size); grid = -1; return; }
        int dev = 0, cus = 0, per_cu = 0;
        if (hipGetDevice(&dev) != hipSuccess || hipDeviceGetAttribute(&cus, hipDeviceAttributeMultiprocessorCount, dev) != hipSuccess) { grid = -1; return; }
        if (hipFuncSetAttribute((const void*)fwd_megakernel, hipFuncAttributeMaxDynamicSharedMemorySize, LDS_BYTES) != hipSuccess) { fprintf(stderr, "kernel_launch: hipFuncSetAttribute failed\n"); grid = -1; return; }
        if (hipOccupancyMaxActiveBlocksPerMultiprocessor(&per_cu, (const void*)fwd_megakernel, NWAVES * 64, LDS_BYTES) != hipSuccess || per_cu < 1) { fprintf(stderr, "kernel_launch: occupancy query says %d\n", per_cu); per_cu = 1; }
        (void)hipGetLastError();
        grid = cus;
        if (grid != 256) fprintf(stderr, "kernel_launch: %d CUs; built for 256\n", grid);
    }
    if (grid < 0) return;
    if (hipMemsetAsync(d_ws, 0, 16384, stream) != hipSuccess) { fprintf(stderr, "kernel_launch: memset failed\n"); return; }
    Args a{};
    for (int i = 0; i < 16; ++i) a.in[i] = (const float*)d_in[i];
    a.out = (float*)d_out; a.ws = (unsigned char*)d_ws;
#if MK_N_LAUNCHES == 1
    a.ph_lo = 0; a.ph_hi = N_PHASES;
    void* kargs[] = {&a};
    hipError_t e = hipLaunchCooperativeKernel((const void*)fwd_megakernel, dim3(grid), dim3(NWAVES * 64), kargs, LDS_BYTES, stream);
    if (e != hipSuccess) fprintf(stderr, "kernel_launch: cooperative launch failed: %s (grid %d)\n", hipGetErrorString(e), grid);
#else
    for (int li = 0; li < N_PHASES; ++li) { a.ph_lo = li; a.ph_hi = li + 1; hipLaunchKernelGGL(fwd_megakernel, dim3(grid), dim3(NWAVES * 64), LDS_BYTES, stream, a); }
#endif
}
```

```cpp
#include <hip/hip_runtime.h>
#include <hip/hip_cooperative_groups.h>
#include <cstdio>
#include <cstdint>
namespace cg = cooperative_groups;

#ifndef MK_N_LAUNCHES
#define MK_N_LAUNCHES 1
#endif
constexpr int N_PHASES = 9;

#define LAS __attribute__((address_space(3)))
typedef unsigned short bf16_t;
typedef short bf16x8 __attribute__((ext_vector_type(8)));
typedef short s16x4 __attribute__((ext_vector_type(4)));
typedef float f32x4 __attribute__((ext_vector_type(4)));
typedef float f32x2 __attribute__((ext_vector_type(2)));
typedef float f32x16 __attribute__((ext_vector_type(16)));
typedef unsigned u32x4 __attribute__((ext_vector_type(4)));
typedef unsigned u32x2 __attribute__((ext_vector_type(2)));
typedef __bf16 bf16x2_t __attribute__((ext_vector_type(2)));

constexpr int BATCH = 16, SEQ = 2048, DM = 1024, M = BATCH * SEQ, NH = 8, HD = 64, DFF = 4096, DPLE = 256;
constexpr int NIN_SRC = 5128, NQKV = 3072, NGATE = 2048, NIN = NQKV + NGATE;
constexpr float EPS = 1e-6f;
constexpr float LOG2E = 1.4426950408889634f;
constexpr float C2 = 0.125f * LOG2E;

constexpr size_t MiB = 1u << 20;
constexpr size_t WS_WIN = 2 * MiB, WS_WBF = 12 * MiB, WS_WBS = 13 * MiB, WS_WOUT = 14 * MiB, WS_WUP = 16 * MiB, WS_WDN = 24 * MiB, WS_WPG = 32 * MiB, WS_WPLE = 34 * MiB;
constexpr size_t WS_LOGF = 36 * MiB, WS_CC = 37 * MiB, WS_SSQ1 = 38 * MiB, WS_SSQ2 = 40 * MiB;
constexpr size_t WS_PB = 42 * MiB, WS_BUFA = 58 * MiB, WS_BUFB = 122 * MiB, WS_QKV = 186 * MiB, WS_SG = 378 * MiB, WS_H = 186 * MiB, WS_E = 442 * MiB, WS_END = 506 * MiB;

__device__ __forceinline__ unsigned cvt_pk_bf16(float lo, float hi) { f32x2 v = {lo, hi}; bf16x2_t b = __builtin_convertvector(v, bf16x2_t); return __builtin_bit_cast(unsigned, b); }
__device__ __forceinline__ float bf_lo(unsigned w) { return __uint_as_float(w << 16); }
__device__ __forceinline__ float bf_hi(unsigned w) { return __uint_as_float(w & 0xffff0000u); }
__device__ __forceinline__ float fast_sigmoid(float v) { return __builtin_amdgcn_rcpf(1.0f + __builtin_amdgcn_exp2f(-v * LOG2E)); }

__device__ __forceinline__ const char* uni_ptr(const char* p) { const unsigned long long v = (unsigned long long)p; const unsigned lo = __builtin_amdgcn_readfirstlane((unsigned)v), hi = __builtin_amdgcn_readfirstlane((unsigned)(v >> 32)); return (const char*)(((unsigned long long)hi << 32) | lo); }
namespace pg8 {
constexpr int BM = 256, BK = 64, HALF = 128, HTB = HALF * BK * 2, STAGE_BYTES = 8 * HTB, NXCD = 8, WGM = 8;
__host__ __device__ __forceinline__ int lds_byte(int r, int c) { const int st = (r >> 4) * 2 + (c >> 5), rr = r & 15, cc = c & 31, ob = rr * 64 + cc * 2; return st * 1024 + (ob ^ (((ob >> 9) & 1) << 5)); }
__host__ __device__ __forceinline__ void stage_rc(int b, int& R, int& C) { const int st = b / 1024, sb = b % 1024, swz = sb ^ (((sb >> 9) & 1) << 5); R = (st >> 1) * 16 + swz / 64; C = (st & 1) * 32 + (swz % 64) / 2; }
__host__ __device__ __forceinline__ int perm32(int rho) { const int n = rho >> 4, i = rho & 15; return 8 * (i >> 2) + 4 * n + (i & 3); }

struct Unit { int pm, pn; const char* A; const char* B; int chain; };
struct Gemm { int lda, ldb, K; };

struct TileOrder {
    int nM, nN, nwg, G, c;
    __device__ void init(int Mrows, int N, int G_, int c_) { nM = Mrows / BM; nN = N / BM; nwg = nM * nN; G = G_; c = c_; }
    __device__ bool tile(int i, int& pm, int& pn) const {
        const long L = (long)i * G + c; if (L >= nwg) return false;
        int wgid = (int)L; { const int q = nwg / NXCD, r = nwg % NXCD, xcd = wgid % NXCD, off = wgid / NXCD; wgid = (xcd < r ? xcd * (q + 1) : r * (q + 1) + (xcd - r) * q) + off; }
        const int nig = WGM * nN, gid = wgid / nig, fm = gid * WGM, gsz = (nM - fm) < WGM ? (nM - fm) : WGM;
        pm = fm + ((wgid % nig) % gsz); pn = (wgid % nig) / gsz; return true;
    }
};
struct PlainSched {
    TileOrder T; const char* A; const char* B; size_t astep, bstep;
    __device__ bool next(int i, Unit& u) const { int pm, pn; if (!T.tile(i, pm, pn)) return false; u.pm = pm; u.pn = pn; u.A = A + (size_t)pm * astep; u.B = B + (size_t)pn * bstep; u.chain = 0; return true; }
};
struct PairSched {
    TileOrder T; const char* A0; const char* A1; const char* B0; const char* B1; size_t astep, bstep;
    __device__ bool next(int i, Unit& u) const { int pm, pn; if (!T.tile(i >> 1, pm, pn)) return false; const int s = i & 1; u.pm = pm; u.pn = pn;
        u.A = (s ? A1 : A0) + (size_t)pm * astep; u.B = (s ? B1 : B0) + (size_t)pn * bstep; u.chain = s ? 0 : 1; return true; }
};

typedef f32x4 Acc[2][2][4][2];

struct EpiQKVG {
    static constexpr bool PERM = true;
    bf16_t* QKV; bf16_t* SG; const float* bgate;
    __device__ __forceinline__ void operator()(Acc& acc, const Unit& u, int wr, int wc, int fr, int fq, LAS float* tab, int tid) const {
        const int row0 = u.pm * BM + wr * 64 + fr;
        if (u.pn < 12) {
            const float sc = (u.pn < 2 || (u.pn >= 6 && u.pn < 8)) ? C2 : 1.0f;
            const int col0 = u.pn * BM + wc * 32 + 8 * fq;
#pragma unroll
            for (int ai = 0; ai < 2; ++ai)
#pragma unroll
                for (int m = 0; m < 4; ++m) { bf16_t* rowp = QKV + (size_t)(row0 + ai * HALF + m * 16) * NQKV + col0;
#pragma unroll
                    for (int bj = 0; bj < 2; ++bj) { const f32x4 v0 = acc[ai][bj][m][0] * sc, v1 = acc[ai][bj][m][1] * sc;
                        u32x4 w; w.x = cvt_pk_bf16(v0[0], v0[1]); w.y = cvt_pk_bf16(v0[2], v0[3]); w.z = cvt_pk_bf16(v1[0], v1[1]); w.w = cvt_pk_bf16(v1[2], v1[3]);
                        *(u32x4*)(rowp + bj * HALF) = w; } }
        } else {
            const int col0 = (u.pn - 12) * BM + wc * 32 + 8 * fq;
            f32x4 bv[2][2];
#pragma unroll
            for (int bj = 0; bj < 2; ++bj)
#pragma unroll
                for (int n = 0; n < 2; ++n) bv[bj][n] = *(const f32x4*)(bgate + col0 + bj * HALF + 4 * n);
#pragma unroll
            for (int ai = 0; ai < 2; ++ai)
#pragma unroll
                for (int m = 0; m < 4; ++m) { bf16_t* rowp = SG + (size_t)(row0 + ai * HALF + m * 16) * NGATE + col0;
#pragma unroll
                    for (int bj = 0; bj < 2; ++bj) { const f32x4 a0 = acc[ai][bj][m][0] + bv[bj][0], a1 = acc[ai][bj][m][1] + bv[bj][1];
                        u32x4 w; w.x = cvt_pk_bf16(fast_sigmoid(a0[0]), fast_sigmoid(a0[1])); w.y = cvt_pk_bf16(fast_sigmoid(a0[2]), fast_sigmoid(a0[3]));
                        w.z = cvt_pk_bf16(fast_sigmoid(a1[0]), fast_sigmoid(a1[1])); w.w = cvt_pk_bf16(fast_sigmoid(a1[2]), fast_sigmoid(a1[3]));
                        *(u32x4*)(rowp + bj * HALF) = w; } }
        }
    }
};
struct EpiBf16 {
    static constexpr bool PERM = true;
    bf16_t* O; int ldc;
    __device__ __forceinline__ void operator()(Acc& acc, const Unit& u, int wr, int wc, int fr, int fq, LAS float* tab, int tid) const {
        const int row0 = u.pm * BM + wr * 64 + fr, col0 = u.pn * BM + wc * 32 + 8 * fq;
#pragma unroll
        for (int ai = 0; ai < 2; ++ai)
#pragma unroll
            for (int m = 0; m < 4; ++m) { bf16_t* rowp = O + (size_t)(row0 + ai * HALF + m * 16) * ldc + col0;
#pragma unroll
                for (int bj = 0; bj < 2; ++bj) { const f32x4 v0 = acc[ai][bj][m][0], v1 = acc[ai][bj][m][1];
                    u32x4 w; w.x = cvt_pk_bf16(v0[0], v0[1]); w.y = cvt_pk_bf16(v0[2], v0[3]); w.z = cvt_pk_bf16(v1[0], v1[1]); w.w = cvt_pk_bf16(v1[2], v1[3]);
                    *(u32x4*)(rowp + bj * HALF) = w; } }
    }
};
__device__ __forceinline__ f32x4 bf4_lo(const u32x4 w) { return (f32x4){bf_lo(w.x), bf_hi(w.x), bf_lo(w.y), bf_hi(w.y)}; }
__device__ __forceinline__ f32x4 bf4_hi(const u32x4 w) { return (f32x4){bf_lo(w.z), bf_hi(w.z), bf_lo(w.w), bf_hi(w.w)}; }
__device__ __forceinline__ u32x4 pack8(const f32x4 v0, const f32x4 v1) { u32x4 w; w.x = cvt_pk_bf16(v0[0], v0[1]); w.y = cvt_pk_bf16(v0[2], v0[3]); w.z = cvt_pk_bf16(v1[0], v1[1]); w.w = cvt_pk_bf16(v1[2], v1[3]); return w; }
struct EpiBranch {
    static constexpr bool PERM = true;
    const bf16_t* SG; bf16_t* MG;
    __device__ __forceinline__ void operator()(Acc& acc, const Unit& u, int wr, int wc, int fr, int fq, LAS float* tab, int tid) const {
        const int row0 = u.pm * BM + wr * 64 + fr, col0 = u.pn * BM + wc * 32 + 8 * fq;
#pragma unroll
        for (int ai = 0; ai < 2; ++ai) {
            u32x4 ga[4][2], gb[4][2];
#pragma unroll
            for (int m = 0; m < 4; ++m)
#pragma unroll
                for (int bj = 0; bj < 2; ++bj) { const bf16_t* p = SG + (size_t)(row0 + ai * HALF + m * 16) * NGATE + col0 + bj * HALF; gb[m][bj] = *(const u32x4*)(p + DM); if (u.chain) ga[m][bj] = *(const u32x4*)p; }
#pragma unroll
            for (int m = 0; m < 4; ++m)
#pragma unroll
                for (int bj = 0; bj < 2; ++bj) { const f32x4 b0 = bf4_lo(gb[m][bj]), b1 = bf4_hi(gb[m][bj]);
                    if (u.chain) { const f32x4 a0 = bf4_lo(ga[m][bj]), a1 = bf4_hi(ga[m][bj]);
#pragma unroll
                        for (int e = 0; e < 4; ++e) { acc[ai][bj][m][0][e] *= a0[e] * __builtin_amdgcn_rcpf(fmaxf(b0[e], 1e-30f)); acc[ai][bj][m][1][e] *= a1[e] * __builtin_amdgcn_rcpf(fmaxf(b1[e], 1e-30f)); }
                    } else *(u32x4*)(MG + (size_t)(row0 + ai * HALF + m * 16) * DM + col0 + bj * HALF) = pack8(acc[ai][bj][m][0] * b0, acc[ai][bj][m][1] * b1); }
            asm volatile("" ::: "memory");
        }
    }
};
__device__ __forceinline__ void ssq_publish(LAS float* tab, float* ssq, const Unit& u, int tid) {
    asm volatile("s_waitcnt lgkmcnt(0)" ::: "memory"); __builtin_amdgcn_s_barrier(); asm volatile("" ::: "memory");
    if (tid < 256) { const f32x4 t = *(const LAS f32x4*)(tab + tid * 4); ssq[(size_t)(u.pm * BM + tid) * 4 + u.pn] = (t[0] + t[1]) + (t[2] + t[3]); }
}
struct EpiRes4 {
    static constexpr bool PERM = true;
    const float* base; bf16_t* xb; float* ssq;
    __device__ __forceinline__ void operator()(Acc& acc, const Unit& u, int wr, int wc, int fr, int fq, LAS float* tab, int tid) const {
        const int row0 = u.pm * BM + wr * 64 + fr, col0 = u.pn * BM + wc * 32 + 8 * fq;
#pragma unroll
        for (int ai = 0; ai < 2; ++ai) {
            f32x4 bs[4][2][2];
#pragma unroll
            for (int m = 0; m < 4; ++m)
#pragma unroll
                for (int bj = 0; bj < 2; ++bj)
#pragma unroll
                    for (int n = 0; n < 2; ++n) bs[m][bj][n] = *(const f32x4*)(base + (size_t)(row0 + ai * HALF + m * 16) * DM + col0 + bj * HALF + 4 * n);
#pragma unroll
            for (int m = 0; m < 4; ++m) { float s = 0.f;
#pragma unroll
                for (int bj = 0; bj < 2; ++bj) { const f32x4 x0 = bs[m][bj][0] + acc[ai][bj][m][0], x1 = bs[m][bj][1] + acc[ai][bj][m][1];
                    s += ((x0[0] * x0[0] + x0[1] * x0[1]) + (x0[2] * x0[2] + x0[3] * x0[3])) + ((x1[0] * x1[0] + x1[1] * x1[1]) + (x1[2] * x1[2] + x1[3] * x1[3]));
                    *(u32x4*)(xb + (size_t)(row0 + ai * HALF + m * 16) * DM + col0 + bj * HALF) = pack8(x0, x1); }
                s += __shfl_xor(s, 16); s += __shfl_xor(s, 32);
                if (fq == 0) tab[(ai * HALF + wr * 64 + m * 16 + fr) * 4 + wc] = s; }
            asm volatile("" ::: "memory");
        }
        ssq_publish(tab, ssq, u, tid);
    }
};
struct EpiRes6 {
    static constexpr bool PERM = true;
    const bf16_t* xin; bf16_t* xb; float* ssq;
    __device__ __forceinline__ void operator()(Acc& acc, const Unit& u, int wr, int wc, int fr, int fq, LAS float* tab, int tid) const {
        const int row0 = u.pm * BM + wr * 64 + fr, col0 = u.pn * BM + wc * 32 + 8 * fq;
        u32x4 xi[2][4][2];
#pragma unroll
        for (int ai = 0; ai < 2; ++ai)
#pragma unroll
            for (int m = 0; m < 4; ++m)
#pragma unroll
                for (int bj = 0; bj < 2; ++bj) xi[ai][m][bj] = *(const u32x4*)(xin + (size_t)(row0 + ai * HALF + m * 16) * DM + col0 + bj * HALF);
#pragma unroll
        for (int ai = 0; ai < 2; ++ai)
#pragma unroll
            for (int m = 0; m < 4; ++m) { float s = 0.f;
#pragma unroll
                for (int bj = 0; bj < 2; ++bj) { const f32x4 x0 = bf4_lo(xi[ai][m][bj]) + acc[ai][bj][m][0], x1 = bf4_hi(xi[ai][m][bj]) + acc[ai][bj][m][1];
                    s += ((x0[0] * x0[0] + x0[1] * x0[1]) + (x0[2] * x0[2] + x0[3] * x0[3])) + ((x1[0] * x1[0] + x1[1] * x1[1]) + (x1[2] * x1[2] + x1[3] * x1[3]));
                    *(u32x4*)(xb + (size_t)(row0 + ai * HALF + m * 16) * DM + col0 + bj * HALF) = pack8(x0, x1); }
                s += __shfl_xor(s, 16); s += __shfl_xor(s, 32);
                if (fq == 0) tab[(ai * HALF + wr * 64 + m * 16 + fr) * 4 + wc] = s; }
        ssq_publish(tab, ssq, u, tid);
    }
};
__device__ __forceinline__ float rstd_of(const f32x4 q) { return __builtin_amdgcn_rsqf(((q[0] + q[1]) + (q[2] + q[3])) * (1.0f / DM) + EPS); }
struct EpiUp {
    static constexpr bool PERM = true;
    bf16_t* H; const float* ssq;
    __device__ __forceinline__ void operator()(Acc& acc, const Unit& u, int wr, int wc, int fr, int fq, LAS float* tab, int tid) const {
        const int row0 = u.pm * BM + wr * 64 + fr, col0 = u.pn * BM + wc * 32 + 8 * fq;
        f32x4 sq[2][4];
#pragma unroll
        for (int ai = 0; ai < 2; ++ai)
#pragma unroll
            for (int m = 0; m < 4; ++m) sq[ai][m] = *(const f32x4*)(ssq + (size_t)(row0 + ai * HALF + m * 16) * 4);
#pragma unroll
        for (int ai = 0; ai < 2; ++ai)
#pragma unroll
            for (int m = 0; m < 4; ++m) { const float r = rstd_of(sq[ai][m]); bf16_t* rowp = H + (size_t)(row0 + ai * HALF + m * 16) * DFF + col0;
#pragma unroll
                for (int bj = 0; bj < 2; ++bj) { f32x4 v0 = acc[ai][bj][m][0] * r, v1 = acc[ai][bj][m][1] * r;
#pragma unroll
                    for (int e = 0; e < 4; ++e) { const float a = fmaxf(v0[e], 0.f), b = fmaxf(v1[e], 0.f); v0[e] = a * a; v1[e] = b * b; }
                    *(u32x4*)(rowp + bj * HALF) = pack8(v0, v1); } }
    }
};
struct EpiPle {
    static constexpr bool PERM = true;
    const bf16_t* xin; bf16_t* xb; const bf16_t* E; const float* ssq;
    __device__ __forceinline__ void operator()(Acc& acc, const Unit& u, int wr, int wc, int fr, int fq, LAS float* tab, int tid) const {
        const int row0 = u.pm * BM + wr * 64 + fr, col0 = u.pn * BM + wc * 32 + 8 * fq;
#pragma unroll
        for (int ai = 0; ai < 2; ++ai)
#pragma unroll
            for (int mh = 0; mh < 2; ++mh) {
                u32x4 xi[2][2], ei[2][2]; f32x4 sq[2];
#pragma unroll
                for (int mm = 0; mm < 2; ++mm) { const int row = row0 + ai * HALF + (2 * mh + mm) * 16; sq[mm] = *(const f32x4*)(ssq + (size_t)row * 4);
#pragma unroll
                    for (int bj = 0; bj < 2; ++bj) { const size_t off = (size_t)row * DM + col0 + bj * HALF; xi[mm][bj] = *(const u32x4*)(xin + off); ei[mm][bj] = *(const u32x4*)(E + off); } }
#pragma unroll
                for (int mm = 0; mm < 2; ++mm) { const int m = 2 * mh + mm; const float r = rstd_of(sq[mm]);
#pragma unroll
                    for (int bj = 0; bj < 2; ++bj) { const f32x4 a0 = acc[ai][bj][m][0] * r, a1 = acc[ai][bj][m][1] * r, e0 = bf4_lo(ei[mm][bj]), e1 = bf4_hi(ei[mm][bj]); f32x4 o0 = bf4_lo(xi[mm][bj]), o1 = bf4_hi(xi[mm][bj]);
#pragma unroll
                        for (int e = 0; e < 4; ++e) { o0[e] += fast_sigmoid(a0[e]) * e0[e]; o1[e] += fast_sigmoid(a1[e]) * e1[e]; }
                        *(u32x4*)(xb + (size_t)(row0 + ai * HALF + m * 16) * DM + col0 + bj * HALF) = pack8(o0, o1); } }
                asm volatile("" ::: "memory");
            }
    }
};

template <class Epi, class Sched>
__device__ __forceinline__ void gemm_phase(LAS unsigned char* lds, const Gemm g, const Sched& S, const Epi& E) {
    const int tid = threadIdx.x, wid = __builtin_amdgcn_readfirstlane(tid >> 6), lane = tid & 63, wr = wid >> 2, wc = wid & 3, fr = lane & 15, fq = lane >> 4;
    const int K = g.K, nt = K / BK;
    unsigned voffA[2], voffB[2];
#pragma unroll
    for (int i = 0; i < 2; ++i) { int R, C; stage_rc(tid * 16 + i * 8192, R, C); const int Rb = Epi::PERM ? ((R & ~31) + perm32(R & 31)) : R;
        voffA[i] = (unsigned)(R * g.lda + C) * 2u; voffB[i] = (unsigned)(Rb * g.ldb + C) * 2u; }
    const size_t kstep = (size_t)(BK * 2);
    const size_t hA = (size_t)HALF * g.lda * 2, hB = (size_t)HALF * g.ldb * 2;
    const unsigned ldsw = (unsigned)wid * 1024u;
    const int aoff = lds_byte(wr * 64 + fr, fq * 8), boff = lds_byte(wc * 32 + fr, fq * 8);
#define PG8_SA(b, h) (((b) * 2 + (h)) * HTB)
#define PG8_SB(b, h) ((4 + (b) * 2 + (h)) * HTB)
#define PG8_STAGE(bufoff, gbase, voff) do { _Pragma("unroll") for (int _i = 0; _i < 2; ++_i) \
        __builtin_amdgcn_global_load_lds((const unsigned*)((const char*)(gbase) + (voff)[_i]), (LAS unsigned*)(lds + (bufoff) + ldsw + _i * 8192), 16, 0, 0); } while (0)
#define PG8_LDA(dst, b, h) do { _Pragma("unroll") for (int m = 0; m < 4; ++m) _Pragma("unroll") for (int k = 0; k < 2; ++k) dst[m][k] = *(const LAS bf16x8*)(lds + PG8_SA(b, h) + aoff + m * 2048 + k * 1024); } while (0)
#define PG8_LDB(dst, b, h) do { _Pragma("unroll") for (int n = 0; n < 2; ++n) _Pragma("unroll") for (int k = 0; k < 2; ++k) dst[n][k] = *(const LAS bf16x8*)(lds + PG8_SB(b, h) + boff + n * 2048 + k * 1024); } while (0)
#define PG8_MMA(ai, bj, At, Bt) do { __builtin_amdgcn_s_setprio(1); _Pragma("unroll") for (int m = 0; m < 4; ++m) _Pragma("unroll") for (int n = 0; n < 2; ++n) _Pragma("unroll") for (int k = 0; k < 2; ++k) \
        acc[ai][bj][m][n] = __builtin_amdgcn_mfma_f32_16x16x32_bf16(Bt[n][k], At[m][k], acc[ai][bj][m][n], 0, 0, 0); __builtin_amdgcn_s_setprio(0); } while (0)
#define PG8_WAIT_V(n) asm volatile("s_waitcnt vmcnt(" #n ")" ::: "memory")
#define PG8_WAIT_L(n) asm volatile("s_waitcnt lgkmcnt(" #n ")" ::: "memory")
#define PG8_BAR __builtin_amdgcn_s_barrier()
#define PG8_SCHED __builtin_amdgcn_sched_barrier(0)
#define PG8_ZERO() do { _Pragma("unroll") for (int a = 0; a < 2; ++a) _Pragma("unroll") for (int b = 0; b < 2; ++b) _Pragma("unroll") for (int m = 0; m < 4; ++m) _Pragma("unroll") for (int n = 0; n < 2; ++n) acc[a][b][m][n] = (f32x4){0.f, 0.f, 0.f, 0.f}; } while (0)
    Unit cur, nxt; int ui = 0;
    if (!S.next(0, cur)) return;
    Acc acc;
    PG8_ZERO();
    bf16x8 At[4][2], B0[2][2], B1[2][2];
    const char* cA = uni_ptr(cur.A); const char* cB = uni_ptr(cur.B);
    PG8_STAGE(PG8_SB(0, 0), cB, voffB); PG8_STAGE(PG8_SB(0, 1), cB + hB, voffB); PG8_STAGE(PG8_SA(0, 0), cA, voffA); PG8_STAGE(PG8_SA(0, 1), cA + hA, voffA);
    if (wr == 1) PG8_BAR;
    PG8_WAIT_V(2); PG8_BAR;
    PG8_STAGE(PG8_SB(1, 0), cB + kstep, voffB); PG8_STAGE(PG8_SA(1, 0), cA + kstep, voffA); PG8_STAGE(PG8_SB(1, 1), cB + hB + kstep, voffB);
    PG8_WAIT_V(6); PG8_BAR;
    for (;;) {
        const bool has_next = S.next(ui + 1, nxt);
        const char* nA = uni_ptr(has_next ? nxt.A : cA); const char* nB = uni_ptr(has_next ? nxt.B : cB);
#pragma nounroll
        for (int t = 0; t < nt; t += 2) {
            const bool last = (t == nt - 2);
            const char* a1 = cA + (size_t)(t + 1) * kstep;
            const char* a2 = last ? nA : cA + (size_t)(t + 2) * kstep; const char* b2 = last ? nB : cB + (size_t)(t + 2) * kstep;
            const char* a3 = a2 + kstep; const char* b3 = b2 + kstep;
            PG8_LDB(B0, 0, 0); PG8_LDB(B1, 0, 1); PG8_SCHED; PG8_LDA(At, 0, 0); PG8_STAGE(PG8_SA(1, 1), a1 + hA, voffA);
            PG8_WAIT_V(8); PG8_WAIT_L(0); PG8_BAR; PG8_MMA(0, 0, At, B0); PG8_MMA(0, 1, At, B1); PG8_BAR; PG8_SCHED;
            PG8_LDA(At, 0, 1); PG8_STAGE(PG8_SB(0, 0), b2, voffB); PG8_STAGE(PG8_SB(0, 1), b2 + hB, voffB); PG8_STAGE(PG8_SA(0, 0), a2, voffA);
            PG8_WAIT_V(8); PG8_WAIT_L(0); PG8_BAR; PG8_MMA(1, 0, At, B0); PG8_MMA(1, 1, At, B1); PG8_BAR; PG8_SCHED;
            PG8_LDB(B0, 1, 0); PG8_LDB(B1, 1, 1); PG8_SCHED; PG8_LDA(At, 1, 0); PG8_STAGE(PG8_SA(0, 1), a2 + hA, voffA);
            PG8_WAIT_V(8); PG8_WAIT_L(0); PG8_BAR; PG8_MMA(0, 0, At, B0); PG8_MMA(0, 1, At, B1); PG8_BAR; PG8_SCHED;
            PG8_LDA(At, 1, 1); PG8_STAGE(PG8_SB(1, 0), b3, voffB); PG8_STAGE(PG8_SB(1, 1), b3 + hB, voffB); PG8_STAGE(PG8_SA(1, 0), a3, voffA);
            PG8_WAIT_V(8); PG8_WAIT_L(0); PG8_BAR; PG8_MMA(1, 0, At, B0); PG8_MMA(1, 1, At, B1); PG8_BAR; PG8_SCHED;
        }
        if (wr == 0) PG8_BAR;
        E(acc, cur, wr, wc, fr, fq, (LAS float*)(lds + STAGE_BYTES + 64), tid);
        if (!has_next) break;
        if (!cur.chain) PG8_ZERO();
        cur = nxt; cA = nA; cB = nB; ++ui;
        if (wr == 1) PG8_BAR;
    }
    PG8_WAIT_V(0);
    PG8_BAR;
#undef PG8_SA
#undef PG8_SB
#undef PG8_STAGE
#undef PG8_LDA
#undef PG8_LDB
#undef PG8_MMA
#undef PG8_WAIT_V
#undef PG8_WAIT_L
#undef PG8_BAR
#undef PG8_SCHED
#undef PG8_ZERO
}
}

namespace att {
constexpr int PITCH = NQKV, OPITCH = DM, RING_END_ = 131072;
constexpr int NSLOT = 4, SLOT = 16384, L_K = 0, L_V = 8192;
constexpr int L_CB = NSLOT * SLOT, L_WS = L_CB + SEQ * 4, L_OST = L_WS + 8 * 256, L_FLAG = L_OST + 8 * 4096, L_END = L_FLAG + 64;
constexpr float SB_THR = -160.0f;
__device__ __forceinline__ int crow(int r, int hi) { return (r & 3) + 8 * (r >> 2) + 4 * hi; }
__device__ __forceinline__ s16x4 vtr(const LAS unsigned char* p) { typedef short v4i16_t __attribute__((ext_vector_type(4))); return __builtin_bit_cast(s16x4, __builtin_amdgcn_ds_read_tr16_b64_v4i16((LAS v4i16_t*)p)); }
__device__ __forceinline__ void swap_halves(float v, float& lo, float& hi_) { auto rr = __builtin_amdgcn_permlane32_swap(__float_as_uint(v), __float_as_uint(v), false, false); lo = __uint_as_float(rr[0]); hi_ = __uint_as_float(rr[1]); }

template <int KIND>
__device__ __forceinline__ void attn_unit(int b, int h, int qb, const bf16_t* QKV, const float* cc, bf16_t* O, LAS unsigned char* lds) {
    const int tid = threadIdx.x, lane = tid & 63, r32 = lane & 31, hi = lane >> 5; const int wid = __builtin_amdgcn_readfirstlane(tid >> 6);
    const size_t rowbase = (size_t)b * SEQ; const int q0 = qb * 256, qw = q0 + wid * 32, qabs = qw + r32;
    const int colq = KIND * 1536 + h * HD;
    const bf16_t* ksrc = QKV + rowbase * PITCH + colq + 512 + (size_t)lane * PITCH + wid * 8;
    const bf16_t* vsrc = QKV + rowbase * PITCH + colq + 1024 + (size_t)(16 * (wid & 3) + (lane >> 2)) * PITCH + (wid >> 2) * 32 + (lane & 3) * 8;
    const int wdst = wid * 1024;
    const int nIter = qb * 4 + 4, T_last = nIter - 1, td = qw >> 6;
#define ATT_DMA(itx) do { const int t_ = T_last - (itx); LAS unsigned char* sl_ = lds + ((itx) & (NSLOT - 1)) * SLOT + wdst; \
        __builtin_amdgcn_global_load_lds((const unsigned*)(ksrc + (size_t)t_ * 64 * PITCH), (LAS unsigned*)(sl_ + L_K), 16, 0, 0); \
        __builtin_amdgcn_global_load_lds((const unsigned*)(vsrc + (size_t)t_ * 64 * PITCH), (LAS unsigned*)(sl_ + L_V), 16, 0, 0); } while (0)
    ATT_DMA(0); ATT_DMA(1); ATT_DMA(2);
    const bf16_t* Qw = QKV + (rowbase + qw) * PITCH + colq;
    bf16x8 qr[4];
#pragma unroll
    for (int d0 = 0; d0 < 4; ++d0) qr[d0] = *(const bf16x8*)(Qw + (size_t)r32 * PITCH + d0 * 16 + hi * 8);
    LAS float* wsf = (LAS float*)(lds + L_WS) + wid * 64;
    LAS unsigned* flags = (LAS unsigned*)(lds + L_FLAG);
    LAS float* cbl = (LAS float*)(lds + L_CB);
    if (KIND == 0) { const float* ccb = cc + (size_t)(b * NH + h) * SEQ; const float cref = ccb[q0 + 255]; const f32x4 c4 = *((const f32x4*)ccb + tid); *((LAS f32x4*)cbl + tid) = cref - c4; }
    f32x16 o[2]; o[0] = (f32x16){}; o[1] = (f32x16){};
    float mrun = -INFINITY, lrun = 0.f, R = 0.f; bool mydone = false;
    for (int it = 0; it < nIter; ++it) {
        const int t = T_last - it; const int ahead = nIter - 1 - it;
        if (ahead >= 2) asm volatile("s_waitcnt vmcnt(4) lgkmcnt(0)" ::: "memory"); else if (ahead == 1) asm volatile("s_waitcnt vmcnt(2) lgkmcnt(0)" ::: "memory"); else asm volatile("s_waitcnt vmcnt(0) lgkmcnt(0)" ::: "memory");
        __builtin_amdgcn_s_barrier(); asm volatile("" ::: "memory");
        if (KIND == 1 && it > 0) { const u32x4 fa = *(const LAS u32x4*)(flags + ((it - 1) & 1) * 8), fb = *(const LAS u32x4*)(flags + ((it - 1) & 1) * 8 + 4);
            if ((fa.x & fa.y & fa.z & fa.w & fb.x & fb.y & fb.z & fb.w) != 0u) break; }
        if (it + 3 < nIter) ATT_DMA(it + 3);
        if (t <= td && !mydone) {
            const LAS unsigned char* slot = lds + (it & (NSLOT - 1)) * SLOT;
            f32x16 p0, p1;
            if (KIND == 0) {
                const LAS f32x4* cb4 = (const LAS f32x4*)(cbl + t * 64 + 4 * hi);
#pragma unroll
                for (int g = 0; g < 4; ++g) { const f32x4 c0 = cb4[2 * g], c1 = cb4[8 + 2 * g];
#pragma unroll
                    for (int i = 0; i < 4; ++i) { p0[4 * g + i] = c0[i]; p1[4 * g + i] = c1[i]; } }
            } else { p0 = (f32x16){}; p1 = (f32x16){}; }
            const LAS unsigned char* kb = slot + L_K + hi * 1024 + r32 * 16;
#pragma unroll
            for (int d0 = 0; d0 < 4; ++d0) { const bf16x8 b0 = *(const LAS bf16x8*)(kb + d0 * 2048), b1 = *(const LAS bf16x8*)(kb + d0 * 2048 + 512);
                p0 = __builtin_amdgcn_mfma_f32_32x32x16_bf16(b0, qr[d0], p0, 0, 0, 0); p1 = __builtin_amdgcn_mfma_f32_32x32x16_bf16(b1, qr[d0], p1, 0, 0, 0); }
            s16x4 vlo[8], vhi[8];
#define ATT_VREAD() do { const unsigned vb = (unsigned)(uintptr_t)(slot + L_V + ((lane >> 4) & 1) * 32 + (lane & 3) * 8 + (4 * hi + ((lane & 15) >> 2)) * 64); \
              _Pragma("unroll") for (int i = 0; i < 8; ++i) { \
                asm volatile("ds_read_b64_tr_b16 %0, %1 offset:%c2" : "=&v"(vlo[i]) : "v"(vb), "i"((i >> 2) * 4096 + (i & 3) * 1024) : "memory"); \
                asm volatile("ds_read_b64_tr_b16 %0, %1 offset:%c2" : "=&v"(vhi[i]) : "v"(vb), "i"((i >> 2) * 4096 + (i & 3) * 1024 + 512) : "memory"); } } while (0)
            if (KIND == 0) ATT_VREAD();
            const bool diag = (t == td); const int kv0 = t * 64 + 4 * hi;
            if (KIND == 0) {
                if (diag) {
#pragma unroll
                    for (int r = 0; r < 16; ++r) { const int kv = kv0 + (r & 3) + 8 * (r >> 2); if (kv > qabs) p0[r] = -INFINITY; if (kv + 32 > qabs) p1[r] = -INFINITY; }
                }
                float rm = fmaxf(p0[0], p1[0]);
#pragma unroll
                for (int r = 1; r < 16; ++r) rm = fmaxf(rm, fmaxf(p0[r], p1[r]));
                { float a, c; swap_halves(rm, a, c); rm = fmaxf(a, c); }
                if (__any(rm > mrun + 8.0f)) {
                    const float mnew = fmaxf(mrun, rm); const float f = __builtin_amdgcn_exp2f(mrun - mnew); mrun = mnew; lrun *= f;
                    if (hi == 0) wsf[r32] = f;
                    asm volatile("s_waitcnt lgkmcnt(0)" ::: "memory");
#pragma unroll
                    for (int r = 0; r < 16; ++r) { const float fr_ = wsf[crow(r, hi)]; o[0][r] *= fr_; o[1][r] *= fr_; }
                    asm volatile("s_waitcnt lgkmcnt(0)" ::: "memory");
                }
                float ls = 0.f;
#pragma unroll
                for (int r = 0; r < 16; ++r) { p0[r] = __builtin_amdgcn_exp2f(p0[r] - mrun); p1[r] = __builtin_amdgcn_exp2f(p1[r] - mrun); ls += p0[r] + p1[r]; }
                lrun += ls;
            } else {
                f32x16 l0, l1;
#pragma unroll
                for (int r = 0; r < 16; ++r) {
                    { const float z = p0[r]; const float tt = __builtin_amdgcn_logf(1.0f + __builtin_amdgcn_exp2f(-fabsf(z))); l0[r] = -(fmaxf(z, 0.f) + tt); }
                    { const float z = p1[r]; const float tt = __builtin_amdgcn_logf(1.0f + __builtin_amdgcn_exp2f(-fabsf(z))); l1[r] = -(fmaxf(z, 0.f) + tt); }
                }
                if (diag) {
#pragma unroll
                    for (int r = 0; r < 16; ++r) { const int kv = kv0 + (r & 3) + 8 * (r >> 2); if (!(kv < qabs)) l0[r] = 0.f; if (!(kv + 32 < qabs)) l1[r] = 0.f; }
                }
                float G[8], Gp[8];
#pragma unroll
                for (int g = 0; g < 4; ++g) { G[g] = (l0[4 * g] + l0[4 * g + 1]) + (l0[4 * g + 2] + l0[4 * g + 3]); G[4 + g] = (l1[4 * g] + l1[4 * g + 1]) + (l1[4 * g + 2] + l1[4 * g + 3]); }
#pragma unroll
                for (int c = 0; c < 8; ++c) { float a, d; swap_halves(G[c], a, d); Gp[c] = hi ? a : d; }
                float cs = 0.f;
#pragma unroll
                for (int c = 7; c >= 0; --c) {
                    const float ex = cs + (hi ? 0.f : Gp[c]);
                    const int g = c & 3;
                    if (c >= 4) { float s3 = l1[4 * g + 3] + ex, s2 = l1[4 * g + 2] + s3, s1 = l1[4 * g + 1] + s2, s0 = l1[4 * g] + s1; l1[4 * g + 3] = s3; l1[4 * g + 2] = s2; l1[4 * g + 1] = s1; l1[4 * g] = s0; }
                    else        { float s3 = l0[4 * g + 3] + ex, s2 = l0[4 * g + 2] + s3, s1 = l0[4 * g + 1] + s2, s0 = l0[4 * g] + s1; l0[4 * g + 3] = s3; l0[4 * g + 2] = s2; l0[4 * g + 1] = s1; l0[4 * g] = s0; }
                    cs += G[c] + Gp[c];
                }
                ATT_VREAD();
#pragma unroll
                for (int r = 0; r < 16; ++r) { p0[r] = __builtin_amdgcn_exp2f(p0[r] + l0[r] + R); p1[r] = __builtin_amdgcn_exp2f(p1[r] + l1[r] + R); }
                if (diag) {
#pragma unroll
                    for (int r = 0; r < 16; ++r) { const int kv = kv0 + (r & 3) + 8 * (r >> 2); if (!(kv < qabs)) p0[r] = 0.f; if (!(kv + 32 < qabs)) p1[r] = 0.f; }
                }
                R += cs;
                mydone = __all(R < SB_THR);
            }
            u32x4 pw[4];
            pw[0] = (u32x4){cvt_pk_bf16(p0[0], p0[1]), cvt_pk_bf16(p0[2], p0[3]), cvt_pk_bf16(p0[4], p0[5]), cvt_pk_bf16(p0[6], p0[7])};
            pw[1] = (u32x4){cvt_pk_bf16(p0[8], p0[9]), cvt_pk_bf16(p0[10], p0[11]), cvt_pk_bf16(p0[12], p0[13]), cvt_pk_bf16(p0[14], p0[15])};
            pw[2] = (u32x4){cvt_pk_bf16(p1[0], p1[1]), cvt_pk_bf16(p1[2], p1[3]), cvt_pk_bf16(p1[4], p1[5]), cvt_pk_bf16(p1[6], p1[7])};
            pw[3] = (u32x4){cvt_pk_bf16(p1[8], p1[9]), cvt_pk_bf16(p1[10], p1[11]), cvt_pk_bf16(p1[12], p1[13]), cvt_pk_bf16(p1[14], p1[15])};
            asm volatile("s_waitcnt lgkmcnt(0)" ::: "memory"); __builtin_amdgcn_sched_barrier(0);
#pragma unroll
            for (int ks = 0; ks < 4; ++ks)
#pragma unroll
                for (int d0 = 0; d0 < 2; ++d0) { const int i = d0 * 4 + ks;
                    const bf16x8 vf = {vlo[i][0], vlo[i][1], vlo[i][2], vlo[i][3], vhi[i][0], vhi[i][1], vhi[i][2], vhi[i][3]};
                    o[d0] = __builtin_amdgcn_mfma_f32_32x32x16_bf16(__builtin_bit_cast(bf16x8, pw[ks]), vf, o[d0], 0, 0, 0); }
        }
        if (KIND == 1) { if (lane == 0) flags[(it & 1) * 8 + wid] = mydone ? 1u : 0u; }
    }
#undef ATT_DMA
#undef ATT_VREAD
    float inv = 1.0f;
    if (KIND == 0) { float a, c; swap_halves(lrun, a, c); inv = 1.0f / (a + c); }
    if (hi == 0) wsf[32 + r32] = inv;
    asm volatile("s_waitcnt lgkmcnt(0)" ::: "memory");
    LAS bf16_t* stg = (LAS bf16_t*)(lds + L_OST) + wid * 2048;
#pragma unroll
    for (int r = 0; r < 16; ++r) { const int orow = crow(r, hi); const float rl = wsf[32 + orow];
        const unsigned w = cvt_pk_bf16(o[0][r] * rl, o[1][r] * rl);
        stg[orow * 64 + r32] = (bf16_t)(w & 0xffffu); stg[orow * 64 + 32 + r32] = (bf16_t)(w >> 16); }
    asm volatile("s_waitcnt lgkmcnt(0)" ::: "memory");
    bf16_t* Ow = O + (rowbase + qw) * OPITCH + KIND * 512 + h * HD;
#pragma unroll
    for (int i = 0; i < 4; ++i) { const int row = i * 8 + (lane >> 3), ch = lane & 7; const u32x4 v = *(const LAS u32x4*)(stg + row * 64 + ch * 8); *(u32x4*)(Ow + (size_t)row * OPITCH + ch * 8) = v; }
    asm volatile("s_waitcnt vmcnt(0) lgkmcnt(0)" ::: "memory");
    __builtin_amdgcn_s_barrier(); asm volatile("" ::: "memory");
}

constexpr int SB_NSLOT = 8, SB_FLAG = RING_END_ + 64;
__device__ __forceinline__ void attn_unit_sb(int b, int h, int qb, const bf16_t* QKV, bf16_t* O, LAS unsigned char* lds) {
    const int tid = threadIdx.x, lane = tid & 63, r32 = lane & 31, hi = lane >> 5; const int wid = __builtin_amdgcn_readfirstlane(tid >> 6);
    const size_t rowbase = (size_t)b * SEQ; const int q0 = qb * 256, qw = q0 + wid * 32, qabs = qw + r32;
    const int colq = 1536 + h * HD;
    const bf16_t* ksrc = QKV + rowbase * PITCH + colq + 512 + (size_t)lane * PITCH + wid * 8;
    const bf16_t* vsrc = QKV + rowbase * PITCH + colq + 1024 + (size_t)(16 * (wid & 3) + (lane >> 2)) * PITCH + (wid >> 2) * 32 + (lane & 3) * 8;
    const int wdst = wid * 1024;
    const int nT = qb * 4 + 4, T_last = nT - 1, dw = 3 - (wid >> 1);
#define SB_DMA(ux) do { const int t_ = T_last - (ux); LAS unsigned char* sl_ = lds + ((ux) & (SB_NSLOT - 1)) * SLOT + wdst; \
        __builtin_amdgcn_global_load_lds((const unsigned*)(ksrc + (size_t)t_ * 64 * PITCH), (LAS unsigned*)(sl_ + L_K), 16, 0, 0); \
        __builtin_amdgcn_global_load_lds((const unsigned*)(vsrc + (size_t)t_ * 64 * PITCH), (LAS unsigned*)(sl_ + L_V), 16, 0, 0); } while (0)
    SB_DMA(0); SB_DMA(1); SB_DMA(2); SB_DMA(3);
    if (nT > 4) { SB_DMA(4); SB_DMA(5); }
    const bf16_t* Qw = QKV + (rowbase + qw) * PITCH + colq;
    bf16x8 qr[4];
#pragma unroll
    for (int d0 = 0; d0 < 4; ++d0) qr[d0] = *(const bf16x8*)(Qw + (size_t)r32 * PITCH + d0 * 16 + hi * 8);
    LAS unsigned* flags = (LAS unsigned*)(lds + SB_FLAG);
    f32x16 o[2]; o[0] = (f32x16){}; o[1] = (f32x16){};
    float R = 0.f; bool mydone = false;
    for (int s = 0; s < nT; ++s) {
        { const int issued = (s + 5 < nT - 1) ? s + 5 : nT - 1, need = (s + 3 < nT - 1) ? s + 3 : nT - 1; const int cnt = issued - need;
          if (cnt >= 2) asm volatile("s_waitcnt vmcnt(4) lgkmcnt(0)" ::: "memory"); else if (cnt == 1) asm volatile("s_waitcnt vmcnt(2) lgkmcnt(0)" ::: "memory"); else asm volatile("s_waitcnt vmcnt(0) lgkmcnt(0)" ::: "memory"); }
        __builtin_amdgcn_s_barrier(); asm volatile("" ::: "memory");
        if (s > 0) { const u32x4 fa = *(const LAS u32x4*)(flags + ((s - 1) & 1) * 8), fb = *(const LAS u32x4*)(flags + ((s - 1) & 1) * 8 + 4);
            if ((fa.x & fa.y & fa.z & fa.w & fb.x & fb.y & fb.z & fb.w) != 0u) break; }
        if (s + 6 < nT) SB_DMA(s + 6);
        const int u = s + dw;
        if (u >= nT) mydone = true;
        if (!mydone) {
            const int t = T_last - u; const LAS unsigned char* slot = lds + (u & (SB_NSLOT - 1)) * SLOT;
            f32x16 p0 = (f32x16){}, p1 = (f32x16){};
            const LAS unsigned char* kb = slot + L_K + hi * 1024 + r32 * 16;
#pragma unroll
            for (int d0 = 0; d0 < 4; ++d0) { const bf16x8 b0 = *(const LAS bf16x8*)(kb + d0 * 2048), b1 = *(const LAS bf16x8*)(kb + d0 * 2048 + 512);
                p0 = __builtin_amdgcn_mfma_f32_32x32x16_bf16(b0, qr[d0], p0, 0, 0, 0); p1 = __builtin_amdgcn_mfma_f32_32x32x16_bf16(b1, qr[d0], p1, 0, 0, 0); }
            const bool diag = (s == 0); const int kv0 = t * 64 + 4 * hi;
            f32x16 l0, l1;
#pragma unroll
            for (int r = 0; r < 16; ++r) {
                { const float z = p0[r]; const float tt = __builtin_amdgcn_logf(1.0f + __builtin_amdgcn_exp2f(-fabsf(z))); l0[r] = -(fmaxf(z, 0.f) + tt); }
                { const float z = p1[r]; const float tt = __builtin_amdgcn_logf(1.0f + __builtin_amdgcn_exp2f(-fabsf(z))); l1[r] = -(fmaxf(z, 0.f) + tt); }
            }
            if (diag) {
#pragma unroll
                for (int r = 0; r < 16; ++r) { const int kv = kv0 + (r & 3) + 8 * (r >> 2); if (!(kv < qabs)) l0[r] = 0.f; if (!(kv + 32 < qabs)) l1[r] = 0.f; }
            }
            float G[8], Gp[8];
#pragma unroll
            for (int g = 0; g < 4; ++g) { G[g] = (l0[4 * g] + l0[4 * g + 1]) + (l0[4 * g + 2] + l0[4 * g + 3]); G[4 + g] = (l1[4 * g] + l1[4 * g + 1]) + (l1[4 * g + 2] + l1[4 * g + 3]); }
#pragma unroll
            for (int c = 0; c < 8; ++c) { float a, d; swap_halves(G[c], a, d); Gp[c] = hi ? a : d; }
            float cs = R;
#pragma unroll
            for (int c = 7; c >= 0; --c) {
                const float ex = cs + (hi ? 0.f : Gp[c]);
                const int g = c & 3;
                if (c >= 4) { float s3 = l1[4 * g + 3] + ex, s2 = l1[4 * g + 2] + s3, s1 = l1[4 * g + 1] + s2, s0 = l1[4 * g] + s1; l1[4 * g + 3] = s3; l1[4 * g + 2] = s2; l1[4 * g + 1] = s1; l1[4 * g] = s0; }
                else        { float s3 = l0[4 * g + 3] + ex, s2 = l0[4 * g + 2] + s3, s1 = l0[4 * g + 1] + s2, s0 = l0[4 * g] + s1; l0[4 * g + 3] = s3; l0[4 * g + 2] = s2; l0[4 * g + 1] = s1; l0[4 * g] = s0; }
                cs += G[c] + Gp[c];
            }
            s16x4 vlo[8], vhi[8];
            { const unsigned vb = (unsigned)(uintptr_t)(slot + L_V + ((lane >> 4) & 1) * 32 + (lane & 3) * 8 + (4 * hi + ((lane & 15) >> 2)) * 64);
#pragma unroll
              for (int i = 0; i < 8; ++i) {
                asm volatile("ds_read_b64_tr_b16 %0, %1 offset:%c2" : "=&v"(vlo[i]) : "v"(vb), "i"((i >> 2) * 4096 + (i & 3) * 1024) : "memory");
                asm volatile("ds_read_b64_tr_b16 %0, %1 offset:%c2" : "=&v"(vhi[i]) : "v"(vb), "i"((i >> 2) * 4096 + (i & 3) * 1024 + 512) : "memory"); } }
#pragma unroll
            for (int r = 0; r < 16; ++r) { p0[r] = __builtin_amdgcn_exp2f(p0[r] + l0[r]); p1[r] = __builtin_amdgcn_exp2f(p1[r] + l1[r]); }
            if (diag) {
#pragma unroll
                for (int r = 0; r < 16; ++r) { const int kv = kv0 + (r & 3) + 8 * (r >> 2); if (!(kv < qabs)) p0[r] = 0.f; if (!(kv + 32 < qabs)) p1[r] = 0.f; }
            }
            R = cs;
            mydone = __all(R < SB_THR);
            u32x4 pw[4];
            pw[0] = (u32x4){cvt_pk_bf16(p0[0], p0[1]), cvt_pk_bf16(p0[2], p0[3]), cvt_pk_bf16(p0[4], p0[5]), cvt_pk_bf16(p0[6], p0[7])};
            pw[1] = (u32x4){cvt_pk_bf16(p0[8], p0[9]), cvt_pk_bf16(p0[10], p0[11]), cvt_pk_bf16(p0[12], p0[13]), cvt_pk_bf16(p0[14], p0[15])};
            pw[2] = (u32x4){cvt_pk_bf16(p1[0], p1[1]), cvt_pk_bf16(p1[2], p1[3]), cvt_pk_bf16(p1[4], p1[5]), cvt_pk_bf16(p1[6], p1[7])};
            pw[3] = (u32x4){cvt_pk_bf16(p1[8], p1[9]), cvt_pk_bf16(p1[10], p1[11]), cvt_pk_bf16(p1[12], p1[13]), cvt_pk_bf16(p1[14], p1[15])};
            asm volatile("s_waitcnt lgkmcnt(0)" ::: "memory"); __builtin_amdgcn_sched_barrier(0);
#pragma unroll
            for (int ks = 0; ks < 4; ++ks)
#pragma unroll
                for (int d0 = 0; d0 < 2; ++d0) { const int i = d0 * 4 + ks;
                    const bf16x8 vf = {vlo[i][0], vlo[i][1], vlo[i][2], vlo[i][3], vhi[i][0], vhi[i][1], vhi[i][2], vhi[i][3]};
                    o[d0] = __builtin_amdgcn_mfma_f32_32x32x16_bf16(__builtin_bit_cast(bf16x8, pw[ks]), vf, o[d0], 0, 0, 0); }
        }
        if (lane == 0) flags[(s & 1) * 8 + wid] = mydone ? 1u : 0u;
    }
#undef SB_DMA
    asm volatile("s_waitcnt vmcnt(0) lgkmcnt(0)" ::: "memory");
    __builtin_amdgcn_s_barrier(); asm volatile("" ::: "memory");
    LAS bf16_t* stg = (LAS bf16_t*)lds + wid * 2048;
#pragma unroll
    for (int r = 0; r < 16; ++r) { const int orow = crow(r, hi); const unsigned w = cvt_pk_bf16(o[0][r], o[1][r]);
        stg[orow * 64 + r32] = (bf16_t)(w & 0xffffu); stg[orow * 64 + 32 + r32] = (bf16_t)(w >> 16); }
    asm volatile("s_waitcnt lgkmcnt(0)" ::: "memory");
    bf16_t* Ow = O + (rowbase + qw) * OPITCH + 512 + h * HD;
#pragma unroll
    for (int i = 0; i < 4; ++i) { const int row = i * 8 + (lane >> 3), ch = lane & 7; const u32x4 v = *(const LAS u32x4*)(stg + row * 64 + ch * 8); *(u32x4*)(Ow + (size_t)row * OPITCH + ch * 8) = v; }
    asm volatile("s_waitcnt vmcnt(0) lgkmcnt(0)" ::: "memory");
    __builtin_amdgcn_s_barrier(); asm volatile("" ::: "memory");
}
}

#define XB_TMO      128
#define XB_XCNT(j)  (256  + 64 * (j))
#define XB_XSUB(j)  (1280 + 64 * (j))
#define XB_XGEN(j)  (2304 + 64 * (j))
#define XB_TOP      3328
#define XB_TOPGEN   3392
#define XCD_BAR_WORDS 3456
#define XB_SPIN_CAP (1u << 18)
__device__ __forceinline__ unsigned xb_ld(unsigned* p)              { return __hip_atomic_load(p, __ATOMIC_RELAXED, __HIP_MEMORY_SCOPE_AGENT); }
__device__ __forceinline__ unsigned xb_add(unsigned* p, unsigned v) { return __hip_atomic_fetch_add(p, v, __ATOMIC_RELAXED, __HIP_MEMORY_SCOPE_AGENT); }
__device__ __forceinline__ unsigned xb_xcc_id() { return (unsigned)__builtin_amdgcn_s_getreg((3 << 11) | 20) & 0xFu; }
#define XB_SPIN(cond, bar) do { unsigned _sp = 0; while (cond) { __builtin_amdgcn_s_sleep(1); \
    if ((++_sp & 255u) == 0u) { if (xb_ld(&(bar)[XB_TMO])) break; if (_sp > XB_SPIN_CAP) { atomicAdd(&(bar)[XB_TMO], 1u); break; } } } } while (0)
struct XcdBarrier { unsigned* bar; unsigned x; volatile LAS unsigned* st; };
__device__ __forceinline__ XcdBarrier xcd_barrier_post(unsigned* bar, volatile LAS unsigned* st) {
    XcdBarrier b; b.bar = bar; b.x = xb_xcc_id(); b.st = st;
    if (threadIdx.x == 0) (void)xb_add(&bar[XB_XCNT(b.x)], 1u);
    return b;
}
__device__ __forceinline__ void xcd_barrier_complete(unsigned* bar, unsigned x, unsigned& nloc, unsigned& nx) {
    const unsigned G = gridDim.x * gridDim.y * gridDim.z;
    unsigned sum, cnt, mine, sp = 0u;
    for (;;) {
        sum = 0u; cnt = 0u; mine = 0u;
#pragma unroll
        for (unsigned j = 0; j < 16; ++j) { const unsigned c = xb_ld(&bar[XB_XCNT(j)]); sum += c; cnt += (c > 0u) ? 1u : 0u; mine = (j == x) ? c : mine; }
        if (sum == G) break;
        __builtin_amdgcn_s_sleep(1);
        if ((++sp & 255u) == 0u) { if (xb_ld(&bar[XB_TMO])) break; if (sp > XB_SPIN_CAP) { atomicAdd(&bar[XB_TMO], 1u); break; } }
    }
    nloc = mine > 0u ? mine : 1u; nx = cnt > 0u ? cnt : 1u;
}
__device__ __forceinline__ void xcd_barrier(const XcdBarrier& b) {
    asm volatile("s_waitcnt vmcnt(0)" ::: "memory");
    __syncthreads();
    if (threadIdx.x == 0) {
        unsigned* bar = b.bar;
        __builtin_amdgcn_s_waitcnt(0);
        unsigned nloc = b.st[0], nx = b.st[1];
        if (nloc == 0u) { xcd_barrier_complete(bar, b.x, nloc, nx); b.st[0] = nloc; b.st[1] = nx; }
        const unsigned old = xb_add(&bar[XB_XSUB(b.x)], 1u);
        const unsigned gen = old / nloc;
        if (old + 1u == (gen + 1u) * nloc) {
            __builtin_amdgcn_fence(__ATOMIC_RELEASE, "agent");
            asm volatile("s_waitcnt vmcnt(0)" ::: "memory");
            const unsigned og = xb_add(&bar[XB_TOP], 1u);
            const unsigned tg = og / nx;
            if (og + 1u == (tg + 1u) * nx) xb_add(&bar[XB_TOPGEN], 1u);
            else XB_SPIN(xb_ld(&bar[XB_TOPGEN]) == tg, bar);
            __builtin_amdgcn_fence(__ATOMIC_ACQUIRE, "agent");
            xb_add(&bar[XB_XGEN(b.x)], 1u);
            asm volatile("s_waitcnt vmcnt(0)" ::: "memory");
        } else {
            XB_SPIN(xb_ld(&bar[XB_XGEN(b.x)]) == gen, bar);
            __builtin_amdgcn_fence(__ATOMIC_ACQUIRE, "agent");
            asm volatile("s_waitcnt vmcnt(0)" ::: "memory");
        }
    }
    __syncthreads();
}

constexpr int NWAVES = 8;
constexpr int RING_BYTES = 131072, LDS_BYTES = 147456;
static_assert(att::L_END <= RING_BYTES, "attention scratch fits the ring region");

__device__ __forceinline__ float wave_sum(float v) {
#pragma unroll
    for (int o = 1; o < 64; o <<= 1) v += __shfl_xor(v, o);
    return v;
}
__device__ __forceinline__ void tr_item(const float* W, int ldw, int col0, int K, bf16_t* WT, int row_off, LAS float* scr, int kb, int nb, int lane, const float* gs) {
    const int k0 = 64 * kb, n0 = 32 * nb;
    float wv[32];
#pragma unroll
    for (int i = 0; i < 32; ++i) { const int kk = 2 * i + (lane >> 5); wv[i] = W[(size_t)(k0 + kk) * ldw + col0 + n0 + (lane & 31)]; }
    if (gs) {
#pragma unroll
        for (int i = 0; i < 32; ++i) wv[i] *= gs[k0 + 2 * i + (lane >> 5)];
    }
#pragma unroll
    for (int i = 0; i < 32; ++i) { const int kk = 2 * i + (lane >> 5); scr[kk * 33 + (lane & 31)] = wv[i]; }
    asm volatile("s_waitcnt lgkmcnt(0)" ::: "memory");
    const int c = lane & 7;
#pragma unroll
    for (int j = 0; j < 4; ++j) { const int n = (lane >> 3) + 8 * j; const LAS float* s = scr + (8 * c) * 33 + n;
        u32x4 o; o.x = cvt_pk_bf16(s[0 * 33], s[1 * 33]); o.y = cvt_pk_bf16(s[2 * 33], s[3 * 33]); o.z = cvt_pk_bf16(s[4 * 33], s[5 * 33]); o.w = cvt_pk_bf16(s[6 * 33], s[7 * 33]);
        *(u32x4*)(WT + (size_t)(row_off + n0 + n) * K + k0 + 8 * c) = o; }
    asm volatile("s_waitcnt lgkmcnt(0)" ::: "memory");
}

struct Args { const float* in[16]; float* out; unsigned char* ws; int ph_lo, ph_hi; };

__global__ void __launch_bounds__(NWAVES * 64, 2) fwd_megakernel(Args args) {
    __builtin_assume(__builtin_amdgcn_workitem_id_y() == 0); __builtin_assume(__builtin_amdgcn_workitem_id_z() == 0);
    extern __shared__ __attribute__((aligned(16))) unsigned char lds_raw[];
    LAS unsigned char* lds = (LAS unsigned char*)lds_raw;
    const int tid = threadIdx.x, lane = tid & 63, wave = __builtin_amdgcn_readfirstlane(tid >> 6);
    const int G = gridDim.x, bx = blockIdx.x, vcu = (G % 8 == 0) ? (bx % 8) * (G / 8) + bx / 8 : bx;
    const int gw = vcu * NWAVES + wave, NGW = G * NWAVES;
    unsigned char* ws = args.ws;
    const float* x = args.in[0]; const float* p_in = args.in[1]; const float* g_mix = args.in[2]; const float* w_in = args.in[3]; const float* b_forget = args.in[4]; const float* b_gate = args.in[5];
    const float* w_bf = args.in[6]; const float* w_bs = args.in[7]; const float* w_out = args.in[8]; const float* g_mlp = args.in[9]; const float* w_up = args.in[10]; const float* w_dn = args.in[11];
    const float* g_ple = args.in[12]; const float* w_pg = args.in[13]; const float* w_ple = args.in[14]; const float* g_final = args.in[15];
    float* out = args.out;
    bf16_t* Win_t = (bf16_t*)(ws + WS_WIN); bf16_t* Wbf_t = (bf16_t*)(ws + WS_WBF); bf16_t* Wbs_t = (bf16_t*)(ws + WS_WBS); bf16_t* Wout_t = (bf16_t*)(ws + WS_WOUT);
    bf16_t* Wup_t = (bf16_t*)(ws + WS_WUP); bf16_t* Wdn_t = (bf16_t*)(ws + WS_WDN); bf16_t* Wpg_t = (bf16_t*)(ws + WS_WPG); bf16_t* Wple_t = (bf16_t*)(ws + WS_WPLE);
    float* LOGF = (float*)(ws + WS_LOGF); float* CC = (float*)(ws + WS_CC); float* SSQ1 = (float*)(ws + WS_SSQ1); float* SSQ2 = (float*)(ws + WS_SSQ2);
    bf16_t* PB = (bf16_t*)(ws + WS_PB); bf16_t* BUFA = (bf16_t*)(ws + WS_BUFA); bf16_t* BUFB = (bf16_t*)(ws + WS_BUFB); bf16_t* QKV = (bf16_t*)(ws + WS_QKV); bf16_t* SG = (bf16_t*)(ws + WS_SG);
    bf16_t* HB = (bf16_t*)(ws + WS_H); bf16_t* EB = (bf16_t*)(ws + WS_E);
    const int lo = args.ph_lo, hi = args.ph_hi;
#define IN(k) (lo <= (k) && (k) < hi)
    volatile LAS unsigned* bst = (volatile LAS unsigned*)(lds + RING_BYTES);
    if (tid < 2) bst[tid] = 0u;
    __syncthreads();
    XcdBarrier xbar; xbar.bar = (unsigned*)ws; xbar.x = 0; xbar.st = bst;
    if (hi - lo > 1) xbar = xcd_barrier_post((unsigned*)ws, bst);
#define SEAM(k) do { if (IN(k) && IN((k) + 1)) { if (hi > N_PHASES) cg::this_grid().sync(); else xcd_barrier(xbar); } } while (0)

    if (IN(0)) {
        LAS float* scr = (LAS float*)(lds + wave * 8448);
        LAS f32x4* wtab = (LAS f32x4*)(lds + 69632);
        {
            constexpr int NSEG = 9;
            int base = 0;
            for (int it = gw; ; it += NGW) {
                int r = it; const float* W; int ldw, col0, K, nblk, row_off; bf16_t* WT; const float* gs = nullptr;
                if (r < 16 * 48) { W = w_in; ldw = NIN_SRC; col0 = 0; K = DM; nblk = 48; WT = Win_t; row_off = 0; }
                else if ((r -= 16 * 48) < 16 * 112) { W = w_in; ldw = NIN_SRC; col0 = 1544; K = DM; nblk = 112; WT = Win_t; row_off = 1536; }
                else if ((r -= 16 * 112) < 8 * 32) { W = w_bf; ldw = DM; col0 = 0; K = 512; nblk = 32; WT = Wbf_t; row_off = 0; }
                else if ((r -= 8 * 32) < 8 * 32) { W = w_bs; ldw = DM; col0 = 0; K = 512; nblk = 32; WT = Wbs_t; row_off = 0; }
                else if ((r -= 8 * 32) < 16 * 32) { W = w_out; ldw = DM; col0 = 0; K = DM; nblk = 32; WT = Wout_t; row_off = 0; }
                else if ((r -= 16 * 32) < 16 * 128) { W = w_up; ldw = DFF; col0 = 0; K = DM; nblk = 128; WT = Wup_t; row_off = 0; gs = g_mlp; }
                else if ((r -= 16 * 128) < 64 * 32) { W = w_dn; ldw = DM; col0 = 0; K = DFF; nblk = 32; WT = Wdn_t; row_off = 0; }
                else if ((r -= 64 * 32) < 16 * 32) { W = w_pg; ldw = DM; col0 = 0; K = DM; nblk = 32; WT = Wpg_t; row_off = 0; gs = g_ple; }
                else if ((r -= 16 * 32) < 4 * 32) { W = w_ple; ldw = DM; col0 = 0; K = DPLE; nblk = 32; WT = Wple_t; row_off = 0; }
                else break;
                tr_item(W, ldw, col0, K, WT, row_off, scr, r / nblk, r % nblk, lane, gs);
                (void)base; (void)NSEG;
            }
        }
        {
            f32x4 gm[4];
#pragma unroll
            for (int j = 0; j < 4; ++j) gm[j] = *((const f32x4*)g_mix + lane + 64 * j);
#pragma unroll
            for (int q = 0; q < 2; ++q) { const int k = tid + 512 * q; const float gk = g_mix[k]; const float* wp = w_in + (size_t)k * NIN_SRC + 1536;
                const int ln = (k & 255) >> 2, e = k & 3, j = k >> 8;
                wtab[((j * 4 + e) * 2 + 0) * 64 + ln] = *(const f32x4*)wp * gk; wtab[((j * 4 + e) * 2 + 1) * 64 + ln] = *(const f32x4*)(wp + 4) * gk; }
            __syncthreads();
            const float bfv = b_forget[lane & 7];
            for (int m0 = gw; m0 < M; m0 += 2 * NGW) {
                f32x4 va[2][4];
#pragma unroll
                for (int q = 0; q < 2; ++q)
#pragma unroll
                    for (int j = 0; j < 4; ++j) va[q][j] = *((const f32x4*)(x + (size_t)(m0 + q * NGW) * DM) + lane + 64 * j);
#pragma unroll
                for (int q = 0; q < 2; ++q) {
                    const int m = m0 + q * NGW;
                    f32x4 v[4]; float s = 0.f;
#pragma unroll
                    for (int j = 0; j < 4; ++j) { v[j] = va[q][j]; s += (v[j][0] * v[j][0] + v[j][1] * v[j][1]) + (v[j][2] * v[j][2] + v[j][3] * v[j][3]); }
                    const float rstd = __builtin_amdgcn_rsqf(wave_sum(s) * (1.0f / DM) + EPS);
                    f32x4 f0 = {0.f, 0.f, 0.f, 0.f}, f1 = {0.f, 0.f, 0.f, 0.f};
#pragma unroll
                    for (int j = 0; j < 4; ++j)
#pragma unroll
                        for (int e = 0; e < 4; ++e) { f0 += wtab[((j * 4 + e) * 2 + 0) * 64 + lane] * v[j][e]; f1 += wtab[((j * 4 + e) * 2 + 1) * 64 + lane] * v[j][e]; }
                    unsigned long long* o8 = (unsigned long long*)(BUFA + (size_t)m * DM) + lane;
#pragma unroll
                    for (int j = 0; j < 4; ++j) { const f32x4 y = v[j] * gm[j] * rstd; o8[64 * j] = (unsigned long long)cvt_pk_bf16(y[0], y[1]) | ((unsigned long long)cvt_pk_bf16(y[2], y[3]) << 32); }
                    float fl[8];
#pragma unroll
                    for (int e = 0; e < 4; ++e) { fl[e] = wave_sum(f0[e]); fl[4 + e] = wave_sum(f1[e]); }
                    float mine = fl[0];
#pragma unroll
                    for (int e = 1; e < 8; ++e) mine = ((lane & 7) == e) ? fl[e] : mine;
                    const float y2 = (mine * rstd + bfv) * LOG2E;
                    const float lf = -(fmaxf(-y2, 0.f) + __builtin_amdgcn_logf(1.0f + __builtin_amdgcn_exp2f(-fabsf(y2))));
                    if (lane < 8) LOGF[(size_t)((m / SEQ) * NH + lane) * SEQ + (m % SEQ)] = lf;
                }
            }
        }
        {
            const size_t n8 = (size_t)M * DPLE / 8;
            for (size_t i = (size_t)bx * 512 + tid; i < n8; i += (size_t)G * 512) { const f32x4 a = *((const f32x4*)p_in + 2 * i), c = *((const f32x4*)p_in + 2 * i + 1);
                u32x4 w; w.x = cvt_pk_bf16(a[0], a[1]); w.y = cvt_pk_bf16(a[2], a[3]); w.z = cvt_pk_bf16(c[0], c[1]); w.w = cvt_pk_bf16(c[2], c[3]); *((u32x4*)PB + i) = w; }
        }
    }
    SEAM(0);

    if (IN(1)) {
        if (gw < BATCH * NH) {
            const float* src = LOGF + (size_t)gw * SEQ + lane * 32; float* dst = CC + (size_t)gw * SEQ + lane * 32;
            f32x4 v[8]; float run = 0.f;
#pragma unroll
            for (int j = 0; j < 8; ++j) { v[j] = *((const f32x4*)src + j);
#pragma unroll
                for (int e = 0; e < 4; ++e) { run += v[j][e]; v[j][e] = run; } }
            float incl = run;
#pragma unroll
            for (int o = 1; o < 64; o <<= 1) { const float tv = __shfl_up(incl, o); if (lane >= o) incl += tv; }
            const float excl = incl - run;
#pragma unroll
            for (int j = 0; j < 8; ++j) *((f32x4*)dst + j) = v[j] + excl;
        }
        pg8::Gemm g{DM, DM, DM};
        pg8::PlainSched S; S.T.init(M, NIN, G, bx); S.A = (const char*)BUFA; S.B = (const char*)Win_t; S.astep = (size_t)256 * DM * 2; S.bstep = (size_t)256 * DM * 2;
        pg8::EpiQKVG E{QKV, SG, b_gate};
        pg8::gemm_phase<pg8::EpiQKVG, pg8::PlainSched>(lds, g, S, E);
    }
    SEAM(1);

    if (IN(2)) {
        for (int i = 0; i < 8; ++i) {
            const int j = i & 3, kind = i >> 2;
            for (int bh = (vcu >> 1); bh < BATCH * NH; bh += (G >> 1)) {
                const int s = (vcu & 1) * 2 + (j >> 1); const int qb = (j & 1) ? 7 - s : s;
                if (kind == 0) att::attn_unit<0>(bh / NH, bh % NH, qb, QKV, CC, BUFB, lds);
                else att::attn_unit_sb(bh / NH, bh % NH, qb, QKV, BUFB, lds);
            }
        }
    }
    SEAM(2);

    if (IN(3)) {
        pg8::Gemm g{DM, 512, 512};
        pg8::PairSched S; S.T.init(M, DM, G, bx); S.A0 = (const char*)BUFB; S.A1 = (const char*)(BUFB + 512); S.B0 = (const char*)Wbf_t; S.B1 = (const char*)Wbs_t; S.astep = (size_t)256 * DM * 2; S.bstep = (size_t)256 * 512 * 2;
        pg8::EpiBranch E{SG, BUFA};
        pg8::gemm_phase<pg8::EpiBranch, pg8::PairSched>(lds, g, S, E);
    }
    SEAM(3);

    if (IN(4)) {
        {
            pg8::Gemm g{DM, DM, DM};
            pg8::PlainSched S; S.T.init(M, DM, G, bx); S.A = (const char*)BUFA; S.B = (const char*)Wout_t; S.astep = (size_t)256 * DM * 2; S.bstep = (size_t)256 * DM * 2;
            pg8::EpiRes4 E{x, BUFB, SSQ1};
            pg8::gemm_phase<pg8::EpiRes4, pg8::PlainSched>(lds, g, S, E);
        }
        {
            pg8::Gemm g{DPLE, DPLE, DPLE};
            pg8::PlainSched S; S.T.init(M, DM, G, bx); S.A = (const char*)PB; S.B = (const char*)Wple_t; S.astep = (size_t)256 * DPLE * 2; S.bstep = (size_t)256 * DPLE * 2;
            pg8::EpiBf16 E{EB, DM};
            pg8::gemm_phase<pg8::EpiBf16, pg8::PlainSched>(lds, g, S, E);
        }
    }
    SEAM(4);

    if (IN(5)) {
        pg8::Gemm g{DM, DM, DM};
        pg8::PlainSched S; S.T.init(M, DFF, G, bx); S.A = (const char*)BUFB; S.B = (const char*)Wup_t; S.astep = (size_t)256 * DM * 2; S.bstep = (size_t)256 * DM * 2;
        pg8::EpiUp E{HB, SSQ1};
        pg8::gemm_phase<pg8::EpiUp, pg8::PlainSched>(lds, g, S, E);
    }
    SEAM(5);

    if (IN(6)) {
        pg8::Gemm g{DFF, DFF, DFF};
        pg8::PlainSched S; S.T.init(M, DM, G, bx); S.A = (const char*)HB; S.B = (const char*)Wdn_t; S.astep = (size_t)256 * DFF * 2; S.bstep = (size_t)256 * DFF * 2;
        pg8::EpiRes6 E{BUFB, BUFA, SSQ2};
        pg8::gemm_phase<pg8::EpiRes6, pg8::PlainSched>(lds, g, S, E);
    }
    SEAM(6);

    if (IN(7)) {
        pg8::Gemm g{DM, DM, DM};
        pg8::PlainSched S; S.T.init(M, DM, G, bx); S.A = (const char*)BUFA; S.B = (const char*)Wpg_t; S.astep = (size_t)256 * DM * 2; S.bstep = (size_t)256 * DM * 2;
        pg8::EpiPle E{BUFA, BUFB, EB, SSQ2};
        pg8::gemm_phase<pg8::EpiPle, pg8::PlainSched>(lds, g, S, E);
    }
    SEAM(7);

    if (IN(8)) {
        f32x4 gf[4];
#pragma unroll
        for (int j = 0; j < 2; ++j) { gf[2 * j] = *((const f32x4*)g_final + 2 * lane + 128 * j); gf[2 * j + 1] = *((const f32x4*)g_final + 2 * lane + 128 * j + 1); }
        for (int m = gw; m < M; m += 2 * NGW) {
            u32x4 w[2][2];
#pragma unroll
            for (int q = 0; q < 2; ++q)
#pragma unroll
                for (int j = 0; j < 2; ++j) w[q][j] = *((const u32x4*)(BUFB + (size_t)(m + q * NGW) * DM) + lane + 64 * j);
#pragma unroll
            for (int q = 0; q < 2; ++q) {
                f32x4 v[4]; float s = 0.f;
#pragma unroll
                for (int j = 0; j < 2; ++j) { v[2 * j] = pg8::bf4_lo(w[q][j]); v[2 * j + 1] = pg8::bf4_hi(w[q][j]); }
#pragma unroll
                for (int j = 0; j < 4; ++j) s += (v[j][0] * v[j][0] + v[j][1] * v[j][1]) + (v[j][2] * v[j][2] + v[j][3] * v[j][3]);
                const float rstd = __builtin_amdgcn_rsqf(wave_sum(s) * (1.0f / DM) + EPS);
                f32x4* orow = (f32x4*)(out + (size_t)(m + q * NGW) * DM);
#pragma unroll
                for (int j = 0; j < 2; ++j) { orow[2 * lane + 128 * j] = v[2 * j] * gf[2 * j] * rstd; orow[2 * lane + 128 * j + 1] = v[2 * j + 1] * gf[2 * j + 1] * rstd; }
            }
        }
    }
#undef IN
#undef SEAM
}

extern "C" void kernel_launch(void* const* d_in, const int* in_sizes, int n_in, void* d_out, int out_size, void* d_ws, size_t ws_size, hipStream_t stream) {
    static int grid = 0;
    if (grid == 0) {
        if (n_in != 16 || in_sizes[0] != M * DM || out_size != M * DM || ws_size < WS_END) { fprintf(stderr, "kernel_launch: unexpected shapes (n_in %d, in0 %d, out %d, ws %zu); nothing launched\n", n_in, n_in > 0 ? in_sizes[0] : -1, out_size, ws_size); grid = -1; return; }
        int dev = 0, cus = 0, per_cu = 0;
        if (hipGetDevice(&dev) != hipSuccess || hipDeviceGetAttribute(&cus, hipDeviceAttributeMultiprocessorCount, dev) != hipSuccess) { grid = -1; return; }
        if (hipFuncSetAttribute((const void*)fwd_megakernel, hipFuncAttributeMaxDynamicSharedMemorySize, LDS_BYTES) != hipSuccess) { fprintf(stderr, "kernel_launch: hipFuncSetAttribute failed\n"); grid = -1; return; }
        if (hipOccupancyMaxActiveBlocksPerMultiprocessor(&per_cu, (const void*)fwd_megakernel, NWAVES * 64, LDS_BYTES) != hipSuccess || per_cu < 1) { fprintf(stderr, "kernel_launch: occupancy query says %d\n", per_cu); per_cu = 1; }
        (void)hipGetLastError();
        grid = cus;
        if (grid != 256) fprintf(stderr, "kernel_launch: %d CUs; built for 256\n", grid);
    }
    if (grid < 0) return;
    if (hipMemsetAsync(d_ws, 0, 16384, stream) != hipSuccess) { fprintf(stderr, "kernel_launch: memset failed\n"); return; }
    Args a{};
    for (int i = 0; i < 16; ++i) a.in[i] = (const float*)d_in[i];
    a.out = (float*)d_out; a.ws = (unsigned char*)d_ws;
#if MK_N_LAUNCHES == 1
    a.ph_lo = 0; a.ph_hi = N_PHASES;
    void* kargs[] = {&a};
    hipError_t e = hipLaunchCooperativeKernel((const void*)fwd_megakernel, dim3(grid), dim3(NWAVES * 64), kargs, LDS_BYTES, stream);
    if (e != hipSuccess) fprintf(stderr, "kernel_launch: cooperative launch failed: %s (grid %d)\n", hipGetErrorString(e), grid);
#else
    for (int li = 0; li < N_PHASES; ++li) { a.ph_lo = li; a.ph_hi = li + 1; hipLaunchKernelGGL(fwd_megakernel, dim3(grid), dim3(NWAVES * 64), LDS_BYTES, stream, a); }
#endif
}
```

```cpp
#include <hip/hip_runtime.h>
#include <hip/hip_cooperative_groups.h>
#include <cstdio>
#include <cstdint>
namespace cg = cooperative_groups;

#ifndef MK_N_LAUNCHES
#define MK_N_LAUNCHES 1
#endif
constexpr int N_PHASES = 9;

#define LAS __attribute__((address_space(3)))
typedef unsigned short bf16_t;
typedef short bf16x8 __attribute__((ext_vector_type(8)));
typedef short s16x4 __attribute__((ext_vector_type(4)));
typedef float f32x4 __attribute__((ext_vector_type(4)));
typedef float f32x2 __attribute__((ext_vector_type(2)));
typedef float f32x16 __attribute__((ext_vector_type(16)));
typedef unsigned u32x4 __attribute__((ext_vector_type(4)));
typedef unsigned u32x2 __attribute__((ext_vector_type(2)));
typedef __bf16 bf16x2_t __attribute__((ext_vector_type(2)));

constexpr int BATCH = 16, SEQ = 2048, DM = 1024, M = BATCH * SEQ, NH = 8, HD = 64, DFF = 4096, DPLE = 256;
constexpr int NIN_SRC = 5128, NQKV = 3072, NGATE = 2048, NIN = NQKV + NGATE;
constexpr float EPS = 1e-6f;
constexpr float LOG2E = 1.4426950408889634f;
constexpr float C2 = 0.125f * LOG2E;

constexpr size_t MiB = 1u << 20;
constexpr size_t WS_WIN = 2 * MiB, WS_WBF = 12 * MiB, WS_WBS = 13 * MiB, WS_WOUT = 14 * MiB, WS_WUP = 16 * MiB, WS_WDN = 24 * MiB, WS_WPG = 32 * MiB, WS_WPLE = 34 * MiB;
constexpr size_t WS_LOGF = 36 * MiB, WS_CC = 37 * MiB, WS_SSQ1 = 38 * MiB, WS_SSQ2 = 40 * MiB;
constexpr size_t WS_PB = 42 * MiB, WS_BUFA = 58 * MiB, WS_BUFB = 122 * MiB, WS_QKV = 186 * MiB, WS_SG = 378 * MiB, WS_H = 186 * MiB, WS_E = 442 * MiB, WS_END = 506 * MiB;

__device__ __forceinline__ unsigned cvt_pk_bf16(float lo, float hi) { f32x2 v = {lo, hi}; bf16x2_t b = __builtin_convertvector(v, bf16x2_t); return __builtin_bit_cast(unsigned, b); }
__device__ __forceinline__ float bf_lo(unsigned w) { return __uint_as_float(w << 16); }
__device__ __forceinline__ float bf_hi(unsigned w) { return __uint_as_float(w & 0xffff0000u); }
__device__ __forceinline__ float fast_sigmoid(float v) { return __builtin_amdgcn_rcpf(1.0f + __builtin_amdgcn_exp2f(-v * LOG2E)); }

__device__ __forceinline__ const char* uni_ptr(const char* p) { const unsigned long long v = (unsigned long long)p; const unsigned lo = __builtin_amdgcn_readfirstlane((unsigned)v), hi = __builtin_amdgcn_readfirstlane((unsigned)(v >> 32)); return (const char*)(((unsigned long long)hi << 32) | lo); }
namespace pg8 {
constexpr int BM = 256, BK = 64, HALF = 128, HTB = HALF * BK * 2, STAGE_BYTES = 8 * HTB, NXCD = 8, WGM = 8;
__host__ __device__ __forceinline__ int lds_byte(int r, int c) { const int st = (r >> 4) * 2 + (c >> 5), rr = r & 15, cc = c & 31, ob = rr * 64 + cc * 2; return st * 1024 + (ob ^ (((ob >> 9) & 1) << 5)); }
__host__ __device__ __forceinline__ void stage_rc(int b, int& R, int& C) { const int st = b / 1024, sb = b % 1024, swz = sb ^ (((sb >> 9) & 1) << 5); R = (st >> 1) * 16 + swz / 64; C = (st & 1) * 32 + (swz % 64) / 2; }
__host__ __device__ __forceinline__ int perm32(int rho) { const int n = rho >> 4, i = rho & 15; return 8 * (i >> 2) + 4 * n + (i & 3); }

struct Unit { int pm, pn; const char* A; const char* B; int chain; };
struct Gemm { int lda, ldb, K; };

struct TileOrder {
    int nM, nN, nwg, G, c;
    __device__ void init(int Mrows, int N, int G_, int c_) { nM = Mrows / BM; nN = N / BM; nwg = nM * nN; G = G_; c = c_; }
    __device__ bool tile(int i, int& pm, int& pn) const {
        const long L = (long)i * G + c; if (L >= nwg) return false;
        int wgid = (int)L; { const int q = nwg / NXCD, r = nwg % NXCD, xcd = wgid % NXCD, off = wgid / NXCD; wgid = (xcd < r ? xcd * (q + 1) : r * (q + 1) + (xcd - r) * q) + off; }
        const int nig = WGM * nN, gid = wgid / nig, fm = gid * WGM, gsz = (nM - fm) < WGM ? (nM - fm) : WGM;
        pm = fm + ((wgid % nig) % gsz); pn = (wgid % nig) / gsz; return true;
    }
};
struct PlainSched {
    TileOrder T; const char* A; const char* B; size_t astep, bstep;
    __device__ bool next(int i, Unit& u) const { int pm, pn; if (!T.tile(i, pm, pn)) return false; u.pm = pm; u.pn = pn; u.A = A + (size_t)pm * astep; u.B = B + (size_t)pn * bstep; u.chain = 0; return true; }
};
struct PairSched {
    TileOrder T; const char* A0; const char* A1; const char* B0; const char* B1; size_t astep, bstep;
    __device__ bool next(int i, Unit& u) const { int pm, pn; if (!T.tile(i >> 1, pm, pn)) return false; const int s = i & 1; u.pm = pm; u.pn = pn;
        u.A = (s ? A1 : A0) + (size_t)pm * astep; u.B = (s ? B1 : B0) + (size_t)pn * bstep; u.chain = s ? 0 : 1; return true; }
};

typedef f32x4 Acc[2][2][4][2];

struct EpiQKVG {
    static constexpr bool PERM = true;
    bf16_t* QKV; bf16_t* SG; const float* bgate;
    __device__ __forceinline__ void operator()(Acc& acc, const Unit& u, int wr, int wc, int fr, int fq, LAS float* tab, int tid) const {
        const int row0 = u.pm * BM + wr * 64 + fr;
        if (u.pn < 12) {
            const float sc = (u.pn < 2 || (u.pn >= 6 && u.pn < 8)) ? C2 : 1.0f;
            const int col0 = u.pn * BM + wc * 32 + 8 * fq;
#pragma unroll
            for (int ai = 0; ai < 2; ++ai)
#pragma unroll
                for (int m = 0; m < 4; ++m) { bf16_t* rowp = QKV + (size_t)(row0 + ai * HALF + m * 16) * NQKV + col0;
#pragma unroll
                    for (int bj = 0; bj < 2; ++bj) { const f32x4 v0 = acc[ai][bj][m][0] * sc, v1 = acc[ai][bj][m][1] * sc;
                        u32x4 w; w.x = cvt_pk_bf16(v0[0], v0[1]); w.y = cvt_pk_bf16(v0[2], v0[3]); w.z = cvt_pk_bf16(v1[0], v1[1]); w.w = cvt_pk_bf16(v1[2], v1[3]);
                        *(u32x4*)(rowp + bj * HALF) = w; } }
        } else {
            const int col0 = (u.pn - 12) * BM + wc * 32 + 8 * fq;
            f32x4 bv[2][2];
#pragma unroll
            for (int bj = 0; bj < 2; ++bj)
#pragma unroll
                for (int n = 0; n < 2; ++n) bv[bj][n] = *(const f32x4*)(bgate + col0 + bj * HALF + 4 * n);
#pragma unroll
            for (int ai = 0; ai < 2; ++ai)
#pragma unroll
                for (int m = 0; m < 4; ++m) { bf16_t* rowp = SG + (size_t)(row0 + ai * HALF + m * 16) * NGATE + col0;
#pragma unroll
                    for (int bj = 0; bj < 2; ++bj) { const f32x4 a0 = acc[ai][bj][m][0] + bv[bj][0], a1 = acc[ai][bj][m][1] + bv[bj][1];
                        u32x4 w; w.x = cvt_pk_bf16(fast_sigmoid(a0[0]), fast_sigmoid(a0[1])); w.y = cvt_pk_bf16(fast_sigmoid(a0[2]), fast_sigmoid(a0[3]));
                        w.z = cvt_pk_bf16(fast_sigmoid(a1[0]), fast_sigmoid(a1[1])); w.w = cvt_pk_bf16(fast_sigmoid(a1[2]), fast_sigmoid(a1[3]));
                        *(u32x4*)(rowp + bj * HALF) = w; } }
        }
    }
};
struct EpiBf16 {
    static constexpr bool PERM = true;
    bf16_t* O; int ldc;
    __device__ __forceinline__ void operator()(Acc& acc, const Unit& u, int wr, int wc, int fr, int fq, LAS float* tab, int tid) const {
        const int row0 = u.pm * BM + wr * 64 + fr, col0 = u.pn * BM + wc * 32 + 8 * fq;
#pragma unroll
        for (int ai = 0; ai < 2; ++ai)
#pragma unroll
            for (int m = 0; m < 4; ++m) { bf16_t* rowp = O + (size_t)(row0 + ai * HALF + m * 16) * ldc + col0;
#pragma unroll
                for (int bj = 0; bj < 2; ++bj) { const f32x4 v0 = acc[ai][bj][m][0], v1 = acc[ai][bj][m][1];
                    u32x4 w; w.x = cvt_pk_bf16(v0[0], v0[1]); w.y = cvt_pk_bf16(v0[2], v0[3]); w.z = cvt_pk_bf16(v1[0], v1[1]); w.w = cvt_pk_bf16(v1[2], v1[3]);
                    *(u32x4*)(rowp + bj * HALF) = w; } }
    }
};
__device__ __forceinline__ f32x4 bf4_lo(const u32x4 w) { return (f32x4){bf_lo(w.x), bf_hi(w.x), bf_lo(w.y), bf_hi(w.y)}; }
__device__ __forceinline__ f32x4 bf4_hi(const u32x4 w) { return (f32x4){bf_lo(w.z), bf_hi(w.z), bf_lo(w.w), bf_hi(w.w)}; }
__device__ __forceinline__ u32x4 pack8(const f32x4 v0, const f32x4 v1) { u32x4 w; w.x = cvt_pk_bf16(v0[0], v0[1]); w.y = cvt_pk_bf16(v0[2], v0[3]); w.z = cvt_pk_bf16(v1[0], v1[1]); w.w = cvt_pk_bf16(v1[2], v1[3]); return w; }
struct EpiBranch {
    static constexpr bool PERM = true;
    const bf16_t* SG; bf16_t* MG;
    __device__ __forceinline__ void operator()(Acc& acc, const Unit& u, int wr, int wc, int fr, int fq, LAS float* tab, int tid) const {
        const int row0 = u.pm * BM + wr * 64 + fr, col0 = u.pn * BM + wc * 32 + 8 * fq;
#pragma unroll
        for (int ai = 0; ai < 2; ++ai) {
            u32x4 ga[4][2], gb[4][2];
#pragma unroll
            for (int m = 0; m < 4; ++m)
#pragma unroll
                for (int bj = 0; bj < 2; ++bj) { const bf16_t* p = SG + (size_t)(row0 + ai * HALF + m * 16) * NGATE + col0 + bj * HALF; gb[m][bj] = *(const u32x4*)(p + DM); if (u.chain) ga[m][bj] = *(const u32x4*)p; }
#pragma unroll
            for (int m = 0; m < 4; ++m)
#pragma unroll
                for (int bj = 0; bj < 2; ++bj) { const f32x4 b0 = bf4_lo(gb[m][bj]), b1 = bf4_hi(gb[m][bj]);
                    if (u.chain) { const f32x4 a0 = bf4_lo(ga[m][bj]), a1 = bf4_hi(ga[m][bj]);
#pragma unroll
                        for (int e = 0; e < 4; ++e) { acc[ai][bj][m][0][e] *= a0[e] * __builtin_amdgcn_rcpf(fmaxf(b0[e], 1e-30f)); acc[ai][bj][m][1][e] *= a1[e] * __builtin_amdgcn_rcpf(fmaxf(b1[e], 1e-30f)); }
                    } else *(u32x4*)(MG + (size_t)(row0 + ai * HALF + m * 16) * DM + col0 + bj * HALF) = pack8(acc[ai][bj][m][0] * b0, acc[ai][bj][m][1] * b1); }
            asm volatile("" ::: "memory");
        }
    }
};
__device__ __forceinline__ void ssq_publish(LAS float* tab, float* ssq, const Unit& u, int tid) {
    asm volatile("s_waitcnt lgkmcnt(0)" ::: "memory"); __builtin_amdgcn_s_barrier(); asm volatile("" ::: "memory");
    if (tid < 256) { const f32x4 t = *(const LAS f32x4*)(tab + tid * 4); ssq[(size_t)(u.pm * BM + tid) * 4 + u.pn] = (t[0] + t[1]) + (t[2] + t[3]); }
}
struct EpiRes4 {
    static constexpr bool PERM = true;
    const float* base; bf16_t* xb; float* ssq;
    __device__ __forceinline__ void operator()(Acc& acc, const Unit& u, int wr, int wc, int fr, int fq, LAS float* tab, int tid) const {
        const int row0 = u.pm * BM + wr * 64 + fr, col0 = u.pn * BM + wc * 32 + 8 * fq;
#pragma unroll
        for (int ai = 0; ai < 2; ++ai) {
            f32x4 bs[4][2][2];
#pragma unroll
            for (int m = 0; m < 4; ++m)
#pragma unroll
                for (int bj = 0; bj < 2; ++bj)
#pragma unroll
                    for (int n = 0; n < 2; ++n) bs[m][bj][n] = *(const f32x4*)(base + (size_t)(row0 + ai * HALF + m * 16) * DM + col0 + bj * HALF + 4 * n);
#pragma unroll
            for (int m = 0; m < 4; ++m) { float s = 0.f;
#pragma unroll
                for (int bj = 0; bj < 2; ++bj) { const f32x4 x0 = bs[m][bj][0] + acc[ai][bj][m][0], x1 = bs[m][bj][1] + acc[ai][bj][m][1];
                    s += ((x0[0] * x0[0] + x0[1] * x0[1]) + (x0[2] * x0[2] + x0[3] * x0[3])) + ((x1[0] * x1[0] + x1[1] * x1[1]) + (x1[2] * x1[2] + x1[3] * x1[3]));
                    *(u32x4*)(xb + (size_t)(row0 + ai * HALF + m * 16) * DM + col0 + bj * HALF) = pack8(x0, x1); }
                s += __shfl_xor(s, 16); s += __shfl_xor(s, 32);
                if (fq == 0) tab[(ai * HALF + wr * 64 + m * 16 + fr) * 4 + wc] = s; }
            asm volatile("" ::: "memory");
        }
        ssq_publish(tab, ssq, u, tid);
    }
};
struct EpiRes6 {
    static constexpr bool PERM = true;
    const bf16_t* xin; bf16_t* xb; float* ssq;
    __device__ __forceinline__ void operator()(Acc& acc, const Unit& u, int wr, int wc, int fr, int fq, LAS float* tab, int tid) const {
        const int row0 = u.pm * BM + wr * 64 + fr, col0 = u.pn * BM + wc * 32 + 8 * fq;
        u32x4 xi[2][4][2];
#pragma unroll
        for (int ai = 0; ai < 2; ++ai)
#pragma unroll
            for (int m = 0; m < 4; ++m)
#pragma unroll
                for (int bj = 0; bj < 2; ++bj) xi[ai][m][bj] = *(const u32x4*)(xin + (size_t)(row0 + ai * HALF + m * 16) * DM + col0 + bj * HALF);
#pragma unroll
        for (int ai = 0; ai < 2; ++ai)
#pragma unroll
            for (int m = 0; m < 4; ++m) { float s = 0.f;
#pragma unroll
                for (int bj = 0; bj < 2; ++bj) { const f32x4 x0 = bf4_lo(xi[ai][m][bj]) + acc[ai][bj][m][0], x1 = bf4_hi(xi[ai][m][bj]) + acc[ai][bj][m][1];
                    s += ((x0[0] * x0[0] + x0[1] * x0[1]) + (x0[2] * x0[2] + x0[3] * x0[3])) + ((x1[0] * x1[0] + x1[1] * x1[1]) + (x1[2] * x1[2] + x1[3] * x1[3]));
                    *(u32x4*)(xb + (size_t)(row0 + ai * HALF + m * 16) * DM + col0 + bj * HALF) = pack8(x0, x1); }
                s += __shfl_xor(s, 16); s += __shfl_xor(s, 32);
                if (fq == 0) tab[(ai * HALF + wr * 64 + m * 16 + fr) * 4 + wc] = s; }
        ssq_publish(tab, ssq, u, tid);
    }
};
__device__ __forceinline__ float rstd_of(const f32x4 q) { return __builtin_amdgcn_rsqf(((q[0] + q[1]) + (q[2] + q[3])) * (1.0f / DM) + EPS); }
struct EpiUp {
    static constexpr bool PERM = true;
    bf16_t* H; const float* ssq;
    __device__ __forceinline__ void operator()(Acc& acc, const Unit& u, int wr, int wc, int fr, int fq, LAS float* tab, int tid) const {
        const int row0 = u.pm * BM + wr * 64 + fr, col0 = u.pn * BM + wc * 32 + 8 * fq;
        f32x4 sq[2][4];
#pragma unroll
        for (int ai = 0; ai < 2; ++ai)
#pragma unroll
            for (int m = 0; m < 4; ++m) sq[ai][m] = *(const f32x4*)(ssq + (size_t)(row0 + ai * HALF + m * 16) * 4);
#pragma unroll
        for (int ai = 0; ai < 2; ++ai)
#pragma unroll
            for (int m = 0; m < 4; ++m) { const float r = rstd_of(sq[ai][m]); bf16_t* rowp = H + (size_t)(row0 + ai * HALF + m * 16) * DFF + col0;
#pragma unroll
                for (int bj = 0; bj < 2; ++bj) { f32x4 v0 = acc[ai][bj][m][0] * r, v1 = acc[ai][bj][m][1] * r;
#pragma unroll
                    for (int e = 0; e < 4; ++e) { const float a = fmaxf(v0[e], 0.f), b = fmaxf(v1[e], 0.f); v0[e] = a * a; v1[e] = b * b; }
                    *(u32x4*)(rowp + bj * HALF) = pack8(v0, v1); } }
    }
};
struct EpiPle {
    static constexpr bool PERM = true;
    const bf16_t* xin; bf16_t* xb; const bf16_t* E; const float* ssq;
    __device__ __forceinline__ void operator()(Acc& acc, const Unit& u, int wr, int wc, int fr, int fq, LAS float* tab, int tid) const {
        const int row0 = u.pm * BM + wr * 64 + fr, col0 = u.pn * BM + wc * 32 + 8 * fq;
#pragma unroll
        for (int ai = 0; ai < 2; ++ai)
#pragma unroll
            for (int mh = 0; mh < 2; ++mh) {
                u32x4 xi[2][2], ei[2][2]; f32x4 sq[2];
#pragma unroll
                for (int mm = 0; mm < 2; ++mm) { const int row = row0 + ai * HALF + (2 * mh + mm) * 16; sq[mm] = *(const f32x4*)(ssq + (size_t)row * 4);
#pragma unroll
                    for (int bj = 0; bj < 2; ++bj) { const size_t off = (size_t)row * DM + col0 + bj * HALF; xi[mm][bj] = *(const u32x4*)(xin + off); ei[mm][bj] = *(const u32x4*)(E + off); } }
#pragma unroll
                for (int mm = 0; mm < 2; ++mm) { const int m = 2 * mh + mm; const float r = rstd_of(sq[mm]);
#pragma unroll
                    for (int bj = 0; bj < 2; ++bj) { const f32x4 a0 = acc[ai][bj][m][0] * r, a1 = acc[ai][bj][m][1] * r, e0 = bf4_lo(ei[mm][bj]), e1 = bf4_hi(ei[mm][bj]); f32x4 o0 = bf4_lo(xi[mm][bj]), o1 = bf4_hi(xi[mm][bj]);
#pragma unroll
                        for (int e = 0; e < 4; ++e) { o0[e] += fast_sigmoid(a0[e]) * e0[e]; o1[e] += fast_sigmoid(a1[e]) * e1[e]; }
                        *(u32x4*)(xb + (size_t)(row0 + ai * HALF + m * 16) * DM + col0 + bj * HALF) = pack8(o0, o1); } }
                asm volatile("" ::: "memory");
            }
    }
};

template <class Epi, class Sched>
__device__ __forceinline__ void gemm_phase(LAS unsigned char* lds, const Gemm g, const Sched& S, const Epi& E) {
    const int tid = threadIdx.x, wid = __builtin_amdgcn_readfirstlane(tid >> 6), lane = tid & 63, wr = wid >> 2, wc = wid & 3, fr = lane & 15, fq = lane >> 4;
    const int K = g.K, nt = K / BK;
    unsigned voffA[2], voffB[2];
#pragma unroll
    for (int i = 0; i < 2; ++i) { int R, C; stage_rc(tid * 16 + i * 8192, R, C); const int Rb = Epi::PERM ? ((R & ~31) + perm32(R & 31)) : R;
        voffA[i] = (unsigned)(R * g.lda + C) * 2u; voffB[i] = (unsigned)(Rb * g.ldb + C) * 2u; }
    const size_t kstep = (size_t)(BK * 2);
    const size_t hA = (size_t)HALF * g.lda * 2, hB = (size_t)HALF * g.ldb * 2;
    const unsigned ldsw = (unsigned)wid * 1024u;
    const int aoff = lds_byte(wr * 64 + fr, fq * 8), boff = lds_byte(wc * 32 + fr, fq * 8);
#define PG8_SA(b, h) (((b) * 2 + (h)) * HTB)
#define PG8_SB(b, h) ((4 + (b) * 2 + (h)) * HTB)
#define PG8_STAGE(bufoff, gbase, voff) do { _Pragma("unroll") for (int _i = 0; _i < 2; ++_i) \
        __builtin_amdgcn_global_load_lds((const unsigned*)((const char*)(gbase) + (voff)[_i]), (LAS unsigned*)(lds + (bufoff) + ldsw + _i * 8192), 16, 0, 0); } while (0)
#define PG8_LDA(dst, b, h) do { _Pragma("unroll") for (int m = 0; m < 4; ++m) _Pragma("unroll") for (int k = 0; k < 2; ++k) dst[m][k] = *(const LAS bf16x8*)(lds + PG8_SA(b, h) + aoff + m * 2048 + k * 1024); } while (0)
#define PG8_LDB(dst, b, h) do { _Pragma("unroll") for (int n = 0; n < 2; ++n) _Pragma("unroll") for (int k = 0; k < 2; ++k) dst[n][k] = *(const LAS bf16x8*)(lds + PG8_SB(b, h) + boff + n * 2048 + k * 1024); } while (0)
#define PG8_MMA(ai, bj, At, Bt) do { __builtin_amdgcn_s_setprio(1); _Pragma("unroll") for (int m = 0; m < 4; ++m) _Pragma("unroll") for (int n = 0; n < 2; ++n) _Pragma("unroll") for (int k = 0; k < 2; ++k) \
        acc[ai][bj][m][n] = __builtin_amdgcn_mfma_f32_16x16x32_bf16(Bt[n][k], At[m][k], acc[ai][bj][m][n], 0, 0, 0); __builtin_amdgcn_s_setprio(0); } while (0)
#define PG8_WAIT_V(n) asm volatile("s_waitcnt vmcnt(" #n ")" ::: "memory")
#define PG8_WAIT_L(n) asm volatile("s_waitcnt lgkmcnt(" #n ")" ::: "memory")
#define PG8_BAR __builtin_amdgcn_s_barrier()
#define PG8_SCHED __builtin_amdgcn_sched_barrier(0)
#define PG8_ZERO() do { _Pragma("unroll") for (int a = 0; a < 2; ++a) _Pragma("unroll") for (int b = 0; b < 2; ++b) _Pragma("unroll") for (int m = 0; m < 4; ++m) _Pragma("unroll") for (int n = 0; n < 2; ++n) acc[a][b][m][n] = (f32x4){0.f, 0.f, 0.f, 0.f}; } while (0)
    Unit cur, nxt; int ui = 0;
    if (!S.next(0, cur)) return;
    Acc acc;
    PG8_ZERO();
    bf16x8 At[4][2], B0[2][2], B1[2][2];
    const char* cA = uni_ptr(cur.A); const char* cB = uni_ptr(cur.B);
    PG8_STAGE(PG8_SB(0, 0), cB, voffB); PG8_STAGE(PG8_SB(0, 1), cB + hB, voffB); PG8_STAGE(PG8_SA(0, 0), cA, voffA); PG8_STAGE(PG8_SA(0, 1), cA + hA, voffA);
    if (wr == 1) PG8_BAR;
    PG8_WAIT_V(2); PG8_BAR;
    PG8_STAGE(PG8_SB(1, 0), cB + kstep, voffB); PG8_STAGE(PG8_SA(1, 0), cA + kstep, voffA); PG8_STAGE(PG8_SB(1, 1), cB + hB + kstep, voffB);
    PG8_WAIT_V(6); PG8_BAR;
    for (;;) {
        const bool has_next = S.next(ui + 1, nxt);
        const char* nA = uni_ptr(has_next ? nxt.A : cA); const char* nB = uni_ptr(has_next ? nxt.B : cB);
#pragma nounroll
        for (int t = 0; t < nt; t += 2) {
            const bool last = (t == nt - 2);
            const char* a1 = cA + (size_t)(t + 1) * kstep;
            const char* a2 = last ? nA : cA + (size_t)(t + 2) * kstep; const char* b2 = last ? nB : cB + (size_t)(t + 2) * kstep;
            const char* a3 = a2 + kstep; const char* b3 = b2 + kstep;
            PG8_LDB(B0, 0, 0); PG8_LDB(B1, 0, 1); PG8_SCHED; PG8_LDA(At, 0, 0); PG8_STAGE(PG8_SA(1, 1), a1 + hA, voffA);
            PG8_WAIT_V(8); PG8_WAIT_L(0); PG8_BAR; PG8_MMA(0, 0, At, B0); PG8_MMA(0, 1, At, B1); PG8_BAR; PG8_SCHED;
            PG8_LDA(At, 0, 1); PG8_STAGE(PG8_SB(0, 0), b2, voffB); PG8_STAGE(PG8_SB(0, 1), b2 + hB, voffB); PG8_STAGE(PG8_SA(0, 0), a2, voffA);
            PG8_WAIT_V(8); PG8_WAIT_L(0); PG8_BAR; PG8_MMA(1, 0, At, B0); PG8_MMA(1, 1, At, B1); PG8_BAR; PG8_SCHED;
            PG8_LDB(B0, 1, 0); PG8_LDB(B1, 1, 1); PG8_SCHED; PG8_LDA(At, 1, 0); PG8_STAGE(PG8_SA(0, 1), a2 + hA, voffA);
            PG8_WAIT_V(8); PG8_WAIT_L(0); PG8_BAR; PG8_MMA(0, 0, At, B0); PG8_MMA(0, 1, At, B1); PG8_BAR; PG8_SCHED;
            PG8_LDA(At, 1, 1); PG8_STAGE(PG8_SB(1, 0), b3, voffB); PG8_STAGE(PG8_SB(1, 1), b3 + hB, voffB); PG8_STAGE(PG8_SA(1, 0), a3, voffA);
            PG8_WAIT_V(8); PG8_WAIT_L(0); PG8_BAR; PG8_MMA(1, 0, At, B0); PG8_MMA(1, 1, At, B1); PG8_BAR; PG8_SCHED;
        }
        if (wr == 0) PG8_BAR;
        E(acc, cur, wr, wc, fr, fq, (LAS float*)(lds + STAGE_BYTES + 64), tid);
        if (!has_next) break;
        if (!cur.chain) PG8_ZERO();
        cur = nxt; cA = nA; cB = nB; ++ui;
        if (wr == 1) PG8_BAR;
    }
    PG8_WAIT_V(0);
    PG8_BAR;
#undef PG8_SA
#undef PG8_SB
#undef PG8_STAGE
#undef PG8_LDA
#undef PG8_LDB
#undef PG8_MMA
#undef PG8_WAIT_V
#undef PG8_WAIT_L
#undef PG8_BAR
#undef PG8_SCHED
#undef PG8_ZERO
}
}

namespace att {
constexpr int PITCH = NQKV, OPITCH = DM;
constexpr int SLOT = 16384, L_K = 0, L_V = 8192;
constexpr int FX_NSLOT = 4, SB_NSLOT = 7;
constexpr int L_CB = FX_NSLOT * SLOT;
constexpr int L_OST = SB_NSLOT * SLOT;
constexpr int L_FLAG = 147456 + 64, L_WS = 147456 + 192;
static_assert(L_CB + 2 * SEQ * 4 <= L_OST && SB_NSLOT * SLOT <= L_OST && L_OST + 8 * 4096 <= 147456, "attention LDS map");
constexpr float SB_THR = -160.0f;
__device__ __forceinline__ int crow(int r, int hi) { return (r & 3) + 8 * (r >> 2) + 4 * hi; }
__device__ __forceinline__ void swap_halves(float v, float& lo, float& hi_) { auto rr = __builtin_amdgcn_permlane32_swap(__float_as_uint(v), __float_as_uint(v), false, false); lo = __uint_as_float(rr[0]); hi_ = __uint_as_float(rr[1]); }

struct AU { int b, h, qb, kind; };
struct Geo {
    const bf16_t* ksrc; const bf16_t* vsrc; const bf16_t* Qw; int wdst, nT, T_last, qw, qabs;
    __device__ __forceinline__ void init(const AU& u, const bf16_t* QKV, int lane, int wid) {
        const size_t rowbase = (size_t)u.b * SEQ; const int colq = u.kind * 1536 + u.h * HD; const int q0 = u.qb * 256;
        qw = q0 + wid * 32; qabs = qw + (lane & 31);
        ksrc = QKV + rowbase * PITCH + colq + 512 + (size_t)lane * PITCH + wid * 8;
        vsrc = QKV + rowbase * PITCH + colq + 1024 + (size_t)(16 * (wid & 3) + (lane >> 2)) * PITCH + (wid >> 2) * 32 + (lane & 3) * 8;
        Qw = QKV + (rowbase + qw) * PITCH + colq + (size_t)(lane & 31) * PITCH + (lane >> 5) * 8;
        wdst = wid * 1024; nT = u.qb * 4 + 4; T_last = nT - 1;
    }
};
#define ATT_DMA(G, tile, slotidx) do { const int t_ = (tile); LAS unsigned char* sl_ = lds + (slotidx) * SLOT + (G).wdst; \
        __builtin_amdgcn_global_load_lds((const unsigned*)((G).ksrc + (size_t)t_ * 64 * PITCH), (LAS unsigned*)(sl_ + L_K), 16, 0, 0); \
        __builtin_amdgcn_global_load_lds((const unsigned*)((G).vsrc + (size_t)t_ * 64 * PITCH), (LAS unsigned*)(sl_ + L_V), 16, 0, 0); } while (0)
#define ATT_VREAD(slot) do { const unsigned vb = (unsigned)(uintptr_t)((slot) + L_V + ((lane >> 4) & 1) * 32 + (lane & 3) * 8 + (4 * hi + ((lane & 15) >> 2)) * 64); \
        _Pragma("unroll") for (int i = 0; i < 8; ++i) { \
            asm volatile("ds_read_b64_tr_b16 %0, %1 offset:%c2" : "=&v"(vlo[i]) : "v"(vb), "i"((i >> 2) * 4096 + (i & 3) * 1024) : "memory"); \
            asm volatile("ds_read_b64_tr_b16 %0, %1 offset:%c2" : "=&v"(vhi[i]) : "v"(vb), "i"((i >> 2) * 4096 + (i & 3) * 1024 + 512) : "memory"); } } while (0)
#define ATT_PV() do { u32x4 pw[4]; \
        pw[0] = (u32x4){cvt_pk_bf16(p0[0], p0[1]), cvt_pk_bf16(p0[2], p0[3]), cvt_pk_bf16(p0[4], p0[5]), cvt_pk_bf16(p0[6], p0[7])}; \
        pw[1] = (u32x4){cvt_pk_bf16(p0[8], p0[9]), cvt_pk_bf16(p0[10], p0[11]), cvt_pk_bf16(p0[12], p0[13]), cvt_pk_bf16(p0[14], p0[15])}; \
        pw[2] = (u32x4){cvt_pk_bf16(p1[0], p1[1]), cvt_pk_bf16(p1[2], p1[3]), cvt_pk_bf16(p1[4], p1[5]), cvt_pk_bf16(p1[6], p1[7])}; \
        pw[3] = (u32x4){cvt_pk_bf16(p1[8], p1[9]), cvt_pk_bf16(p1[10], p1[11]), cvt_pk_bf16(p1[12], p1[13]), cvt_pk_bf16(p1[14], p1[15])}; \
        asm volatile("s_waitcnt lgkmcnt(0)" ::: "memory"); __builtin_amdgcn_sched_barrier(0); \
        _Pragma("unroll") for (int ks = 0; ks < 4; ++ks) _Pragma("unroll") for (int d0 = 0; d0 < 2; ++d0) { const int i = d0 * 4 + ks; \
            const bf16x8 vf = {vlo[i][0], vlo[i][1], vlo[i][2], vlo[i][3], vhi[i][0], vhi[i][1], vhi[i][2], vhi[i][3]}; \
            o[d0] = __builtin_amdgcn_mfma_f32_32x32x16_bf16(__builtin_bit_cast(bf16x8, pw[ks]), vf, o[d0], 0, 0, 0); } } while (0)

__device__ __forceinline__ void unit_prologue(const AU& u, const bf16_t* QKV, const float* cc, LAS unsigned char* lds, bf16x8 (&qr)[4], f32x4& c4, float& cref) {
    const int tid = threadIdx.x, lane = tid & 63; const int wid = __builtin_amdgcn_readfirstlane(tid >> 6);
    Geo g; g.init(u, QKV, lane, wid);
    if (u.kind == 0) { ATT_DMA(g, g.T_last, 0); ATT_DMA(g, g.T_last - 1, 1); ATT_DMA(g, g.T_last - 2, 2); }
    else { ATT_DMA(g, g.T_last, 0); ATT_DMA(g, g.T_last - 1, 1); ATT_DMA(g, g.T_last - 2, 2); ATT_DMA(g, g.T_last - 3, 3); if (g.nT > 4) { ATT_DMA(g, g.T_last - 4, 4); ATT_DMA(g, g.T_last - 5, 5); } }
#pragma unroll
    for (int d0 = 0; d0 < 4; ++d0) qr[d0] = *(const bf16x8*)(g.Qw + d0 * 16);
    if (u.kind == 0) { const float* ccb = cc + (size_t)(u.b * NH + u.h) * SEQ; cref = ccb[u.qb * 256 + 255]; c4 = *((const f32x4*)ccb + tid); }
}
__device__ __forceinline__ void unit_prologue_finish(const AU& u, LAS unsigned char* lds, bf16x8 (&qr)[4], const f32x4 c4, const float cref, int cbuf) {
    if (u.kind == 0) *((LAS f32x4*)(lds + L_CB + cbuf * SEQ * 4) + threadIdx.x) = cref - c4;
#pragma unroll
    for (int d0 = 0; d0 < 4; ++d0) { const u32x4 w = __builtin_bit_cast(u32x4, qr[d0]); u32x4 y;
        asm volatile("v_mov_b32 %0, %1" : "=&v"(y.x) : "v"(w.x)); asm volatile("v_mov_b32 %0, %1" : "=&v"(y.y) : "v"(w.y)); asm volatile("v_mov_b32 %0, %1" : "=&v"(y.z) : "v"(w.z)); asm volatile("v_mov_b32 %0, %1" : "=&v"(y.w) : "v"(w.w));
        qr[d0] = __builtin_bit_cast(bf16x8, y); }
}

__device__ __forceinline__ void fox_loop(const AU& u, const bf16_t* QKV, LAS unsigned char* lds, const bf16x8 (&qr)[4], int cbuf, f32x16 (&o)[2], float& inv) {
    const int tid = threadIdx.x, lane = tid & 63, r32 = lane & 31, hi = lane >> 5; const int wid = __builtin_amdgcn_readfirstlane(tid >> 6);
    Geo g; g.init(u, QKV, lane, wid);
    const int nIter = g.nT, T_last = g.T_last, td = g.qw >> 6, qabs = g.qabs;
    LAS float* wsf = (LAS float*)(lds + L_WS) + wid * 64;
    const LAS float* cbl = (const LAS float*)(lds + L_CB + cbuf * SEQ * 4);
    o[0] = (f32x16){}; o[1] = (f32x16){};
    float mrun = -INFINITY, lrun = 0.f;
    for (int it = 0; it < nIter; ++it) {
        const int t = T_last - it; const int ahead = nIter - 1 - it;
        if (ahead >= 2) asm volatile("s_waitcnt vmcnt(4) lgkmcnt(0)" ::: "memory"); else if (ahead == 1) asm volatile("s_waitcnt vmcnt(2) lgkmcnt(0)" ::: "memory"); else asm volatile("s_waitcnt vmcnt(0) lgkmcnt(0)" ::: "memory");
        __builtin_amdgcn_s_barrier(); asm volatile("" ::: "memory");
        if (it + 3 < nIter) ATT_DMA(g, T_last - (it + 3), (it + 3) & (FX_NSLOT - 1));
        if (t <= td) {
            const LAS unsigned char* slot = lds + (it & (FX_NSLOT - 1)) * SLOT;
            f32x16 p0, p1; f32x4 cq[8]; bf16x8 kf[8];
            { const unsigned ca = (unsigned)(uintptr_t)(cbl + t * 64 + 4 * hi), ka = (unsigned)(uintptr_t)(slot + L_K + hi * 1024 + r32 * 16);
#pragma unroll
              for (int gq = 0; gq < 4; ++gq) { asm volatile("ds_read_b128 %0, %1 offset:%c2" : "=&v"(cq[gq]) : "v"(ca), "i"(32 * gq) : "memory"); asm volatile("ds_read_b128 %0, %1 offset:%c2" : "=&v"(cq[4 + gq]) : "v"(ca), "i"(128 + 32 * gq) : "memory"); }
#pragma unroll
              for (int d0 = 0; d0 < 4; ++d0) { asm volatile("ds_read_b128 %0, %1 offset:%c2" : "=&v"(kf[2 * d0]) : "v"(ka), "i"(d0 * 2048) : "memory"); asm volatile("ds_read_b128 %0, %1 offset:%c2" : "=&v"(kf[2 * d0 + 1]) : "v"(ka), "i"(d0 * 2048 + 512) : "memory"); } }
            s16x4 vlo[8], vhi[8];
            ATT_VREAD(slot);
            asm volatile("s_waitcnt lgkmcnt(15)" ::: "memory"); __builtin_amdgcn_sched_barrier(0);
#pragma unroll
            for (int gq = 0; gq < 4; ++gq)
#pragma unroll
                for (int i = 0; i < 4; ++i) { p0[4 * gq + i] = cq[gq][i]; p1[4 * gq + i] = cq[4 + gq][i]; }
#pragma unroll
            for (int d0 = 0; d0 < 4; ++d0) { p0 = __builtin_amdgcn_mfma_f32_32x32x16_bf16(kf[2 * d0], qr[d0], p0, 0, 0, 0); p1 = __builtin_amdgcn_mfma_f32_32x32x16_bf16(kf[2 * d0 + 1], qr[d0], p1, 0, 0, 0); }
            if (t == td) { asm volatile("" ::: "memory"); const int kv0 = t * 64 + 4 * hi;
#pragma unroll
                for (int r = 0; r < 16; ++r) { const int kv = kv0 + (r & 3) + 8 * (r >> 2); if (kv > qabs) p0[r] = -INFINITY; if (kv + 32 > qabs) p1[r] = -INFINITY; } }
            float rm = fmaxf(p0[0], p1[0]);
#pragma unroll
            for (int r = 1; r < 16; ++r) rm = fmaxf(rm, fmaxf(p0[r], p1[r]));
            { float a, c; swap_halves(rm, a, c); rm = fmaxf(a, c); }
            if (__any(rm > mrun + 8.0f)) {
                const float mnew = fmaxf(mrun, rm); const float f = __builtin_amdgcn_exp2f(mrun - mnew); mrun = mnew; lrun *= f;
                if (hi == 0) wsf[r32] = f;
                asm volatile("s_waitcnt lgkmcnt(0)" ::: "memory");
#pragma unroll
                for (int r = 0; r < 16; ++r) { const float fr_ = wsf[crow(r, hi)]; o[0][r] *= fr_; o[1][r] *= fr_; }
                asm volatile("s_waitcnt lgkmcnt(0)" ::: "memory");
            }
            float ls = 0.f;
#pragma unroll
            for (int r = 0; r < 16; ++r) { p0[r] = __builtin_amdgcn_exp2f(p0[r] - mrun); p1[r] = __builtin_amdgcn_exp2f(p1[r] - mrun); ls += p0[r] + p1[r]; }
            lrun += ls;
            ATT_PV();
        }
    }
    { float a, c; swap_halves(lrun, a, c); inv = 1.0f / (a + c); }
    asm volatile("s_waitcnt lgkmcnt(0)" ::: "memory");
    __builtin_amdgcn_s_barrier(); asm volatile("" ::: "memory");
}

__device__ __forceinline__ void sb_loop(const AU& u, const bf16_t* QKV, LAS unsigned char* lds, const bf16x8 (&qr)[4], f32x16 (&o)[2]) {
    const int tid = threadIdx.x, lane = tid & 63, r32 = lane & 31, hi = lane >> 5; const int wid = __builtin_amdgcn_readfirstlane(tid >> 6);
    Geo g; g.init(u, QKV, lane, wid);
    const int nT = g.nT, T_last = g.T_last, dw = 3 - (wid >> 1), qabs = g.qabs;
    LAS unsigned* flags = (LAS unsigned*)(lds + L_FLAG);
    o[0] = (f32x16){}; o[1] = (f32x16){};
    float R = 0.f; bool mydone = false;
    for (int s = 0; s < nT; ++s) {
        { const int issued = (s + 5 < nT - 1) ? s + 5 : nT - 1, need = (s + 3 < nT - 1) ? s + 3 : nT - 1; const int cnt = issued - need;
          if (cnt >= 2) asm volatile("s_waitcnt vmcnt(4) lgkmcnt(0)" ::: "memory"); else if (cnt == 1) asm volatile("s_waitcnt vmcnt(2) lgkmcnt(0)" ::: "memory"); else asm volatile("s_waitcnt vmcnt(0) lgkmcnt(0)" ::: "memory"); }
        __builtin_amdgcn_s_barrier(); asm volatile("" ::: "memory");
        if (s > 0) { u32x4 fa, fb; const unsigned fad = (unsigned)(uintptr_t)(flags + ((s - 1) & 1) * 8);
            asm volatile("ds_read_b128 %0, %1" : "=&v"(fa) : "v"(fad) : "memory"); asm volatile("ds_read_b128 %0, %1 offset:16" : "=&v"(fb) : "v"(fad) : "memory");
            asm volatile("s_waitcnt lgkmcnt(0)" ::: "memory"); __builtin_amdgcn_sched_barrier(0);
            if ((fa.x & fa.y & fa.z & fa.w & fb.x & fb.y & fb.z & fb.w) != 0u) break; }
        if (s + 6 < nT) ATT_DMA(g, T_last - (s + 6), (s + 6) % SB_NSLOT);
        const int uu = s + dw;
        if (uu >= nT) mydone = true;
        if (!mydone) {
            const int t = T_last - uu; const LAS unsigned char* slot = lds + (uu % SB_NSLOT) * SLOT;
            f32x16 p0 = (f32x16){}, p1 = (f32x16){}; bf16x8 kf[8];
            { const unsigned ka = (unsigned)(uintptr_t)(slot + L_K + hi * 1024 + r32 * 16);
#pragma unroll
              for (int d0 = 0; d0 < 4; ++d0) { asm volatile("ds_read_b128 %0, %1 offset:%c2" : "=&v"(kf[2 * d0]) : "v"(ka), "i"(d0 * 2048) : "memory"); asm volatile("ds_read_b128 %0, %1 offset:%c2" : "=&v"(kf[2 * d0 + 1]) : "v"(ka), "i"(d0 * 2048 + 512) : "memory"); } }
            asm volatile("s_waitcnt lgkmcnt(0)" ::: "memory"); __builtin_amdgcn_sched_barrier(0);
#pragma unroll
            for (int d0 = 0; d0 < 4; ++d0) { p0 = __builtin_amdgcn_mfma_f32_32x32x16_bf16(kf[2 * d0], qr[d0], p0, 0, 0, 0); p1 = __builtin_amdgcn_mfma_f32_32x32x16_bf16(kf[2 * d0 + 1], qr[d0], p1, 0, 0, 0); }
            const bool diag = (s == 0); const int kv0 = t * 64 + 4 * hi;
            f32x16 l0, l1;
#pragma unroll
            for (int r = 0; r < 16; ++r) {
                { const float z = p0[r]; const float tt = __builtin_amdgcn_logf(1.0f + __builtin_amdgcn_exp2f(-fabsf(z))); l0[r] = -(fmaxf(z, 0.f) + tt); }
                { const float z = p1[r]; const float tt = __builtin_amdgcn_logf(1.0f + __builtin_amdgcn_exp2f(-fabsf(z))); l1[r] = -(fmaxf(z, 0.f) + tt); }
            }
            if (diag) {   asm volatile("" ::: "memory");
#pragma unroll
                for (int r = 0; r < 16; ++r) { const int kv = kv0 + (r & 3) + 8 * (r >> 2); if (!(kv < qabs)) l0[r] = 0.f; if (!(kv + 32 < qabs)) l1[r] = 0.f; }
            }
            float G[8], Gp[8];
#pragma unroll
            for (int gq = 0; gq < 4; ++gq) { G[gq] = (l0[4 * gq] + l0[4 * gq + 1]) + (l0[4 * gq + 2] + l0[4 * gq + 3]); G[4 + gq] = (l1[4 * gq] + l1[4 * gq + 1]) + (l1[4 * gq + 2] + l1[4 * gq + 3]); }
#pragma unroll
            for (int c = 0; c < 8; ++c) { float a, d; swap_halves(G[c], a, d); Gp[c] = hi ? a : d; }
            float cs = R;
#pragma unroll
            for (int c = 7; c >= 0; --c) {
                const float ex = cs + (hi ? 0.f : Gp[c]);
                const int gq = c & 3;
                if (c >= 4) { float s3 = l1[4 * gq + 3] + ex, s2 = l1[4 * gq + 2] + s3, s1 = l1[4 * gq + 1] + s2, s0 = l1[4 * gq] + s1; l1[4 * gq + 3] = s3; l1[4 * gq + 2] = s2; l1[4 * gq + 1] = s1; l1[4 * gq] = s0; }
                else        { float s3 = l0[4 * gq + 3] + ex, s2 = l0[4 * gq + 2] + s3, s1 = l0[4 * gq + 1] + s2, s0 = l0[4 * gq] + s1; l0[4 * gq + 3] = s3; l0[4 * gq + 2] = s2; l0[4 * gq + 1] = s1; l0[4 * gq] = s0; }
                cs += G[c] + Gp[c];
            }
            s16x4 vlo[8], vhi[8];
            ATT_VREAD(slot);
#pragma unroll
            for (int r = 0; r < 16; ++r) { p0[r] = __builtin_amdgcn_exp2f(p0[r] + l0[r]); p1[r] = __builtin_amdgcn_exp2f(p1[r] + l1[r]); }
            if (diag) {   asm volatile("" ::: "memory");
#pragma unroll
                for (int r = 0; r < 16; ++r) { const int kv = kv0 + (r & 3) + 8 * (r >> 2); if (!(kv < qabs)) p0[r] = 0.f; if (!(kv + 32 < qabs)) p1[r] = 0.f; }
            }
            R = cs;
            mydone = __all(R < SB_THR);
            ATT_PV();
        }
        if (lane == 0) flags[(s & 1) * 8 + wid] = mydone ? 1u : 0u;
    }
    asm volatile("s_waitcnt lgkmcnt(0)" ::: "memory");
    __builtin_amdgcn_s_barrier(); asm volatile("" ::: "memory");
}

__device__ __forceinline__ void unit_epilogue(const AU& u, bf16_t* O, LAS unsigned char* lds, const f32x16 (&o)[2], float inv) {
    const int tid = threadIdx.x, lane = tid & 63, r32 = lane & 31, hi = lane >> 5; const int wid = __builtin_amdgcn_readfirstlane(tid >> 6);
    LAS float* wsf = (LAS float*)(lds + L_WS) + wid * 64;
    if (hi == 0) wsf[32 + r32] = inv;
    asm volatile("s_waitcnt lgkmcnt(0)" ::: "memory");
    LAS bf16_t* stg = (LAS bf16_t*)(lds + L_OST) + wid * 2048;
#pragma unroll
    for (int r = 0; r < 16; ++r) { const int orow = crow(r, hi); const float rl = wsf[32 + orow]; const unsigned w = cvt_pk_bf16(o[0][r] * rl, o[1][r] * rl);
        stg[orow * 64 + r32] = (bf16_t)(w & 0xffffu); stg[orow * 64 + 32 + r32] = (bf16_t)(w >> 16); }
    asm volatile("s_waitcnt lgkmcnt(0)" ::: "memory");
    bf16_t* Ow = O + ((size_t)u.b * SEQ + u.qb * 256 + wid * 32) * OPITCH + u.kind * 512 + u.h * HD;
#pragma unroll
    for (int i = 0; i < 4; ++i) { const int row = i * 8 + (lane >> 3), ch = lane & 7; const u32x4 v = *(const LAS u32x4*)(stg + row * 64 + ch * 8); *(u32x4*)(Ow + (size_t)row * OPITCH + ch * 8) = v; }
    asm volatile("s_waitcnt lgkmcnt(0)" ::: "memory");
}
#undef ATT_DMA
#undef ATT_VREAD
#undef ATT_PV
}

#define XB_TMO      128
#define XB_XCNT(j)  (256  + 64 * (j))
#define XB_XSUB(j)  (1280 + 64 * (j))
#define XB_XGEN(j)  (2304 + 64 * (j))
#define XB_TOP      3328
#define XB_TOPGEN   3392
#define XCD_BAR_WORDS 3456
#define XB_SPIN_CAP (1u << 18)
__device__ __forceinline__ unsigned xb_ld(unsigned* p)              { return __hip_atomic_load(p, __ATOMIC_RELAXED, __HIP_MEMORY_SCOPE_AGENT); }
__device__ __forceinline__ unsigned xb_add(unsigned* p, unsigned v) { return __hip_atomic_fetch_add(p, v, __ATOMIC_RELAXED, __HIP_MEMORY_SCOPE_AGENT); }
__device__ __forceinline__ unsigned xb_xcc_id() { return (unsigned)__builtin_amdgcn_s_getreg((3 << 11) | 20) & 0xFu; }
#define XB_SPIN(cond, bar) do { unsigned _sp = 0; while (cond) { __builtin_amdgcn_s_sleep(1); \
    if ((++_sp & 255u) == 0u) { if (xb_ld(&(bar)[XB_TMO])) break; if (_sp > XB_SPIN_CAP) { atomicAdd(&(bar)[XB_TMO], 1u); break; } } } } while (0)
struct XcdBarrier { unsigned* bar; unsigned x; volatile LAS unsigned* st; };
__device__ __forceinline__ XcdBarrier xcd_barrier_post(unsigned* bar, volatile LAS unsigned* st) {
    XcdBarrier b; b.bar = bar; b.x = xb_xcc_id(); b.st = st;
    if (threadIdx.x == 0) (void)xb_add(&bar[XB_XCNT(b.x)], 1u);
    return b;
}
__device__ __forceinline__ void xcd_barrier_complete(unsigned* bar, unsigned x, unsigned& nloc, unsigned& nx) {
    const unsigned G = gridDim.x * gridDim.y * gridDim.z;
    unsigned sum, cnt, mine, sp = 0u;
    for (;;) {
        sum = 0u; cnt = 0u; mine = 0u;
#pragma unroll
        for (unsigned j = 0; j < 16; ++j) { const unsigned c = xb_ld(&bar[XB_XCNT(j)]); sum += c; cnt += (c > 0u) ? 1u : 0u; mine = (j == x) ? c : mine; }
        if (sum == G) break;
        __builtin_amdgcn_s_sleep(1);
        if ((++sp & 255u) == 0u) { if (xb_ld(&bar[XB_TMO])) break; if (sp > XB_SPIN_CAP) { atomicAdd(&bar[XB_TMO], 1u); break; } }
    }
    nloc = mine > 0u ? mine : 1u; nx = cnt > 0u ? cnt : 1u;
}
__device__ __forceinline__ void xcd_barrier(const XcdBarrier& b) {
    asm volatile("s_waitcnt vmcnt(0)" ::: "memory");
    __syncthreads();
    if (threadIdx.x == 0) {
        unsigned* bar = b.bar;
        __builtin_amdgcn_s_waitcnt(0);
        unsigned nloc = b.st[0], nx = b.st[1];
        if (nloc == 0u) { xcd_barrier_complete(bar, b.x, nloc, nx); b.st[0] = nloc; b.st[1] = nx; }
        const unsigned old = xb_add(&bar[XB_XSUB(b.x)], 1u);
        const unsigned gen = old / nloc;
        if (old + 1u == (gen + 1u) * nloc) {
            __builtin_amdgcn_fence(__ATOMIC_RELEASE, "agent");
            asm volatile("s_waitcnt vmcnt(0)" ::: "memory");
            const unsigned og = xb_add(&bar[XB_TOP], 1u);
            const unsigned tg = og / nx;
            if (og + 1u == (tg + 1u) * nx) xb_add(&bar[XB_TOPGEN], 1u);
            else XB_SPIN(xb_ld(&bar[XB_TOPGEN]) == tg, bar);
            __builtin_amdgcn_fence(__ATOMIC_ACQUIRE, "agent");
            xb_add(&bar[XB_XGEN(b.x)], 1u);
            asm volatile("s_waitcnt vmcnt(0)" ::: "memory");
        } else {
            XB_SPIN(xb_ld(&bar[XB_XGEN(b.x)]) == gen, bar);
            __builtin_amdgcn_fence(__ATOMIC_ACQUIRE, "agent");
            asm volatile("s_waitcnt vmcnt(0)" ::: "memory");
        }
    }
    __syncthreads();
}

constexpr int NWAVES = 8;
constexpr int RING_BYTES = 131072, LDS_BYTES = 151552;

__device__ __forceinline__ float wave_sum(float v) {
#pragma unroll
    for (int o = 1; o < 64; o <<= 1) v += __shfl_xor(v, o);
    return v;
}
__device__ __forceinline__ void tr_item(const float* W, int ldw, int col0, int K, bf16_t* WT, int row_off, LAS float* scr, int kb, int nb, int lane, const float* gs) {
    const int k0 = 64 * kb, n0 = 32 * nb;
    float wv[32];
#pragma unroll
    for (int i = 0; i < 32; ++i) { const int kk = 2 * i + (lane >> 5); wv[i] = W[(size_t)(k0 + kk) * ldw + col0 + n0 + (lane & 31)]; }
    if (gs) {
#pragma unroll
        for (int i = 0; i < 32; ++i) wv[i] *= gs[k0 + 2 * i + (lane >> 5)];
    }
#pragma unroll
    for (int i = 0; i < 32; ++i) { const int kk = 2 * i + (lane >> 5); scr[kk * 33 + (lane & 31)] = wv[i]; }
    asm volatile("s_waitcnt lgkmcnt(0)" ::: "memory");
    const int c = lane & 7;
#pragma unroll
    for (int j = 0; j < 4; ++j) { const int n = (lane >> 3) + 8 * j; const LAS float* s = scr + (8 * c) * 33 + n;
        u32x4 o; o.x = cvt_pk_bf16(s[0 * 33], s[1 * 33]); o.y = cvt_pk_bf16(s[2 * 33], s[3 * 33]); o.z = cvt_pk_bf16(s[4 * 33], s[5 * 33]); o.w = cvt_pk_bf16(s[6 * 33], s[7 * 33]);
        *(u32x4*)(WT + (size_t)(row_off + n0 + n) * K + k0 + 8 * c) = o; }
    asm volatile("s_waitcnt lgkmcnt(0)" ::: "memory");
}

struct Args { const float* in[16]; float* out; unsigned char* ws; int ph_lo, ph_hi; };

__global__ void __launch_bounds__(NWAVES * 64, 2) fwd_megakernel(Args args) {
    __builtin_assume(__builtin_amdgcn_workitem_id_y() == 0); __builtin_assume(__builtin_amdgcn_workitem_id_z() == 0);
    extern __shared__ __attribute__((aligned(16))) unsigned char lds_raw[];
    LAS unsigned char* lds = (LAS unsigned char*)lds_raw;
    const int tid = threadIdx.x, lane = tid & 63, wave = __builtin_amdgcn_readfirstlane(tid >> 6);
    const int G = gridDim.x, bx = blockIdx.x, vcu = (G % 8 == 0) ? (bx % 8) * (G / 8) + bx / 8 : bx;
    const int gw = vcu * NWAVES + wave, NGW = G * NWAVES;
    unsigned char* ws = args.ws;
    const float* x = args.in[0]; const float* p_in = args.in[1]; const float* g_mix = args.in[2]; const float* w_in = args.in[3]; const float* b_forget = args.in[4]; const float* b_gate = args.in[5];
    const float* w_bf = args.in[6]; const float* w_bs = args.in[7]; const float* w_out = args.in[8]; const float* g_mlp = args.in[9]; const float* w_up = args.in[10]; const float* w_dn = args.in[11];
    const float* g_ple = args.in[12]; const float* w_pg = args.in[13]; const float* w_ple = args.in[14]; const float* g_final = args.in[15];
    float* out = args.out;
    bf16_t* Win_t = (bf16_t*)(ws + WS_WIN); bf16_t* Wbf_t = (bf16_t*)(ws + WS_WBF); bf16_t* Wbs_t = (bf16_t*)(ws + WS_WBS); bf16_t* Wout_t = (bf16_t*)(ws + WS_WOUT);
    bf16_t* Wup_t = (bf16_t*)(ws + WS_WUP); bf16_t* Wdn_t = (bf16_t*)(ws + WS_WDN); bf16_t* Wpg_t = (bf16_t*)(ws + WS_WPG); bf16_t* Wple_t = (bf16_t*)(ws + WS_WPLE);
    float* LOGF = (float*)(ws + WS_LOGF); float* CC = (float*)(ws + WS_CC); float* SSQ1 = (float*)(ws + WS_SSQ1); float* SSQ2 = (float*)(ws + WS_SSQ2);
    bf16_t* PB = (bf16_t*)(ws + WS_PB); bf16_t* BUFA = (bf16_t*)(ws + WS_BUFA); bf16_t* BUFB = (bf16_t*)(ws + WS_BUFB); bf16_t* QKV = (bf16_t*)(ws + WS_QKV); bf16_t* SG = (bf16_t*)(ws + WS_SG);
    bf16_t* HB = (bf16_t*)(ws + WS_H); bf16_t* EB = (bf16_t*)(ws + WS_E);
    const int lo = args.ph_lo, hi = args.ph_hi;
#define IN(k) (lo <= (k) && (k) < hi)
    volatile LAS unsigned* bst = (volatile LAS unsigned*)(lds + LDS_BYTES - 64);
    if (tid < 2) bst[tid] = 0u;
    __syncthreads();
    XcdBarrier xbar; xbar.bar = (unsigned*)ws; xbar.x = 0; xbar.st = bst;
    if (hi - lo > 1) xbar = xcd_barrier_post((unsigned*)ws, bst);
#define SEAM(k) do { if (IN(k) && IN((k) + 1)) { if (hi > N_PHASES) cg::this_grid().sync(); else xcd_barrier(xbar); } } while (0)

    if (IN(0)) {
        LAS float* scr = (LAS float*)(lds + wave * 8448);
        LAS f32x4* wtab = (LAS f32x4*)(lds + 69632);
        {
            constexpr int NSEG = 9;
            int base = 0;
            for (int it = gw; ; it += NGW) {
                int r = it; const float* W; int ldw, col0, K, nblk, row_off; bf16_t* WT; const float* gs = nullptr;
                if (r < 16 * 48) { W = w_in; ldw = NIN_SRC; col0 = 0; K = DM; nblk = 48; WT = Win_t; row_off = 0; }
                else if ((r -= 16 * 48) < 16 * 112) { W = w_in; ldw = NIN_SRC; col0 = 1544; K = DM; nblk = 112; WT = Win_t; row_off = 1536; }
                else if ((r -= 16 * 112) < 8 * 32) { W = w_bf; ldw = DM; col0 = 0; K = 512; nblk = 32; WT = Wbf_t; row_off = 0; }
                else if ((r -= 8 * 32) < 8 * 32) { W = w_bs; ldw = DM; col0 = 0; K = 512; nblk = 32; WT = Wbs_t; row_off = 0; }
                else if ((r -= 8 * 32) < 16 * 32) { W = w_out; ldw = DM; col0 = 0; K = DM; nblk = 32; WT = Wout_t; row_off = 0; }
                else if ((r -= 16 * 32) < 16 * 128) { W = w_up; ldw = DFF; col0 = 0; K = DM; nblk = 128; WT = Wup_t; row_off = 0; gs = g_mlp; }
                else if ((r -= 16 * 128) < 64 * 32) { W = w_dn; ldw = DM; col0 = 0; K = DFF; nblk = 32; WT = Wdn_t; row_off = 0; }
                else if ((r -= 64 * 32) < 16 * 32) { W = w_pg; ldw = DM; col0 = 0; K = DM; nblk = 32; WT = Wpg_t; row_off = 0; gs = g_ple; }
                else if ((r -= 16 * 32) < 4 * 32) { W = w_ple; ldw = DM; col0 = 0; K = DPLE; nblk = 32; WT = Wple_t; row_off = 0; }
                else break;
                tr_item(W, ldw, col0, K, WT, row_off, scr, r / nblk, r % nblk, lane, gs);
                (void)base; (void)NSEG;
            }
        }
        {
            f32x4 gm[4];
#pragma unroll
            for (int j = 0; j < 4; ++j) gm[j] = *((const f32x4*)g_mix + lane + 64 * j);
#pragma unroll
            for (int q = 0; q < 2; ++q) { const int k = tid + 512 * q; const float gk = g_mix[k]; const float* wp = w_in + (size_t)k * NIN_SRC + 1536;
                const int ln = (k & 255) >> 2, e = k & 3, j = k >> 8;
                wtab[((j * 4 + e) * 2 + 0) * 64 + ln] = *(const f32x4*)wp * gk; wtab[((j * 4 + e) * 2 + 1) * 64 + ln] = *(const f32x4*)(wp + 4) * gk; }
            __syncthreads();
            const float bfv = b_forget[lane & 7];
            for (int m0 = gw; m0 < M; m0 += 2 * NGW) {
                f32x4 va[2][4];
#pragma unroll
                for (int q = 0; q < 2; ++q)
#pragma unroll
                    for (int j = 0; j < 4; ++j) va[q][j] = *((const f32x4*)(x + (size_t)(m0 + q * NGW) * DM) + lane + 64 * j);
#pragma unroll
                for (int q = 0; q < 2; ++q) {
                    const int m = m0 + q * NGW;
                    f32x4 v[4]; float s = 0.f;
#pragma unroll
                    for (int j = 0; j < 4; ++j) { v[j] = va[q][j]; s += (v[j][0] * v[j][0] + v[j][1] * v[j][1]) + (v[j][2] * v[j][2] + v[j][3] * v[j][3]); }
                    const float rstd = __builtin_amdgcn_rsqf(wave_sum(s) * (1.0f / DM) + EPS);
                    f32x4 f0 = {0.f, 0.f, 0.f, 0.f}, f1 = {0.f, 0.f, 0.f, 0.f};
#pragma unroll
                    for (int j = 0; j < 4; ++j)
#pragma unroll
                        for (int e = 0; e < 4; ++e) { f0 += wtab[((j * 4 + e) * 2 + 0) * 64 + lane] * v[j][e]; f1 += wtab[((j * 4 + e) * 2 + 1) * 64 + lane] * v[j][e]; }
                    unsigned long long* o8 = (unsigned long long*)(BUFA + (size_t)m * DM) + lane;
#pragma unroll
                    for (int j = 0; j < 4; ++j) { const f32x4 y = v[j] * gm[j] * rstd; o8[64 * j] = (unsigned long long)cvt_pk_bf16(y[0], y[1]) | ((unsigned long long)cvt_pk_bf16(y[2], y[3]) << 32); }
                    float fl[8];
#pragma unroll
                    for (int e = 0; e < 4; ++e) { fl[e] = wave_sum(f0[e]); fl[4 + e] = wave_sum(f1[e]); }
                    float mine = fl[0];
#pragma unroll
                    for (int e = 1; e < 8; ++e) mine = ((lane & 7) == e) ? fl[e] : mine;
                    const float y2 = (mine * rstd + bfv) * LOG2E;
                    const float lf = -(fmaxf(-y2, 0.f) + __builtin_amdgcn_logf(1.0f + __builtin_amdgcn_exp2f(-fabsf(y2))));
                    if (lane < 8) LOGF[(size_t)((m / SEQ) * NH + lane) * SEQ + (m % SEQ)] = lf;
                }
            }
        }
        {
            const size_t n8 = (size_t)M * DPLE / 8;
            for (size_t i = (size_t)bx * 512 + tid; i < n8; i += (size_t)G * 512) { const f32x4 a = *((const f32x4*)p_in + 2 * i), c = *((const f32x4*)p_in + 2 * i + 1);
                u32x4 w; w.x = cvt_pk_bf16(a[0], a[1]); w.y = cvt_pk_bf16(a[2], a[3]); w.z = cvt_pk_bf16(c[0], c[1]); w.w = cvt_pk_bf16(c[2], c[3]); *((u32x4*)PB + i) = w; }
        }
    }
    SEAM(0);

    if (IN(1)) {
        if (gw < BATCH * NH) {
            const float* src = LOGF + (size_t)gw * SEQ + lane * 32; float* dst = CC + (size_t)gw * SEQ + lane * 32;
            f32x4 v[8]; float run = 0.f;
#pragma unroll
            for (int j = 0; j < 8; ++j) { v[j] = *((const f32x4*)src + j);
#pragma unroll
                for (int e = 0; e < 4; ++e) { run += v[j][e]; v[j][e] = run; } }
            float incl = run;
#pragma unroll
            for (int o = 1; o < 64; o <<= 1) { const float tv = __shfl_up(incl, o); if (lane >= o) incl += tv; }
            const float excl = incl - run;
#pragma unroll
            for (int j = 0; j < 8; ++j) *((f32x4*)dst + j) = v[j] + excl;
        }
        pg8::Gemm g{DM, DM, DM};
        pg8::PlainSched S; S.T.init(M, NIN, G, bx); S.A = (const char*)BUFA; S.B = (const char*)Win_t; S.astep = (size_t)256 * DM * 2; S.bstep = (size_t)256 * DM * 2;
        pg8::EpiQKVG E{QKV, SG, b_gate};
        pg8::gemm_phase<pg8::EpiQKVG, pg8::PlainSched>(lds, g, S, E);
    }
    SEAM(1);

    if (IN(2)) {
        const int bh = vcu >> 1;
#define ATT_UNIT(i) att::AU{bh / NH, bh % NH, (((i) & 1) ? 7 - ((vcu & 1) * 2 + (((i) & 3) >> 1)) : ((vcu & 1) * 2 + (((i) & 3) >> 1))), (i) >> 2}
        if (bh < BATCH * NH) {
            bf16x8 qr[4]; f32x16 o[2]; float inv = 1.0f; f32x4 c4 = {0.f, 0.f, 0.f, 0.f}; float cref = 0.f;
            att::AU cur = ATT_UNIT(0);
            att::unit_prologue(cur, QKV, CC, lds, qr, c4, cref);
            att::unit_prologue_finish(cur, lds, qr, c4, cref, 0);
            for (int i = 0; i < 8; ++i) {
                if (cur.kind == 0) att::fox_loop(cur, QKV, lds, qr, i & 1, o, inv); else { att::sb_loop(cur, QKV, lds, qr, o); inv = 1.0f; }
                const att::AU nxt = ATT_UNIT(i + 1);
                if (i < 7) att::unit_prologue(nxt, QKV, CC, lds, qr, c4, cref);
                att::unit_epilogue(cur, BUFB, lds, o, inv);
                if (i < 7) att::unit_prologue_finish(nxt, lds, qr, c4, cref, (i + 1) & 1);
                cur = nxt;
            }
        }
#undef ATT_UNIT
    }
    SEAM(2);

    if (IN(3)) {
        pg8::Gemm g{DM, 512, 512};
        pg8::PairSched S; S.T.init(M, DM, G, bx); S.A0 = (const char*)BUFB; S.A1 = (const char*)(BUFB + 512); S.B0 = (const char*)Wbf_t; S.B1 = (const char*)Wbs_t; S.astep = (size_t)256 * DM * 2; S.bstep = (size_t)256 * 512 * 2;
        pg8::EpiBranch E{SG, BUFA};
        pg8::gemm_phase<pg8::EpiBranch, pg8::PairSched>(lds, g, S, E);
    }
    SEAM(3);

    if (IN(4)) {
        {
            pg8::Gemm g{DM, DM, DM};
            pg8::PlainSched S; S.T.init(M, DM, G, bx); S.A = (const char*)BUFA; S.B = (const char*)Wout_t; S.astep = (size_t)256 * DM * 2; S.bstep = (size_t)256 * DM * 2;
            pg8::EpiRes4 E{x, BUFB, SSQ1};
            pg8::gemm_phase<pg8::EpiRes4, pg8::PlainSched>(lds, g, S, E);
        }
        {
            pg8::Gemm g{DPLE, DPLE, DPLE};
            pg8::PlainSched S; S.T.init(M, DM, G, bx); S.A = (const char*)PB; S.B = (const char*)Wple_t; S.astep = (size_t)256 * DPLE * 2; S.bstep = (size_t)256 * DPLE * 2;
            pg8::EpiBf16 E{EB, DM};
            pg8::gemm_phase<pg8::EpiBf16, pg8::PlainSched>(lds, g, S, E);
        }
    }
    SEAM(4);

    if (IN(5)) {
        pg8::Gemm g{DM, DM, DM};
        pg8::PlainSched S; S.T.init(M, DFF, G, bx); S.A = (const char*)BUFB; S.B = (const char*)Wup_t; S.astep = (size_t)256 * DM * 2; S.bstep = (size_t)256 * DM * 2;
        pg8::EpiUp E{HB, SSQ1};
        pg8::gemm_phase<pg8::EpiUp, pg8::PlainSched>(lds, g, S, E);
    }
    SEAM(5);

    if (IN(6)) {
        pg8::Gemm g{DFF, DFF, DFF};
        pg8::PlainSched S; S.T.init(M, DM, G, bx); S.A = (const char*)HB; S.B = (const char*)Wdn_t; S.astep = (size_t)256 * DFF * 2; S.bstep = (size_t)256 * DFF * 2;
        pg8::EpiRes6 E{BUFB, BUFA, SSQ2};
        pg8::gemm_phase<pg8::EpiRes6, pg8::PlainSched>(lds, g, S, E);
    }
    SEAM(6);

    if (IN(7)) {
        pg8::Gemm g{DM, DM, DM};
        pg8::PlainSched S; S.T.init(M, DM, G, bx); S.A = (const char*)BUFA; S.B = (const char*)Wpg_t; S.astep = (size_t)256 * DM * 2; S.bstep = (size_t)256 * DM * 2;
        pg8::EpiPle E{BUFA, BUFB, EB, SSQ2};
        pg8::gemm_phase<pg8::EpiPle, pg8::PlainSched>(lds, g, S, E);
    }
    SEAM(7);

    if (IN(8)) {
        f32x4 gf[4];
#pragma unroll
        for (int j = 0; j < 2; ++j) { gf[2 * j] = *((const f32x4*)g_final + 2 * lane + 128 * j); gf[2 * j + 1] = *((const f32x4*)g_final + 2 * lane + 128 * j + 1); }
        for (int m = gw; m < M; m += 2 * NGW) {
            u32x4 w[2][2];
#pragma unroll
            for (int q = 0; q < 2; ++q)
#pragma unroll
                for (int j = 0; j < 2; ++j) w[q][j] = *((const u32x4*)(BUFB + (size_t)(m + q * NGW) * DM) + lane + 64 * j);
#pragma unroll
            for (int q = 0; q < 2; ++q) {
                f32x4 v[4]; float s = 0.f;
#pragma unroll
                for (int j = 0; j < 2; ++j) { v[2 * j] = pg8::bf4_lo(w[q][j]); v[2 * j + 1] = pg8::bf4_hi(w[q][j]); }
#pragma unroll
                for (int j = 0; j < 4; ++j) s += (v[j][0] * v[j][0] + v[j][1] * v[j][1]) + (v[j][2] * v[j][2] + v[j][3] * v[j][3]);
                const float rstd = __builtin_amdgcn_rsqf(wave_sum(s) * (1.0f / DM) + EPS);
                f32x4* orow = (f32x4*)(out + (size_t)(m + q * NGW) * DM);
#pragma unroll
                for (int j = 0; j < 2; ++j) { orow[2 * lane + 128 * j] = v[2 * j] * gf[2 * j] * rstd; orow[2 * lane + 128 * j + 1] = v[2 * j + 1] * gf[2 * j + 1] * rstd; }
            }
        }
    }
#undef IN
#undef SEAM
}

extern "C" void kernel_launch(void* const* d_in, const int* in_sizes, int n_in, void* d_out, int out_size, void* d_ws, size_t ws_size, hipStream_t stream) {
    static int grid = 0;
    if (grid == 0) {
        if (n_in != 16 || in_sizes[0] != M * DM || out_size != M * DM || ws_size < WS_END) { fprintf(stderr, "kernel_launch: unexpected shapes (n_in %d, in0 %d, out %d, ws %zu); nothing launched\n", n_in, n_in > 0 ? in_sizes[0] : -1, out_size, ws_size); grid = -1; return; }
        int dev = 0, cus = 0, per_cu = 0;
        if (hipGetDevice(&dev) != hipSuccess || hipDeviceGetAttribute(&cus, hipDeviceAttributeMultiprocessorCount, dev) != hipSuccess) { grid = -1; return; }
        if (hipFuncSetAttribute((const void*)fwd_megakernel, hipFuncAttributeMaxDynamicSharedMemorySize, LDS_BYTES) != hipSuccess) { fprintf(stderr, "kernel_launch: hipFuncSetAttribute failed\n"); grid = -1; return; }
        if (hipOccupancyMaxActiveBlocksPerMultiprocessor(&per_cu, (const void*)fwd_megakernel, NWAVES * 64, LDS_BYTES) != hipSuccess || per_cu < 1) { fprintf(stderr, "kernel_launch: occupancy query says %d\n", per_cu); per_cu = 1; }
        (void)hipGetLastError();
        grid = cus;
        if (grid != 256) fprintf(stderr, "kernel_launch: %d CUs; built for 256\n", grid);
    }
    if (grid < 0) return;
    if (hipMemsetAsync(d_ws, 0, 16384, stream) != hipSuccess) { fprintf(stderr, "kernel_launch: memset failed\n"); return; }
    Args a{};
    for (int i = 0; i < 16; ++i) a.in[i] = (const float*)d_in[i];
    a.out = (float*)d_out; a.ws = (unsigned char*)d_ws;
#if MK_N_LAUNCHES == 1
    a.ph_lo = 0; a.ph_hi = N_PHASES;
    void* kargs[] = {&a};
    hipError_t e = hipLaunchCooperativeKernel((const void*)fwd_megakernel, dim3(grid), dim3(NWAVES * 64), kargs, LDS_BYTES, stream);
    if (e != hipSuccess) fprintf(stderr, "kernel_launch: cooperative launch failed: %s (grid %d)\n", hipGetErrorString(e), grid);
#else
    for (int li = 0; li < N_PHASES; ++li) { a.ph_lo = li; a.ph_hi = li + 1; hipLaunchKernelGGL(fwd_megakernel, dim3(grid), dim3(NWAVES * 64), LDS_BYTES, stream, a); }
#endif
}
```

```cpp
#include <hip/hip_runtime.h>
#include <hip/hip_cooperative_groups.h>
#include <cstdio>
#include <cstdint>
namespace cg = cooperative_groups;

#ifndef MK_N_LAUNCHES
#define MK_N_LAUNCHES 1
#endif
constexpr int N_PHASES = 9;

#define LAS __attribute__((address_space(3)))
typedef unsigned short bf16_t;
typedef short bf16x8 __attribute__((ext_vector_type(8)));
typedef short s16x4 __attribute__((ext_vector_type(4)));
typedef float f32x4 __attribute__((ext_vector_type(4)));
typedef float f32x2 __attribute__((ext_vector_type(2)));
typedef float f32x16 __attribute__((ext_vector_type(16)));
typedef unsigned u32x4 __attribute__((ext_vector_type(4)));
typedef unsigned u32x2 __attribute__((ext_vector_type(2)));
typedef __bf16 bf16x2_t __attribute__((ext_vector_type(2)));

constexpr int BATCH = 16, SEQ = 2048, DM = 1024, M = BATCH * SEQ, NH = 8, HD = 64, DFF = 4096, DPLE = 256;
constexpr int NIN_SRC = 5128, NQKV = 3072, NGATE = 2048, NIN = NQKV + NGATE;
constexpr float EPS = 1e-6f;
constexpr float LOG2E = 1.4426950408889634f;
constexpr float C2 = 0.125f * LOG2E;

constexpr size_t MiB = 1u << 20;
constexpr size_t WS_WIN = 2 * MiB, WS_WBF = 12 * MiB, WS_WBS = 13 * MiB, WS_WOUT = 14 * MiB, WS_WUP = 16 * MiB, WS_WDN = 24 * MiB, WS_WPG = 32 * MiB, WS_WPLE = 34 * MiB;
constexpr size_t WS_LOGF = 36 * MiB, WS_CC = 37 * MiB, WS_SSQ1 = 38 * MiB, WS_SSQ2 = 40 * MiB;
constexpr size_t WS_PB = 42 * MiB, WS_BUFA = 58 * MiB, WS_BUFB = 122 * MiB, WS_QKV = 186 * MiB, WS_SG = 378 * MiB, WS_H = 186 * MiB, WS_E = 442 * MiB, WS_END = 506 * MiB;

__device__ __forceinline__ unsigned cvt_pk_bf16(float lo, float hi) { f32x2 v = {lo, hi}; bf16x2_t b = __builtin_convertvector(v, bf16x2_t); return __builtin_bit_cast(unsigned, b); }
__device__ __forceinline__ float bf_lo(unsigned w) { return __uint_as_float(w << 16); }
__device__ __forceinline__ float bf_hi(unsigned w) { return __uint_as_float(w & 0xffff0000u); }
__device__ __forceinline__ float fast_sigmoid(float v) { return __builtin_amdgcn_rcpf(1.0f + __builtin_amdgcn_exp2f(-v * LOG2E)); }

__device__ __forceinline__ const char* uni_ptr(const char* p) { const unsigned long long v = (unsigned long long)p; const unsigned lo = __builtin_amdgcn_readfirstlane((unsigned)v), hi = __builtin_amdgcn_readfirstlane((unsigned)(v >> 32)); return (const char*)(((unsigned long long)hi << 32) | lo); }
namespace pg8 {
constexpr int BM = 256, BK = 64, HALF = 128, HTB = HALF * BK * 2, STAGE_BYTES = 8 * HTB, NXCD = 8, WGM = 8;
__host__ __device__ __forceinline__ int lds_byte(int r, int c) { const int st = (r >> 4) * 2 + (c >> 5), rr = r & 15, cc = c & 31, ob = rr * 64 + cc * 2; return st * 1024 + (ob ^ (((ob >> 9) & 1) << 5)); }
__host__ __device__ __forceinline__ void stage_rc(int b, int& R, int& C) { const int st = b / 1024, sb = b % 1024, swz = sb ^ (((sb >> 9) & 1) << 5); R = (st >> 1) * 16 + swz / 64; C = (st & 1) * 32 + (swz % 64) / 2; }
__host__ __device__ __forceinline__ int perm32(int rho) { const int n = rho >> 4, i = rho & 15; return 8 * (i >> 2) + 4 * n + (i & 3); }

struct Unit { int pm, pn; const char* A; const char* B; int chain; };
struct Gemm { int lda, ldb, K; };

struct TileOrder {
    int nM, nN, nwg, G, c;
    __device__ void init(int Mrows, int N, int G_, int c_) { nM = Mrows / BM; nN = N / BM; nwg = nM * nN; G = G_; c = c_; }
    __device__ bool tile(int i, int& pm, int& pn) const {
        const long L = (long)i * G + c; if (L >= nwg) return false;
        int wgid = (int)L; { const int q = nwg / NXCD, r = nwg % NXCD, xcd = wgid % NXCD, off = wgid / NXCD; wgid = (xcd < r ? xcd * (q + 1) : r * (q + 1) + (xcd - r) * q) + off; }
        const int nig = WGM * nN, gid = wgid / nig, fm = gid * WGM, gsz = (nM - fm) < WGM ? (nM - fm) : WGM;
        pm = fm + ((wgid % nig) % gsz); pn = (wgid % nig) / gsz; return true;
    }
};
struct PlainSched {
    TileOrder T; const char* A; const char* B; size_t astep, bstep;
    __device__ bool next(int i, Unit& u) const { int pm, pn; if (!T.tile(i, pm, pn)) return false; u.pm = pm; u.pn = pn; u.A = A + (size_t)pm * astep; u.B = B + (size_t)pn * bstep; u.chain = 0; return true; }
};
struct PairSched {
    TileOrder T; const char* A0; const char* A1; const char* B0; const char* B1; size_t astep, bstep;
    __device__ bool next(int i, Unit& u) const { int pm, pn; if (!T.tile(i >> 1, pm, pn)) return false; const int s = i & 1; u.pm = pm; u.pn = pn;
        u.A = (s ? A1 : A0) + (size_t)pm * astep; u.B = (s ? B1 : B0) + (size_t)pn * bstep; u.chain = s ? 0 : 1; return true; }
};

typedef f32x4 Acc[2][2][4][2];

struct EpiQKVG {
    static constexpr bool PERM = true, PREF = false;
    bf16_t* QKV; bf16_t* SG; const float* bgate;
    __device__ __forceinline__ void operator()(Acc& acc, const Unit& u, int wr, int wc, int fr, int fq, LAS float* tab, int tid) const {
        const int row0 = u.pm * BM + wr * 64 + fr;
        if (u.pn < 12) {
            const float sc = (u.pn < 2 || (u.pn >= 6 && u.pn < 8)) ? C2 : 1.0f;
            const int col0 = u.pn * BM + wc * 32 + 8 * fq;
#pragma unroll
            for (int ai = 0; ai < 2; ++ai)
#pragma unroll
                for (int m = 0; m < 4; ++m) { bf16_t* rowp = QKV + (size_t)(row0 + ai * HALF + m * 16) * NQKV + col0;
#pragma unroll
                    for (int bj = 0; bj < 2; ++bj) { const f32x4 v0 = acc[ai][bj][m][0] * sc, v1 = acc[ai][bj][m][1] * sc;
                        u32x4 w; w.x = cvt_pk_bf16(v0[0], v0[1]); w.y = cvt_pk_bf16(v0[2], v0[3]); w.z = cvt_pk_bf16(v1[0], v1[1]); w.w = cvt_pk_bf16(v1[2], v1[3]);
                        *(u32x4*)(rowp + bj * HALF) = w; } }
        } else {
            const int col0 = (u.pn - 12) * BM + wc * 32 + 8 * fq;
            f32x4 bv[2][2];
#pragma unroll
            for (int bj = 0; bj < 2; ++bj)
#pragma unroll
                for (int n = 0; n < 2; ++n) bv[bj][n] = *(const f32x4*)(bgate + col0 + bj * HALF + 4 * n);
#pragma unroll
            for (int ai = 0; ai < 2; ++ai)
#pragma unroll
                for (int m = 0; m < 4; ++m) { bf16_t* rowp = SG + (size_t)(row0 + ai * HALF + m * 16) * NGATE + col0;
#pragma unroll
                    for (int bj = 0; bj < 2; ++bj) { const f32x4 a0 = acc[ai][bj][m][0] + bv[bj][0], a1 = acc[ai][bj][m][1] + bv[bj][1];
                        u32x4 w; w.x = cvt_pk_bf16(fast_sigmoid(a0[0]), fast_sigmoid(a0[1])); w.y = cvt_pk_bf16(fast_sigmoid(a0[2]), fast_sigmoid(a0[3]));
                        w.z = cvt_pk_bf16(fast_sigmoid(a1[0]), fast_sigmoid(a1[1])); w.w = cvt_pk_bf16(fast_sigmoid(a1[2]), fast_sigmoid(a1[3]));
                        *(u32x4*)(rowp + bj * HALF) = w; } }
        }
    }
};
struct EpiBf16 {
    static constexpr bool PERM = true, PREF = false;
    bf16_t* O; int ldc;
    __device__ __forceinline__ void operator()(Acc& acc, const Unit& u, int wr, int wc, int fr, int fq, LAS float* tab, int tid) const {
        const int row0 = u.pm * BM + wr * 64 + fr, col0 = u.pn * BM + wc * 32 + 8 * fq;
#pragma unroll
        for (int ai = 0; ai < 2; ++ai)
#pragma unroll
            for (int m = 0; m < 4; ++m) { bf16_t* rowp = O + (size_t)(row0 + ai * HALF + m * 16) * ldc + col0;
#pragma unroll
                for (int bj = 0; bj < 2; ++bj) { const f32x4 v0 = acc[ai][bj][m][0], v1 = acc[ai][bj][m][1];
                    u32x4 w; w.x = cvt_pk_bf16(v0[0], v0[1]); w.y = cvt_pk_bf16(v0[2], v0[3]); w.z = cvt_pk_bf16(v1[0], v1[1]); w.w = cvt_pk_bf16(v1[2], v1[3]);
                    *(u32x4*)(rowp + bj * HALF) = w; } }
    }
};
__device__ __forceinline__ f32x4 bf4_lo(const u32x4 w) { return (f32x4){bf_lo(w.x), bf_hi(w.x), bf_lo(w.y), bf_hi(w.y)}; }
__device__ __forceinline__ f32x4 bf4_hi(const u32x4 w) { return (f32x4){bf_lo(w.z), bf_hi(w.z), bf_lo(w.w), bf_hi(w.w)}; }
__device__ __forceinline__ u32x4 pack8(const f32x4 v0, const f32x4 v1) { u32x4 w; w.x = cvt_pk_bf16(v0[0], v0[1]); w.y = cvt_pk_bf16(v0[2], v0[3]); w.z = cvt_pk_bf16(v1[0], v1[1]); w.w = cvt_pk_bf16(v1[2], v1[3]); return w; }
struct EpiBranch {
    static constexpr bool PERM = true, PREF = false;
    const bf16_t* SG; bf16_t* MG;
    __device__ __forceinline__ void operator()(Acc& acc, const Unit& u, int wr, int wc, int fr, int fq, LAS float* tab, int tid) const {
        const int row0 = u.pm * BM + wr * 64 + fr, col0 = u.pn * BM + wc * 32 + 8 * fq;
#pragma unroll
        for (int ai = 0; ai < 2; ++ai) {
            u32x4 ga[4][2], gb[4][2];
#pragma unroll
            for (int m = 0; m < 4; ++m)
#pragma unroll
                for (int bj = 0; bj < 2; ++bj) { const bf16_t* p = SG + (size_t)(row0 + ai * HALF + m * 16) * NGATE + col0 + bj * HALF; gb[m][bj] = *(const u32x4*)(p + DM); if (u.chain) ga[m][bj] = *(const u32x4*)p; }
#pragma unroll
            for (int m = 0; m < 4; ++m)
#pragma unroll
                for (int bj = 0; bj < 2; ++bj) { const f32x4 b0 = bf4_lo(gb[m][bj]), b1 = bf4_hi(gb[m][bj]);
                    if (u.chain) { const f32x4 a0 = bf4_lo(ga[m][bj]), a1 = bf4_hi(ga[m][bj]);
#pragma unroll
                        for (int e = 0; e < 4; ++e) { acc[ai][bj][m][0][e] *= a0[e] * __builtin_amdgcn_rcpf(fmaxf(b0[e], 1e-30f)); acc[ai][bj][m][1][e] *= a1[e] * __builtin_amdgcn_rcpf(fmaxf(b1[e], 1e-30f)); }
                    } else *(u32x4*)(MG + (size_t)(row0 + ai * HALF + m * 16) * DM + col0 + bj * HALF) = pack8(acc[ai][bj][m][0] * b0, acc[ai][bj][m][1] * b1); }
            asm volatile("" ::: "memory");
        }
    }
};
__device__ __forceinline__ void ssq_publish(LAS float* tab, float* ssq, const Unit& u, int tid) {
    asm volatile("s_waitcnt lgkmcnt(0)" ::: "memory"); __builtin_amdgcn_s_barrier(); asm volatile("" ::: "memory");
    if (tid < 256) { const f32x4 t = *(const LAS f32x4*)(tab + tid * 4); ssq[(size_t)(u.pm * BM + tid) * 4 + u.pn] = (t[0] + t[1]) + (t[2] + t[3]); }
}
struct EpiRes4 {
    static constexpr bool PERM = true, PREF = false;
    const float* base; bf16_t* xb; float* ssq;
    __device__ __forceinline__ void operator()(Acc& acc, const Unit& u, int wr, int wc, int fr, int fq, LAS float* tab, int tid) const {
        const int row0 = u.pm * BM + wr * 64 + fr, col0 = u.pn * BM + wc * 32 + 8 * fq;
#pragma unroll
        for (int ai = 0; ai < 2; ++ai) {
            f32x4 bs[4][2][2];
#pragma unroll
            for (int m = 0; m < 4; ++m)
#pragma unroll
                for (int bj = 0; bj < 2; ++bj)
#pragma unroll
                    for (int n = 0; n < 2; ++n) bs[m][bj][n] = *(const f32x4*)(base + (size_t)(row0 + ai * HALF + m * 16) * DM + col0 + bj * HALF + 4 * n);
#pragma unroll
            for (int m = 0; m < 4; ++m) { float s = 0.f;
#pragma unroll
                for (int bj = 0; bj < 2; ++bj) { const f32x4 x0 = bs[m][bj][0] + acc[ai][bj][m][0], x1 = bs[m][bj][1] + acc[ai][bj][m][1];
                    s += ((x0[0] * x0[0] + x0[1] * x0[1]) + (x0[2] * x0[2] + x0[3] * x0[3])) + ((x1[0] * x1[0] + x1[1] * x1[1]) + (x1[2] * x1[2] + x1[3] * x1[3]));
                    *(u32x4*)(xb + (size_t)(row0 + ai * HALF + m * 16) * DM + col0 + bj * HALF) = pack8(x0, x1); }
                s += __shfl_xor(s, 16); s += __shfl_xor(s, 32);
                if (fq == 0) tab[(ai * HALF + wr * 64 + m * 16 + fr) * 4 + wc] = s; }
            asm volatile("" ::: "memory");
        }
        ssq_publish(tab, ssq, u, tid);
    }
};
struct EpiRes6 {
    static constexpr bool PERM = true, PREF = false;
    const bf16_t* xin; bf16_t* xb; float* ssq;
    __device__ __forceinline__ void operator()(Acc& acc, const Unit& u, int wr, int wc, int fr, int fq, LAS float* tab, int tid) const {
        const int row0 = u.pm * BM + wr * 64 + fr, col0 = u.pn * BM + wc * 32 + 8 * fq;
        u32x4 xi[2][4][2];
#pragma unroll
        for (int ai = 0; ai < 2; ++ai)
#pragma unroll
            for (int m = 0; m < 4; ++m)
#pragma unroll
                for (int bj = 0; bj < 2; ++bj) xi[ai][m][bj] = *(const u32x4*)(xin + (size_t)(row0 + ai * HALF + m * 16) * DM + col0 + bj * HALF);
#pragma unroll
        for (int ai = 0; ai < 2; ++ai)
#pragma unroll
            for (int m = 0; m < 4; ++m) { float s = 0.f;
#pragma unroll
                for (int bj = 0; bj < 2; ++bj) { const f32x4 x0 = bf4_lo(xi[ai][m][bj]) + acc[ai][bj][m][0], x1 = bf4_hi(xi[ai][m][bj]) + acc[ai][bj][m][1];
                    s += ((x0[0] * x0[0] + x0[1] * x0[1]) + (x0[2] * x0[2] + x0[3] * x0[3])) + ((x1[0] * x1[0] + x1[1] * x1[1]) + (x1[2] * x1[2] + x1[3] * x1[3]));
                    *(u32x4*)(xb + (size_t)(row0 + ai * HALF + m * 16) * DM + col0 + bj * HALF) = pack8(x0, x1); }
                s += __shfl_xor(s, 16); s += __shfl_xor(s, 32);
                if (fq == 0) tab[(ai * HALF + wr * 64 + m * 16 + fr) * 4 + wc] = s; }
        ssq_publish(tab, ssq, u, tid);
    }
};
__device__ __forceinline__ float rstd_of(const f32x4 q) { return __builtin_amdgcn_rsqf(((q[0] + q[1]) + (q[2] + q[3])) * (1.0f / DM) + EPS); }
struct EpiUp {
    static constexpr bool PERM = true, PREF = true;
    bf16_t* H; const float* ssq;
    __device__ __forceinline__ void prefetch(const Unit& u, LAS unsigned char* tabb, int tid, int wid) const {
        if (tid < 256) __builtin_amdgcn_global_load_lds((const unsigned*)(ssq + (size_t)(u.pm * BM + tid) * 4), (LAS unsigned*)(tabb + wid * 1024), 16, 0, 0);
    }
    __device__ __forceinline__ void operator()(Acc& acc, const Unit& u, int wr, int wc, int fr, int fq, LAS float* tab, int tid) const {
        const int row0 = u.pm * BM + wr * 64 + fr, col0 = u.pn * BM + wc * 32 + 8 * fq;
        f32x4 sq[2][4];
        { const unsigned ta = (unsigned)(uintptr_t)tab + (unsigned)(wr * 64 + fr) * 16u;
#pragma unroll
          for (int ai = 0; ai < 2; ++ai)
#pragma unroll
              for (int m = 0; m < 4; ++m) asm volatile("ds_read_b128 %0, %1 offset:%c2" : "=&v"(sq[ai][m]) : "v"(ta), "i"((ai * HALF + m * 16) * 16) : "memory");
          asm volatile("s_waitcnt lgkmcnt(0)" ::: "memory"); __builtin_amdgcn_sched_barrier(0); }
#pragma unroll
        for (int ai = 0; ai < 2; ++ai)
#pragma unroll
            for (int m = 0; m < 4; ++m) { const float r = rstd_of(sq[ai][m]); bf16_t* rowp = H + (size_t)(row0 + ai * HALF + m * 16) * DFF + col0;
#pragma unroll
                for (int bj = 0; bj < 2; ++bj) { f32x4 v0 = acc[ai][bj][m][0] * r, v1 = acc[ai][bj][m][1] * r;
#pragma unroll
                    for (int e = 0; e < 4; ++e) { const float a = fmaxf(v0[e], 0.f), b = fmaxf(v1[e], 0.f); v0[e] = a * a; v1[e] = b * b; }
                    *(u32x4*)(rowp + bj * HALF) = pack8(v0, v1); } }
    }
};
struct EpiPle {
    static constexpr bool PERM = true, PREF = false;
    const bf16_t* xin; bf16_t* xb; const bf16_t* E; const float* ssq;
    __device__ __forceinline__ void operator()(Acc& acc, const Unit& u, int wr, int wc, int fr, int fq, LAS float* tab, int tid) const {
        const int row0 = u.pm * BM + wr * 64 + fr, col0 = u.pn * BM + wc * 32 + 8 * fq;
#pragma unroll
        for (int ai = 0; ai < 2; ++ai)
#pragma unroll
            for (int mh = 0; mh < 2; ++mh) {
                u32x4 xi[2][2], ei[2][2]; f32x4 sq[2];
#pragma unroll
                for (int mm = 0; mm < 2; ++mm) { const int row = row0 + ai * HALF + (2 * mh + mm) * 16; sq[mm] = *(const f32x4*)(ssq + (size_t)row * 4);
#pragma unroll
                    for (int bj = 0; bj < 2; ++bj) { const size_t off = (size_t)row * DM + col0 + bj * HALF; xi[mm][bj] = *(const u32x4*)(xin + off); ei[mm][bj] = *(const u32x4*)(E + off); } }
#pragma unroll
                for (int mm = 0; mm < 2; ++mm) { const int m = 2 * mh + mm; const float r = rstd_of(sq[mm]);
#pragma unroll
                    for (int bj = 0; bj < 2; ++bj) { const f32x4 a0 = acc[ai][bj][m][0] * r, a1 = acc[ai][bj][m][1] * r, e0 = bf4_lo(ei[mm][bj]), e1 = bf4_hi(ei[mm][bj]); f32x4 o0 = bf4_lo(xi[mm][bj]), o1 = bf4_hi(xi[mm][bj]);
#pragma unroll
                        for (int e = 0; e < 4; ++e) { o0[e] += fast_sigmoid(a0[e]) * e0[e]; o1[e] += fast_sigmoid(a1[e]) * e1[e]; }
                        *(u32x4*)(xb + (size_t)(row0 + ai * HALF + m * 16) * DM + col0 + bj * HALF) = pack8(o0, o1); } }
                asm volatile("" ::: "memory");
            }
    }
};

template <class Epi, class Sched>
__device__ __forceinline__ void gemm_phase(LAS unsigned char* lds, const Gemm g, const Sched& S, const Epi& E) {
    const int tid = threadIdx.x, wid = __builtin_amdgcn_readfirstlane(tid >> 6), lane = tid & 63, wr = wid >> 2, wc = wid & 3, fr = lane & 15, fq = lane >> 4;
    const int K = g.K, nt = K / BK;
    unsigned voffA[2], voffB[2];
#pragma unroll
    for (int i = 0; i < 2; ++i) { int R, C; stage_rc(tid * 16 + i * 8192, R, C); const int Rb = Epi::PERM ? ((R & ~31) + perm32(R & 31)) : R;
        voffA[i] = (unsigned)(R * g.lda + C) * 2u; voffB[i] = (unsigned)(Rb * g.ldb + C) * 2u; }
    const size_t kstep = (size_t)(BK * 2);
    const size_t hA = (size_t)HALF * g.lda * 2, hB = (size_t)HALF * g.ldb * 2;
    const unsigned ldsw = (unsigned)wid * 1024u;
    const int aoff = lds_byte(wr * 64 + fr, fq * 8), boff = lds_byte(wc * 32 + fr, fq * 8);
#define PG8_SA(b, h) (((b) * 2 + (h)) * HTB)
#define PG8_SB(b, h) ((4 + (b) * 2 + (h)) * HTB)
#define PG8_STAGE(bufoff, gbase, voff) do { _Pragma("unroll") for (int _i = 0; _i < 2; ++_i) \
        __builtin_amdgcn_global_load_lds((const unsigned*)((const char*)(gbase) + (voff)[_i]), (LAS unsigned*)(lds + (bufoff) + ldsw + _i * 8192), 16, 0, 0); } while (0)
#define PG8_LDA(dst, b, h) do { _Pragma("unroll") for (int m = 0; m < 4; ++m) _Pragma("unroll") for (int k = 0; k < 2; ++k) dst[m][k] = *(const LAS bf16x8*)(lds + PG8_SA(b, h) + aoff + m * 2048 + k * 1024); } while (0)
#define PG8_LDB(dst, b, h) do { _Pragma("unroll") for (int n = 0; n < 2; ++n) _Pragma("unroll") for (int k = 0; k < 2; ++k) dst[n][k] = *(const LAS bf16x8*)(lds + PG8_SB(b, h) + boff + n * 2048 + k * 1024); } while (0)
#define PG8_MMA(ai, bj, At, Bt) do { __builtin_amdgcn_s_setprio(1); _Pragma("unroll") for (int m = 0; m < 4; ++m) _Pragma("unroll") for (int n = 0; n < 2; ++n) _Pragma("unroll") for (int k = 0; k < 2; ++k) \
        acc[ai][bj][m][n] = __builtin_amdgcn_mfma_f32_16x16x32_bf16(Bt[n][k], At[m][k], acc[ai][bj][m][n], 0, 0, 0); __builtin_amdgcn_s_setprio(0); } while (0)
#define PG8_WAIT_V(n) asm volatile("s_waitcnt vmcnt(" #n ")" ::: "memory")
#define PG8_WAIT_L(n) asm volatile("s_waitcnt lgkmcnt(" #n ")" ::: "memory")
#define PG8_BAR __builtin_amdgcn_s_barrier()
#define PG8_SCHED __builtin_amdgcn_sched_barrier(0)
#define PG8_ZERO() do { _Pragma("unroll") for (int a = 0; a < 2; ++a) _Pragma("unroll") for (int b = 0; b < 2; ++b) _Pragma("unroll") for (int m = 0; m < 4; ++m) _Pragma("unroll") for (int n = 0; n < 2; ++n) acc[a][b][m][n] = (f32x4){0.f, 0.f, 0.f, 0.f}; } while (0)
    Unit cur, nxt; int ui = 0;
    if (!S.next(0, cur)) return;
    Acc acc;
    PG8_ZERO();
    bf16x8 At[4][2], B0[2][2], B1[2][2];
    const char* cA = uni_ptr(cur.A); const char* cB = uni_ptr(cur.B);
    if constexpr (Epi::PREF) E.prefetch(cur, lds + STAGE_BYTES + 64, tid, wid);
    PG8_STAGE(PG8_SB(0, 0), cB, voffB); PG8_STAGE(PG8_SB(0, 1), cB + hB, voffB); PG8_STAGE(PG8_SA(0, 0), cA, voffA); PG8_STAGE(PG8_SA(0, 1), cA + hA, voffA);
    if (wr == 1) PG8_BAR;
    PG8_WAIT_V(2); PG8_BAR;
    PG8_STAGE(PG8_SB(1, 0), cB + kstep, voffB); PG8_STAGE(PG8_SA(1, 0), cA + kstep, voffA); PG8_STAGE(PG8_SB(1, 1), cB + hB + kstep, voffB);
    PG8_WAIT_V(6); PG8_BAR;
    for (;;) {
        const bool has_next = S.next(ui + 1, nxt);
        const char* nA = uni_ptr(has_next ? nxt.A : cA); const char* nB = uni_ptr(has_next ? nxt.B : cB);
#pragma nounroll
        for (int t = 0; t < nt; t += 2) {
            const bool last = (t == nt - 2);
            const char* a1 = cA + (size_t)(t + 1) * kstep;
            const char* a2 = last ? nA : cA + (size_t)(t + 2) * kstep; const char* b2 = last ? nB : cB + (size_t)(t + 2) * kstep;
            const char* a3 = a2 + kstep; const char* b3 = b2 + kstep;
            PG8_LDB(B0, 0, 0); PG8_LDB(B1, 0, 1); PG8_SCHED; PG8_LDA(At, 0, 0); PG8_STAGE(PG8_SA(1, 1), a1 + hA, voffA);
            PG8_WAIT_V(8); PG8_WAIT_L(0); PG8_BAR; PG8_MMA(0, 0, At, B0); PG8_MMA(0, 1, At, B1); PG8_BAR; PG8_SCHED;
            PG8_LDA(At, 0, 1); PG8_STAGE(PG8_SB(0, 0), b2, voffB); PG8_STAGE(PG8_SB(0, 1), b2 + hB, voffB); PG8_STAGE(PG8_SA(0, 0), a2, voffA);
            PG8_WAIT_V(8); PG8_WAIT_L(0); PG8_BAR; PG8_MMA(1, 0, At, B0); PG8_MMA(1, 1, At, B1); PG8_BAR; PG8_SCHED;
            PG8_LDB(B0, 1, 0); PG8_LDB(B1, 1, 1); PG8_SCHED; PG8_LDA(At, 1, 0); PG8_STAGE(PG8_SA(0, 1), a2 + hA, voffA);
            PG8_WAIT_V(8); PG8_WAIT_L(0); PG8_BAR; PG8_MMA(0, 0, At, B0); PG8_MMA(0, 1, At, B1); PG8_BAR; PG8_SCHED;
            PG8_LDA(At, 1, 1); PG8_STAGE(PG8_SB(1, 0), b3, voffB); PG8_STAGE(PG8_SB(1, 1), b3 + hB, voffB); PG8_STAGE(PG8_SA(1, 0), a3, voffA);
            PG8_WAIT_V(8); PG8_WAIT_L(0); PG8_BAR; PG8_MMA(1, 0, At, B0); PG8_MMA(1, 1, At, B1); PG8_BAR; PG8_SCHED;
        }
        if (wr == 0) PG8_BAR;
        E(acc, cur, wr, wc, fr, fq, (LAS float*)(lds + STAGE_BYTES + 64 + (ui & 1) * 4096), tid);
        if (!has_next) break;
        if constexpr (Epi::PREF) E.prefetch(nxt, lds + STAGE_BYTES + 64 + ((ui + 1) & 1) * 4096, tid, wid);
        if (!cur.chain) PG8_ZERO();
        cur = nxt; cA = nA; cB = nB; ++ui;
        if (wr == 1) PG8_BAR;
    }
    PG8_WAIT_V(0);
    PG8_BAR;
#undef PG8_SA
#undef PG8_SB
#undef PG8_STAGE
#undef PG8_LDA
#undef PG8_LDB
#undef PG8_MMA
#undef PG8_WAIT_V
#undef PG8_WAIT_L
#undef PG8_BAR
#undef PG8_SCHED
#undef PG8_ZERO
}
}

namespace att {
constexpr int PITCH = NQKV, OPITCH = DM;
constexpr int SLOT = 16384, L_K = 0, L_V = 8192;
constexpr int FX_NSLOT = 4, SB_NSLOT = 7;
constexpr int L_CB = FX_NSLOT * SLOT;
constexpr int L_OST = SB_NSLOT * SLOT;
constexpr int L_FLAG = 147456 + 64, L_WS = 147456 + 192;
static_assert(L_CB + 2 * SEQ * 4 <= L_OST && SB_NSLOT * SLOT <= L_OST && L_OST + 8 * 4096 <= 147456, "attention LDS map");
constexpr float SB_THR = -160.0f;
__device__ __forceinline__ int crow(int r, int hi) { return (r & 3) + 8 * (r >> 2) + 4 * hi; }
__device__ __forceinline__ void swap_halves(float v, float& lo, float& hi_) { auto rr = __builtin_amdgcn_permlane32_swap(__float_as_uint(v), __float_as_uint(v), false, false); lo = __uint_as_float(rr[0]); hi_ = __uint_as_float(rr[1]); }

struct AU { int b, h, qb, kind; };
struct Geo {
    const bf16_t* ksrc; const bf16_t* vsrc; const bf16_t* Qw; int wdst, nT, T_last, qw, qabs;
    __device__ __forceinline__ void init(const AU& u, const bf16_t* QKV, int lane, int wid) {
        const size_t rowbase = (size_t)u.b * SEQ; const int colq = u.kind * 1536 + u.h * HD; const int q0 = u.qb * 256;
        qw = q0 + wid * 32; qabs = qw + (lane & 31);
        ksrc = QKV + rowbase * PITCH + colq + 512 + (size_t)lane * PITCH + wid * 8;
        vsrc = QKV + rowbase * PITCH + colq + 1024 + (size_t)(16 * (wid & 3) + (lane >> 2)) * PITCH + (wid >> 2) * 32 + (lane & 3) * 8;
        Qw = QKV + (rowbase + qw) * PITCH + colq + (size_t)(lane & 31) * PITCH + (lane >> 5) * 8;
        wdst = wid * 1024; nT = u.qb * 4 + 4; T_last = nT - 1;
    }
};
#define ATT_DMA(G, tile, slotidx) do { const int t_ = (tile); LAS unsigned char* sl_ = lds + (slotidx) * SLOT + (G).wdst; \
        __builtin_amdgcn_global_load_lds((const unsigned*)((G).ksrc + (size_t)t_ * 64 * PITCH), (LAS unsigned*)(sl_ + L_K), 16, 0, 0); \
        __builtin_amdgcn_global_load_lds((const unsigned*)((G).vsrc + (size_t)t_ * 64 * PITCH), (LAS unsigned*)(sl_ + L_V), 16, 0, 0); } while (0)
#define ATT_VREAD(slot) do { const unsigned vb = (unsigned)(uintptr_t)((slot) + L_V + ((lane >> 4) & 1) * 32 + (lane & 3) * 8 + (4 * hi + ((lane & 15) >> 2)) * 64); \
        _Pragma("unroll") for (int i = 0; i < 8; ++i) { \
            asm volatile("ds_read_b64_tr_b16 %0, %1 offset:%c2" : "=&v"(vlo[i]) : "v"(vb), "i"((i >> 2) * 4096 + (i & 3) * 1024) : "memory"); \
            asm volatile("ds_read_b64_tr_b16 %0, %1 offset:%c2" : "=&v"(vhi[i]) : "v"(vb), "i"((i >> 2) * 4096 + (i & 3) * 1024 + 512) : "memory"); } } while (0)
#define ATT_PV() do { u32x4 pw[4]; \
        pw[0] = (u32x4){cvt_pk_bf16(p0[0], p0[1]), cvt_pk_bf16(p0[2], p0[3]), cvt_pk_bf16(p0[4], p0[5]), cvt_pk_bf16(p0[6], p0[7])}; \
        pw[1] = (u32x4){cvt_pk_bf16(p0[8], p0[9]), cvt_pk_bf16(p0[10], p0[11]), cvt_pk_bf16(p0[12], p0[13]), cvt_pk_bf16(p0[14], p0[15])}; \
        pw[2] = (u32x4){cvt_pk_bf16(p1[0], p1[1]), cvt_pk_bf16(p1[2], p1[3]), cvt_pk_bf16(p1[4], p1[5]), cvt_pk_bf16(p1[6], p1[7])}; \
        pw[3] = (u32x4){cvt_pk_bf16(p1[8], p1[9]), cvt_pk_bf16(p1[10], p1[11]), cvt_pk_bf16(p1[12], p1[13]), cvt_pk_bf16(p1[14], p1[15])}; \
        asm volatile("s_waitcnt lgkmcnt(0)" ::: "memory"); __builtin_amdgcn_sched_barrier(0); \
        _Pragma("unroll") for (int ks = 0; ks < 4; ++ks) _Pragma("unroll") for (int d0 = 0; d0 < 2; ++d0) { const int i = d0 * 4 + ks; \
            const bf16x8 vf = {vlo[i][0], vlo[i][1], vlo[i][2], vlo[i][3], vhi[i][0], vhi[i][1], vhi[i][2], vhi[i][3]}; \
            o[d0] = __builtin_amdgcn_mfma_f32_32x32x16_bf16(__builtin_bit_cast(bf16x8, pw[ks]), vf, o[d0], 0, 0, 0); } } while (0)

__device__ __forceinline__ void unit_prologue(const AU& u, const bf16_t* QKV, const float* cc, LAS unsigned char* lds, bf16x8 (&qr)[4], f32x4& c4, float& cref) {
    const int tid = threadIdx.x, lane = tid & 63; const int wid = __builtin_amdgcn_readfirstlane(tid >> 6);
    Geo g; g.init(u, QKV, lane, wid);
    if (u.kind == 0) { ATT_DMA(g, g.T_last, 0); ATT_DMA(g, g.T_last - 1, 1); ATT_DMA(g, g.T_last - 2, 2); }
    else { ATT_DMA(g, g.T_last, 0); ATT_DMA(g, g.T_last - 1, 1); ATT_DMA(g, g.T_last - 2, 2); ATT_DMA(g, g.T_last - 3, 3); if (g.nT > 4) { ATT_DMA(g, g.T_last - 4, 4); ATT_DMA(g, g.T_last - 5, 5); } }
#pragma unroll
    for (int d0 = 0; d0 < 4; ++d0) qr[d0] = *(const bf16x8*)(g.Qw + d0 * 16);
    if (u.kind == 0) { const float* ccb = cc + (size_t)(u.b * NH + u.h) * SEQ; cref = ccb[u.qb * 256 + 255]; c4 = *((const f32x4*)ccb + tid); }
}
__device__ __forceinline__ void unit_prologue_finish(const AU& u, LAS unsigned char* lds, bf16x8 (&qr)[4], const f32x4 c4, const float cref, int cbuf) {
    if (u.kind == 0) *((LAS f32x4*)(lds + L_CB + cbuf * SEQ * 4) + threadIdx.x) = cref - c4;
#pragma unroll
    for (int d0 = 0; d0 < 4; ++d0) { const u32x4 w = __builtin_bit_cast(u32x4, qr[d0]); u32x4 y;
        asm volatile("v_mov_b32 %0, %1" : "=&v"(y.x) : "v"(w.x)); asm volatile("v_mov_b32 %0, %1" : "=&v"(y.y) : "v"(w.y)); asm volatile("v_mov_b32 %0, %1" : "=&v"(y.z) : "v"(w.z)); asm volatile("v_mov_b32 %0, %1" : "=&v"(y.w) : "v"(w.w));
        qr[d0] = __builtin_bit_cast(bf16x8, y); }
}

__device__ __forceinline__ void fox_loop(const AU& u, const bf16_t* QKV, LAS unsigned char* lds, const bf16x8 (&qr)[4], int cbuf, f32x16 (&o)[2], float& inv) {
    const int tid = threadIdx.x, lane = tid & 63, r32 = lane & 31, hi = lane >> 5; const int wid = __builtin_amdgcn_readfirstlane(tid >> 6);
    Geo g; g.init(u, QKV, lane, wid);
    const int nIter = g.nT, T_last = g.T_last, td = g.qw >> 6, qabs = g.qabs;
    LAS float* wsf = (LAS float*)(lds + L_WS) + wid * 64;
    const LAS float* cbl = (const LAS float*)(lds + L_CB + cbuf * SEQ * 4);
    o[0] = (f32x16){}; o[1] = (f32x16){};
    float mrun = -INFINITY, lrun = 0.f;
    for (int it = 0; it < nIter; ++it) {
        const int t = T_last - it; const int ahead = nIter - 1 - it;
        if (ahead >= 2) asm volatile("s_waitcnt vmcnt(4) lgkmcnt(0)" ::: "memory"); else if (ahead == 1) asm volatile("s_waitcnt vmcnt(2) lgkmcnt(0)" ::: "memory"); else asm volatile("s_waitcnt vmcnt(0) lgkmcnt(0)" ::: "memory");
        __builtin_amdgcn_s_barrier(); asm volatile("" ::: "memory");
        if (it + 3 < nIter) ATT_DMA(g, T_last - (it + 3), (it + 3) & (FX_NSLOT - 1));
        if (t <= td) {
            const LAS unsigned char* slot = lds + (it & (FX_NSLOT - 1)) * SLOT;
            f32x16 p0, p1; f32x4 cq[8]; bf16x8 kf[8];
            { const unsigned ca = (unsigned)(uintptr_t)(cbl + t * 64 + 4 * hi), ka = (unsigned)(uintptr_t)(slot + L_K + hi * 1024 + r32 * 16);
#pragma unroll
              for (int gq = 0; gq < 4; ++gq) { asm volatile("ds_read_b128 %0, %1 offset:%c2" : "=&v"(cq[gq]) : "v"(ca), "i"(32 * gq) : "memory"); asm volatile("ds_read_b128 %0, %1 offset:%c2" : "=&v"(cq[4 + gq]) : "v"(ca), "i"(128 + 32 * gq) : "memory"); }
#pragma unroll
              for (int d0 = 0; d0 < 4; ++d0) { asm volatile("ds_read_b128 %0, %1 offset:%c2" : "=&v"(kf[2 * d0]) : "v"(ka), "i"(d0 * 2048) : "memory"); asm volatile("ds_read_b128 %0, %1 offset:%c2" : "=&v"(kf[2 * d0 + 1]) : "v"(ka), "i"(d0 * 2048 + 512) : "memory"); } }
            s16x4 vlo[8], vhi[8];
            ATT_VREAD(slot);
            asm volatile("s_waitcnt lgkmcnt(15)" ::: "memory"); __builtin_amdgcn_sched_barrier(0);
#pragma unroll
            for (int gq = 0; gq < 4; ++gq)
#pragma unroll
                for (int i = 0; i < 4; ++i) { p0[4 * gq + i] = cq[gq][i]; p1[4 * gq + i] = cq[4 + gq][i]; }
#pragma unroll
            for (int d0 = 0; d0 < 4; ++d0) { p0 = __builtin_amdgcn_mfma_f32_32x32x16_bf16(kf[2 * d0], qr[d0], p0, 0, 0, 0); p1 = __builtin_amdgcn_mfma_f32_32x32x16_bf16(kf[2 * d0 + 1], qr[d0], p1, 0, 0, 0); }
            if (t == td) { asm volatile("" ::: "memory"); const int kv0 = t * 64 + 4 * hi;
#pragma unroll
                for (int r = 0; r < 16; ++r) { const int kv = kv0 + (r & 3) + 8 * (r >> 2); if (kv > qabs) p0[r] = -INFINITY; if (kv + 32 > qabs) p1[r] = -INFINITY; } }
            float rm = fmaxf(p0[0], p1[0]);
#pragma unroll
            for (int r = 1; r < 16; ++r) rm = fmaxf(rm, fmaxf(p0[r], p1[r]));
            { float a, c; swap_halves(rm, a, c); rm = fmaxf(a, c); }
            if (__any(rm > mrun + 8.0f)) {
                const float mnew = fmaxf(mrun, rm); const float f = __builtin_amdgcn_exp2f(mrun - mnew); mrun = mnew; lrun *= f;
                if (hi == 0) wsf[r32] = f;
                asm volatile("s_waitcnt lgkmcnt(0)" ::: "memory");
#pragma unroll
                for (int r = 0; r < 16; ++r) { const float fr_ = wsf[crow(r, hi)]; o[0][r] *= fr_; o[1][r] *= fr_; }
                asm volatile("s_waitcnt lgkmcnt(0)" ::: "memory");
            }
            float ls = 0.f;
#pragma unroll
            for (int r = 0; r < 16; ++r) { p0[r] = __builtin_amdgcn_exp2f(p0[r] - mrun); p1[r] = __builtin_amdgcn_exp2f(p1[r] - mrun); ls += p0[r] + p1[r]; }
            lrun += ls;
            ATT_PV();
        }
    }
    { float a, c; swap_halves(lrun, a, c); inv = 1.0f / (a + c); }
    asm volatile("s_waitcnt lgkmcnt(0)" ::: "memory");
    __builtin_amdgcn_s_barrier(); asm volatile("" ::: "memory");
}

__device__ __forceinline__ void sb_loop(const AU& u, const bf16_t* QKV, LAS unsigned char* lds, const bf16x8 (&qr)[4], f32x16 (&o)[2]) {
    const int tid = threadIdx.x, lane = tid & 63, r32 = lane & 31, hi = lane >> 5; const int wid = __builtin_amdgcn_readfirstlane(tid >> 6);
    Geo g; g.init(u, QKV, lane, wid);
    const int nT = g.nT, T_last = g.T_last, dw = 3 - (wid >> 1), qabs = g.qabs;
    LAS unsigned* flags = (LAS unsigned*)(lds + L_FLAG);
    o[0] = (f32x16){}; o[1] = (f32x16){};
    float R = 0.f; bool mydone = false;
    for (int s = 0; s < nT; ++s) {
        { const int issued = (s + 5 < nT - 1) ? s + 5 : nT - 1, need = (s + 3 < nT - 1) ? s + 3 : nT - 1; const int cnt = issued - need;
          if (cnt >= 2) asm volatile("s_waitcnt vmcnt(4) lgkmcnt(0)" ::: "memory"); else if (cnt == 1) asm volatile("s_waitcnt vmcnt(2) lgkmcnt(0)" ::: "memory"); else asm volatile("s_waitcnt vmcnt(0) lgkmcnt(0)" ::: "memory"); }
        __builtin_amdgcn_s_barrier(); asm volatile("" ::: "memory");
        if (s > 0) { u32x4 fa, fb; const unsigned fad = (unsigned)(uintptr_t)(flags + ((s - 1) & 1) * 8);
            asm volatile("ds_read_b128 %0, %1" : "=&v"(fa) : "v"(fad) : "memory"); asm volatile("ds_read_b128 %0, %1 offset:16" : "=&v"(fb) : "v"(fad) : "memory");
            asm volatile("s_waitcnt lgkmcnt(0)" ::: "memory"); __builtin_amdgcn_sched_barrier(0);
            if ((fa.x & fa.y & fa.z & fa.w & fb.x & fb.y & fb.z & fb.w) != 0u) break; }
        if (s + 6 < nT) ATT_DMA(g, T_last - (s + 6), (s + 6) % SB_NSLOT);
        const int uu = s + dw;
        if (uu >= nT) mydone = true;
        if (!mydone) {
            const int t = T_last - uu; const LAS unsigned char* slot = lds + (uu % SB_NSLOT) * SLOT;
            f32x16 p0 = (f32x16){}, p1 = (f32x16){}; bf16x8 kf[8];
            { const unsigned ka = (unsigned)(uintptr_t)(slot + L_K + hi * 1024 + r32 * 16);
#pragma unroll
              for (int d0 = 0; d0 < 4; ++d0) { asm volatile("ds_read_b128 %0, %1 offset:%c2" : "=&v"(kf[2 * d0]) : "v"(ka), "i"(d0 * 2048) : "memory"); asm volatile("ds_read_b128 %0, %1 offset:%c2" : "=&v"(kf[2 * d0 + 1]) : "v"(ka), "i"(d0 * 2048 + 512) : "memory"); } }
            asm volatile("s_waitcnt lgkmcnt(0)" ::: "memory"); __builtin_amdgcn_sched_barrier(0);
#pragma unroll
            for (int d0 = 0; d0 < 4; ++d0) { p0 = __builtin_amdgcn_mfma_f32_32x32x16_bf16(kf[2 * d0], qr[d0], p0, 0, 0, 0); p1 = __builtin_amdgcn_mfma_f32_32x32x16_bf16(kf[2 * d0 + 1], qr[d0], p1, 0, 0, 0); }
            const bool diag = (s == 0); const int kv0 = t * 64 + 4 * hi;
            f32x16 l0, l1;
#pragma unroll
            for (int r = 0; r < 16; ++r) {
                { const float z = p0[r]; const float tt = __builtin_amdgcn_logf(1.0f + __builtin_amdgcn_exp2f(-fabsf(z))); l0[r] = -(fmaxf(z, 0.f) + tt); }
                { const float z = p1[r]; const float tt = __builtin_amdgcn_logf(1.0f + __builtin_amdgcn_exp2f(-fabsf(z))); l1[r] = -(fmaxf(z, 0.f) + tt); }
            }
            if (diag) {   asm volatile("" ::: "memory");
#pragma unroll
                for (int r = 0; r < 16; ++r) { const int kv = kv0 + (r & 3) + 8 * (r >> 2); if (!(kv < qabs)) l0[r] = 0.f; if (!(kv + 32 < qabs)) l1[r] = 0.f; }
            }
            float G[8], Gp[8];
#pragma unroll
            for (int gq = 0; gq < 4; ++gq) { G[gq] = (l0[4 * gq] + l0[4 * gq + 1]) + (l0[4 * gq + 2] + l0[4 * gq + 3]); G[4 + gq] = (l1[4 * gq] + l1[4 * gq + 1]) + (l1[4 * gq + 2] + l1[4 * gq + 3]); }
#pragma unroll
            for (int c = 0; c < 8; ++c) { float a, d; swap_halves(G[c], a, d); Gp[c] = hi ? a : d; }
            float cs = R;
#pragma unroll
            for (int c = 7; c >= 0; --c) {
                const float ex = cs + (hi ? 0.f : Gp[c]);
                const int gq = c & 3;
                if (c >= 4) { float s3 = l1[4 * gq + 3] + ex, s2 = l1[4 * gq + 2] + s3, s1 = l1[4 * gq + 1] + s2, s0 = l1[4 * gq] + s1; l1[4 * gq + 3] = s3; l1[4 * gq + 2] = s2; l1[4 * gq + 1] = s1; l1[4 * gq] = s0; }
                else        { float s3 = l0[4 * gq + 3] + ex, s2 = l0[4 * gq + 2] + s3, s1 = l0[4 * gq + 1] + s2, s0 = l0[4 * gq] + s1; l0[4 * gq + 3] = s3; l0[4 * gq + 2] = s2; l0[4 * gq + 1] = s1; l0[4 * gq] = s0; }
                cs += G[c] + Gp[c];
            }
            s16x4 vlo[8], vhi[8];
            ATT_VREAD(slot);
#pragma unroll
            for (int r = 0; r < 16; ++r) { p0[r] = __builtin_amdgcn_exp2f(p0[r] + l0[r]); p1[r] = __builtin_amdgcn_exp2f(p1[r] + l1[r]); }
            if (diag) {   asm volatile("" ::: "memory");
#pragma unroll
                for (int r = 0; r < 16; ++r) { const int kv = kv0 + (r & 3) + 8 * (r >> 2); if (!(kv < qabs)) p0[r] = 0.f; if (!(kv + 32 < qabs)) p1[r] = 0.f; }
            }
            R = cs;
            mydone = __all(R < SB_THR);
            ATT_PV();
        }
        if (lane == 0) flags[(s & 1) * 8 + wid] = mydone ? 1u : 0u;
    }
    asm volatile("s_waitcnt lgkmcnt(0)" ::: "memory");
    __builtin_amdgcn_s_barrier(); asm volatile("" ::: "memory");
}

__device__ __forceinline__ void unit_epilogue(const AU& u, bf16_t* O, LAS unsigned char* lds, const f32x16 (&o)[2], float inv) {
    const int tid = threadIdx.x, lane = tid & 63, r32 = lane & 31, hi = lane >> 5; const int wid = __builtin_amdgcn_readfirstlane(tid >> 6);
    LAS float* wsf = (LAS float*)(lds + L_WS) + wid * 64;
    if (hi == 0) wsf[32 + r32] = inv;
    asm volatile("s_waitcnt lgkmcnt(0)" ::: "memory");
    LAS bf16_t* stg = (LAS bf16_t*)(lds + L_OST) + wid * 2048;
#pragma unroll
    for (int r = 0; r < 16; ++r) { const int orow = crow(r, hi); const float rl = wsf[32 + orow]; const unsigned w = cvt_pk_bf16(o[0][r] * rl, o[1][r] * rl);
        stg[orow * 64 + r32] = (bf16_t)(w & 0xffffu); stg[orow * 64 + 32 + r32] = (bf16_t)(w >> 16); }
    asm volatile("s_waitcnt lgkmcnt(0)" ::: "memory");
    bf16_t* Ow = O + ((size_t)u.b * SEQ + u.qb * 256 + wid * 32) * OPITCH + u.kind * 512 + u.h * HD;
#pragma unroll
    for (int i = 0; i < 4; ++i) { const int row = i * 8 + (lane >> 3), ch = lane & 7; const u32x4 v = *(const LAS u32x4*)(stg + row * 64 + ch * 8); *(u32x4*)(Ow + (size_t)row * OPITCH + ch * 8) = v; }
    asm volatile("s_waitcnt lgkmcnt(0)" ::: "memory");
}
#undef ATT_DMA
#undef ATT_VREAD
#undef ATT_PV
}

#define XB_TMO      128
#define XB_XCNT(j)  (256  + 64 * (j))
#define XB_XSUB(j)  (1280 + 64 * (j))
#define XB_XGEN(j)  (2304 + 64 * (j))
#define XB_TOP      3328
#define XB_TOPGEN   3392
#define XCD_BAR_WORDS 3456
#define XB_SPIN_CAP (1u << 18)
__device__ __forceinline__ unsigned xb_ld(unsigned* p)              { return __hip_atomic_load(p, __ATOMIC_RELAXED, __HIP_MEMORY_SCOPE_AGENT); }
__device__ __forceinline__ unsigned xb_add(unsigned* p, unsigned v) { return __hip_atomic_fetch_add(p, v, __ATOMIC_RELAXED, __HIP_MEMORY_SCOPE_AGENT); }
__device__ __forceinline__ unsigned xb_xcc_id() { return (unsigned)__builtin_amdgcn_s_getreg((3 << 11) | 20) & 0xFu; }
#define XB_SPIN(cond, bar) do { unsigned _sp = 0; while (cond) { __builtin_amdgcn_s_sleep(1); \
    if ((++_sp & 255u) == 0u) { if (xb_ld(&(bar)[XB_TMO])) break; if (_sp > XB_SPIN_CAP) { atomicAdd(&(bar)[XB_TMO], 1u); break; } } } } while (0)
struct XcdBarrier { unsigned* bar; unsigned x; volatile LAS unsigned* st; };
__device__ __forceinline__ XcdBarrier xcd_barrier_post(unsigned* bar, volatile LAS unsigned* st) {
    XcdBarrier b; b.bar = bar; b.x = xb_xcc_id(); b.st = st;
    if (threadIdx.x == 0) (void)xb_add(&bar[XB_XCNT(b.x)], 1u);
    return b;
}
__device__ __forceinline__ void xcd_barrier_complete(unsigned* bar, unsigned x, unsigned& nloc, unsigned& nx) {
    const unsigned G = gridDim.x * gridDim.y * gridDim.z;
    unsigned sum, cnt, mine, sp = 0u;
    for (;;) {
        sum = 0u; cnt = 0u; mine = 0u;
#pragma unroll
        for (unsigned j = 0; j < 16; ++j) { const unsigned c = xb_ld(&bar[XB_XCNT(j)]); sum += c; cnt += (c > 0u) ? 1u : 0u; mine = (j == x) ? c : mine; }
        if (sum == G) break;
        __builtin_amdgcn_s_sleep(1);
        if ((++sp & 255u) == 0u) { if (xb_ld(&bar[XB_TMO])) break; if (sp > XB_SPIN_CAP) { atomicAdd(&bar[XB_TMO], 1u); break; } }
    }
    nloc = mine > 0u ? mine : 1u; nx = cnt > 0u ? cnt : 1u;
}
__device__ __forceinline__ void xcd_barrier(const XcdBarrier& b) {
    asm volatile("s_waitcnt vmcnt(0)" ::: "memory");
    __syncthreads();
    if (threadIdx.x == 0) {
        unsigned* bar = b.bar;
        __builtin_amdgcn_s_waitcnt(0);
        unsigned nloc = b.st[0], nx = b.st[1];
        if (nloc == 0u) { xcd_barrier_complete(bar, b.x, nloc, nx); b.st[0] = nloc; b.st[1] = nx; }
        const unsigned old = xb_add(&bar[XB_XSUB(b.x)], 1u);
        const unsigned gen = old / nloc;
        if (old + 1u == (gen + 1u) * nloc) {
            __builtin_amdgcn_fence(__ATOMIC_RELEASE, "agent");
            asm volatile("s_waitcnt vmcnt(0)" ::: "memory");
            const unsigned og = xb_add(&bar[XB_TOP], 1u);
            const unsigned tg = og / nx;
            if (og + 1u == (tg + 1u) * nx) xb_add(&bar[XB_TOPGEN], 1u);
            else XB_SPIN(xb_ld(&bar[XB_TOPGEN]) == tg, bar);
            __builtin_amdgcn_fence(__ATOMIC_ACQUIRE, "agent");
            xb_add(&bar[XB_XGEN(b.x)], 1u);
            asm volatile("s_waitcnt vmcnt(0)" ::: "memory");
        } else {
            XB_SPIN(xb_ld(&bar[XB_XGEN(b.x)]) == gen, bar);
            __builtin_amdgcn_fence(__ATOMIC_ACQUIRE, "agent");
            asm volatile("s_waitcnt vmcnt(0)" ::: "memory");
        }
    }
    __syncthreads();
}

constexpr int NWAVES = 8;
constexpr int RING_BYTES = 131072, LDS_BYTES = 151552;

__device__ __forceinline__ float wave_sum(float v) {
#pragma unroll
    for (int o = 1; o < 64; o <<= 1) v += __shfl_xor(v, o);
    return v;
}
__device__ __forceinline__ void tr_item(const float* W, int ldw, int col0, int K, bf16_t* WT, int row_off, LAS float* scr, int kb, int nb, int lane, const float* gs) {
    const int k0 = 64 * kb, n0 = 32 * nb;
    float wv[32];
#pragma unroll
    for (int i = 0; i < 32; ++i) { const int kk = 2 * i + (lane >> 5); wv[i] = W[(size_t)(k0 + kk) * ldw + col0 + n0 + (lane & 31)]; }
    if (gs) {
#pragma unroll
        for (int i = 0; i < 32; ++i) wv[i] *= gs[k0 + 2 * i + (lane >> 5)];
    }
#pragma unroll
    for (int i = 0; i < 32; ++i) { const int kk = 2 * i + (lane >> 5); scr[kk * 33 + (lane & 31)] = wv[i]; }
    asm volatile("s_waitcnt lgkmcnt(0)" ::: "memory");
    const int c = lane & 7;
#pragma unroll
    for (int j = 0; j < 4; ++j) { const int n = (lane >> 3) + 8 * j; const LAS float* s = scr + (8 * c) * 33 + n;
        u32x4 o; o.x = cvt_pk_bf16(s[0 * 33], s[1 * 33]); o.y = cvt_pk_bf16(s[2 * 33], s[3 * 33]); o.z = cvt_pk_bf16(s[4 * 33], s[5 * 33]); o.w = cvt_pk_bf16(s[6 * 33], s[7 * 33]);
        *(u32x4*)(WT + (size_t)(row_off + n0 + n) * K + k0 + 8 * c) = o; }
    asm volatile("s_waitcnt lgkmcnt(0)" ::: "memory");
}

struct Args { const float* in[16]; float* out; unsigned char* ws; int ph_lo, ph_hi; };

__global__ void __launch_bounds__(NWAVES * 64, 2) fwd_megakernel(Args args) {
    __builtin_assume(__builtin_amdgcn_workitem_id_y() == 0); __builtin_assume(__builtin_amdgcn_workitem_id_z() == 0);
    extern __shared__ __attribute__((aligned(16))) unsigned char lds_raw[];
    LAS unsigned char* lds = (LAS unsigned char*)lds_raw;
    const int tid = threadIdx.x, lane = tid & 63, wave = __builtin_amdgcn_readfirstlane(tid >> 6);
    const int G = gridDim.x, bx = blockIdx.x, vcu = (G % 8 == 0) ? (bx % 8) * (G / 8) + bx / 8 : bx;
    const int gw = vcu * NWAVES + wave, NGW = G * NWAVES;
    unsigned char* ws = args.ws;
    const float* x = args.in[0]; const float* p_in = args.in[1]; const float* g_mix = args.in[2]; const float* w_in = args.in[3]; const float* b_forget = args.in[4]; const float* b_gate = args.in[5];
    const float* w_bf = args.in[6]; const float* w_bs = args.in[7]; const float* w_out = args.in[8]; const float* g_mlp = args.in[9]; const float* w_up = args.in[10]; const float* w_dn = args.in[11];
    const float* g_ple = args.in[12]; const float* w_pg = args.in[13]; const float* w_ple = args.in[14]; const float* g_final = args.in[15];
    float* out = args.out;
    bf16_t* Win_t = (bf16_t*)(ws + WS_WIN); bf16_t* Wbf_t = (bf16_t*)(ws + WS_WBF); bf16_t* Wbs_t = (bf16_t*)(ws + WS_WBS); bf16_t* Wout_t = (bf16_t*)(ws + WS_WOUT);
    bf16_t* Wup_t = (bf16_t*)(ws + WS_WUP); bf16_t* Wdn_t = (bf16_t*)(ws + WS_WDN); bf16_t* Wpg_t = (bf16_t*)(ws + WS_WPG); bf16_t* Wple_t = (bf16_t*)(ws + WS_WPLE);
    float* LOGF = (float*)(ws + WS_LOGF); float* CC = (float*)(ws + WS_CC); float* SSQ1 = (float*)(ws + WS_SSQ1); float* SSQ2 = (float*)(ws + WS_SSQ2);
    bf16_t* PB = (bf16_t*)(ws + WS_PB); bf16_t* BUFA = (bf16_t*)(ws + WS_BUFA); bf16_t* BUFB = (bf16_t*)(ws + WS_BUFB); bf16_t* QKV = (bf16_t*)(ws + WS_QKV); bf16_t* SG = (bf16_t*)(ws + WS_SG);
    bf16_t* HB = (bf16_t*)(ws + WS_H); bf16_t* EB = (bf16_t*)(ws + WS_E);
    const int lo = args.ph_lo, hi = args.ph_hi;
#define IN(k) (lo <= (k) && (k) < hi)
    volatile LAS unsigned* bst = (volatile LAS unsigned*)(lds + LDS_BYTES - 64);
    if (tid < 2) bst[tid] = 0u;
    __syncthreads();
    XcdBarrier xbar; xbar.bar = (unsigned*)ws; xbar.x = 0; xbar.st = bst;
    if (hi - lo > 1) xbar = xcd_barrier_post((unsigned*)ws, bst);
#define SEAM(k) do { if (IN(k) && IN((k) + 1)) { if (hi > N_PHASES) cg::this_grid().sync(); else xcd_barrier(xbar); } } while (0)

    if (IN(0)) {
        LAS float* scr = (LAS float*)(lds + wave * 8448);
        LAS f32x4* wtab = (LAS f32x4*)(lds + 69632);
        {
            constexpr int NSEG = 9;
            int base = 0;
            for (int it = gw; ; it += NGW) {
                int r = it; const float* W; int ldw, col0, K, nblk, row_off; bf16_t* WT; const float* gs = nullptr;
                if (r < 16 * 48) { W = w_in; ldw = NIN_SRC; col0 = 0; K = DM; nblk = 48; WT = Win_t; row_off = 0; }
                else if ((r -= 16 * 48) < 16 * 112) { W = w_in; ldw = NIN_SRC; col0 = 1544; K = DM; nblk = 112; WT = Win_t; row_off = 1536; }
                else if ((r -= 16 * 112) < 8 * 32) { W = w_bf; ldw = DM; col0 = 0; K = 512; nblk = 32; WT = Wbf_t; row_off = 0; }
                else if ((r -= 8 * 32) < 8 * 32) { W = w_bs; ldw = DM; col0 = 0; K = 512; nblk = 32; WT = Wbs_t; row_off = 0; }
                else if ((r -= 8 * 32) < 16 * 32) { W = w_out; ldw = DM; col0 = 0; K = DM; nblk = 32; WT = Wout_t; row_off = 0; }
                else if ((r -= 16 * 32) < 16 * 128) { W = w_up; ldw = DFF; col0 = 0; K = DM; nblk = 128; WT = Wup_t; row_off = 0; gs = g_mlp; }
                else if ((r -= 16 * 128) < 64 * 32) { W = w_dn; ldw = DM; col0 = 0; K = DFF; nblk = 32; WT = Wdn_t; row_off = 0; }
                else if ((r -= 64 * 32) < 16 * 32) { W = w_pg; ldw = DM; col0 = 0; K = DM; nblk = 32; WT = Wpg_t; row_off = 0; gs = g_ple; }
                else if ((r -= 16 * 32) < 4 * 32) { W = w_ple; ldw = DM; col0 = 0; K = DPLE; nblk = 32; WT = Wple_t; row_off = 0; }
                else break;
                tr_item(W, ldw, col0, K, WT, row_off, scr, r / nblk, r % nblk, lane, gs);
                (void)base; (void)NSEG;
            }
        }
        {
            f32x4 gm[4];
#pragma unroll
            for (int j = 0; j < 4; ++j) gm[j] = *((const f32x4*)g_mix + lane + 64 * j);
#pragma unroll
            for (int q = 0; q < 2; ++q) { const int k = tid + 512 * q; const float gk = g_mix[k]; const float* wp = w_in + (size_t)k * NIN_SRC + 1536;
                const int ln = (k & 255) >> 2, e = k & 3, j = k >> 8;
                wtab[((j * 4 + e) * 2 + 0) * 64 + ln] = *(const f32x4*)wp * gk; wtab[((j * 4 + e) * 2 + 1) * 64 + ln] = *(const f32x4*)(wp + 4) * gk; }
            __syncthreads();
            const float bfv = b_forget[lane & 7];
            for (int m0 = gw; m0 < M; m0 += 2 * NGW) {
                f32x4 va[2][4];
#pragma unroll
                for (int q = 0; q < 2; ++q)
#pragma unroll
                    for (int j = 0; j < 4; ++j) va[q][j] = *((const f32x4*)(x + (size_t)(m0 + q * NGW) * DM) + lane + 64 * j);
#pragma unroll
                for (int q = 0; q < 2; ++q) {
                    const int m = m0 + q * NGW;
                    f32x4 v[4]; float s = 0.f;
#pragma unroll
                    for (int j = 0; j < 4; ++j) { v[j] = va[q][j]; s += (v[j][0] * v[j][0] + v[j][1] * v[j][1]) + (v[j][2] * v[j][2] + v[j][3] * v[j][3]); }
                    const float rstd = __builtin_amdgcn_rsqf(wave_sum(s) * (1.0f / DM) + EPS);
                    f32x4 f0 = {0.f, 0.f, 0.f, 0.f}, f1 = {0.f, 0.f, 0.f, 0.f};
#pragma unroll
                    for (int j = 0; j < 4; ++j)
#pragma unroll
                        for (int e = 0; e < 4; ++e) { f0 += wtab[((j * 4 + e) * 2 + 0) * 64 + lane] * v[j][e]; f1 += wtab[((j * 4 + e) * 2 + 1) * 64 + lane] * v[j][e]; }
                    unsigned long long* o8 = (unsigned long long*)(BUFA + (size_t)m * DM) + lane;
#pragma unroll
                    for (int j = 0; j < 4; ++j) { const f32x4 y = v[j] * gm[j] * rstd; o8[64 * j] = (unsigned long long)cvt_pk_bf16(y[0], y[1]) | ((unsigned long long)cvt_pk_bf16(y[2], y[3]) << 32); }
                    float fl[8];
#pragma unroll
                    for (int e = 0; e < 4; ++e) { fl[e] = wave_sum(f0[e]); fl[4 + e] = wave_sum(f1[e]); }
                    float mine = fl[0];
#pragma unroll
                    for (int e = 1; e < 8; ++e) mine = ((lane & 7) == e) ? fl[e] : mine;
                    const float y2 = (mine * rstd + bfv) * LOG2E;
                    const float lf = -(fmaxf(-y2, 0.f) + __builtin_amdgcn_logf(1.0f + __builtin_amdgcn_exp2f(-fabsf(y2))));
                    if (lane < 8) LOGF[(size_t)((m / SEQ) * NH + lane) * SEQ + (m % SEQ)] = lf;
                }
            }
        }
        {
            const size_t n8 = (size_t)M * DPLE / 8;
            for (size_t i = (size_t)bx * 512 + tid; i < n8; i += (size_t)G * 512) { const f32x4 a = *((const f32x4*)p_in + 2 * i), c = *((const f32x4*)p_in + 2 * i + 1);
                u32x4 w; w.x = cvt_pk_bf16(a[0], a[1]); w.y = cvt_pk_bf16(a[2], a[3]); w.z = cvt_pk_bf16(c[0], c[1]); w.w = cvt_pk_bf16(c[2], c[3]); *((u32x4*)PB + i) = w; }
        }
    }
    SEAM(0);

    if (IN(1)) {
        if (gw < BATCH * NH) {
            const float* src = LOGF + (size_t)gw * SEQ + lane * 32; float* dst = CC + (size_t)gw * SEQ + lane * 32;
            f32x4 v[8]; float run = 0.f;
#pragma unroll
            for (int j = 0; j < 8; ++j) { v[j] = *((const f32x4*)src + j);
#pragma unroll
                for (int e = 0; e < 4; ++e) { run += v[j][e]; v[j][e] = run; } }
            float incl = run;
#pragma unroll
            for (int o = 1; o < 64; o <<= 1) { const float tv = __shfl_up(incl, o); if (lane >= o) incl += tv; }
            const float excl = incl - run;
#pragma unroll
            for (int j = 0; j < 8; ++j) *((f32x4*)dst + j) = v[j] + excl;
        }
        pg8::Gemm g{DM, DM, DM};
        pg8::PlainSched S; S.T.init(M, NIN, G, bx); S.A = (const char*)BUFA; S.B = (const char*)Win_t; S.astep = (size_t)256 * DM * 2; S.bstep = (size_t)256 * DM * 2;
        pg8::EpiQKVG E{QKV, SG, b_gate};
        pg8::gemm_phase<pg8::EpiQKVG, pg8::PlainSched>(lds, g, S, E);
    }
    SEAM(1);

    if (IN(2)) {
        const int bh = vcu >> 1;
#define ATT_UNIT(i) att::AU{bh / NH, bh % NH, (((i) & 1) ? 7 - ((vcu & 1) * 2 + (((i) & 3) >> 1)) : ((vcu & 1) * 2 + (((i) & 3) >> 1))), (i) >> 2}
        if (bh < BATCH * NH) {
            bf16x8 qr[4]; f32x16 o[2]; float inv = 1.0f; f32x4 c4 = {0.f, 0.f, 0.f, 0.f}; float cref = 0.f;
            att::AU cur = ATT_UNIT(0);
            att::unit_prologue(cur, QKV, CC, lds, qr, c4, cref);
            att::unit_prologue_finish(cur, lds, qr, c4, cref, 0);
            for (int i = 0; i < 8; ++i) {
                if (cur.kind == 0) att::fox_loop(cur, QKV, lds, qr, i & 1, o, inv); else { att::sb_loop(cur, QKV, lds, qr, o); inv = 1.0f; }
                const att::AU nxt = ATT_UNIT(i + 1);
                if (i < 7) att::unit_prologue(nxt, QKV, CC, lds, qr, c4, cref);
                att::unit_epilogue(cur, BUFB, lds, o, inv);
                if (i < 7) att::unit_prologue_finish(nxt, lds, qr, c4, cref, (i + 1) & 1);
                cur = nxt;
            }
        }
#undef ATT_UNIT
    }
    SEAM(2);

    if (IN(3)) {
        pg8::Gemm g{DM, 512, 512};
        pg8::PairSched S; S.T.init(M, DM, G, bx); S.A0 = (const char*)BUFB; S.A1 = (const char*)(BUFB + 512); S.B0 = (const char*)Wbf_t; S.B1 = (const char*)Wbs_t; S.astep = (size_t)256 * DM * 2; S.bstep = (size_t)256 * 512 * 2;
        pg8::EpiBranch E{SG, BUFA};
        pg8::gemm_phase<pg8::EpiBranch, pg8::PairSched>(lds, g, S, E);
    }
    SEAM(3);

    if (IN(4)) {
        {
            pg8::Gemm g{DM, DM, DM};
            pg8::PlainSched S; S.T.init(M, DM, G, bx); S.A = (const char*)BUFA; S.B = (const char*)Wout_t; S.astep = (size_t)256 * DM * 2; S.bstep = (size_t)256 * DM * 2;
            pg8::EpiRes4 E{x, BUFB, SSQ1};
            pg8::gemm_phase<pg8::EpiRes4, pg8::PlainSched>(lds, g, S, E);
        }
        {
            pg8::Gemm g{DPLE, DPLE, DPLE};
            pg8::PlainSched S; S.T.init(M, DM, G, bx); S.A = (const char*)PB; S.B = (const char*)Wple_t; S.astep = (size_t)256 * DPLE * 2; S.bstep = (size_t)256 * DPLE * 2;
            pg8::EpiBf16 E{EB, DM};
            pg8::gemm_phase<pg8::EpiBf16, pg8::PlainSched>(lds, g, S, E);
        }
    }
    SEAM(4);

    if (IN(5)) {
        pg8::Gemm g{DM, DM, DM};
        pg8::PlainSched S; S.T.init(M, DFF, G, bx); S.A = (const char*)BUFB; S.B = (const char*)Wup_t; S.astep = (size_t)256 * DM * 2; S.bstep = (size_t)256 * DM * 2;
        pg8::EpiUp E{HB, SSQ1};
        pg8::gemm_phase<pg8::EpiUp, pg8::PlainSched>(lds, g, S, E);
    }
    SEAM(5);

    if (IN(6)) {
        pg8::Gemm g{DFF, DFF, DFF};
        pg8::PlainSched S; S.T.init(M, DM, G, bx); S.A = (const char*)HB; S.B = (const char*)Wdn_t; S.astep = (size_t)256 * DFF * 2; S.bstep = (size_t)256 * DFF * 2;
        pg8::EpiRes6 E{BUFB, BUFA, SSQ2};
        pg8::gemm_phase<pg8::EpiRes6, pg8::PlainSched>(lds, g, S, E);
    }
    SEAM(6);

    if (IN(7)) {
        pg8::Gemm g{DM, DM, DM};
        pg8::PlainSched S; S.T.init(M, DM, G, bx); S.A = (const char*)BUFA; S.B = (const char*)Wpg_t; S.astep = (size_t)256 * DM * 2; S.bstep = (size_t)256 * DM * 2;
        pg8::EpiPle E{BUFA, BUFB, EB, SSQ2};
        pg8::gemm_phase<pg8::EpiPle, pg8::PlainSched>(lds, g, S, E);
    }
    SEAM(7);

    if (IN(8)) {
        f32x4 gf[4];
#pragma unroll
        for (int j = 0; j < 2; ++j) { gf[2 * j] = *((const f32x4*)g_final + 2 * lane + 128 * j); gf[2 * j + 1] = *((const f32x4*)g_final + 2 * lane + 128 * j + 1); }
        for (int m = gw; m < M; m += 2 * NGW) {
            u32x4 w[2][2];
#pragma unroll
            for (int q = 0; q < 2; ++q)
#pragma unroll
                for (int j = 0; j < 2; ++j) w[q][j] = *((const u32x4*)(BUFB + (size_t)(m + q * NGW) * DM) + lane + 64 * j);
#pragma unroll
            for (int q = 0; q < 2; ++q) {
                f32x4 v[4]; float s = 0.f;
#pragma unroll
                for (int j = 0; j < 2; ++j) { v[2 * j] = pg8::bf4_lo(w[q][j]); v[2 * j + 1] = pg8::bf4_hi(w[q][j]); }
#pragma unroll
                for (int j = 0; j < 4; ++j) s += (v[j][0] * v[j][0] + v[j][1] * v[j][1]) + (v[j][2] * v[j][2] + v[j][3] * v[j][3]);
                const float rstd = __builtin_amdgcn_rsqf(wave_sum(s) * (1.0f / DM) + EPS);
                f32x4* orow = (f32x4*)(out + (size_t)(m + q * NGW) * DM);
#pragma unroll
                for (int j = 0; j < 2; ++j) { orow[2 * lane + 128 * j] = v[2 * j] * gf[2 * j] * rstd; orow[2 * lane + 128 * j + 1] = v[2 * j + 1] * gf[2 * j + 1] * rstd; }
            }
        }
    }
#undef IN
#undef SEAM
}

extern "C" void kernel_launch(void* const* d_in, const int* in_sizes, int n_in, void* d_out, int out_size, void* d_ws, size_t ws_size, hipStream_t stream) {
    static int grid = 0;
    if (grid == 0) {
        if (n_in != 16 || in_sizes[0] != M * DM || out_size != M * DM || ws_size < WS_END) { fprintf(stderr, "kernel_launch: unexpected shapes (n_in %d, in0 %d, out %d, ws %zu); nothing launched\n", n_in, n_in > 0 ? in_sizes[0] : -1, out_size, ws_size); grid = -1; return; }
        int dev = 0, cus = 0, per_cu = 0;
        if (hipGetDevice(&dev) != hipSuccess || hipDeviceGetAttribute(&cus, hipDeviceAttributeMultiprocessorCount, dev) != hipSuccess) { grid = -1; return; }
        if (hipFuncSetAttribute((const void*)fwd_megakernel, hipFuncAttributeMaxDynamicSharedMemorySize, LDS_BYTES) != hipSuccess) { fprintf(stderr, "kernel_launch: hipFuncSetAttribute failed\n"); grid = -1; return; }
        if (hipOccupancyMaxActiveBlocksPerMultiprocessor(&per_cu, (const void*)fwd_megakernel, NWAVES * 64, LDS_BYTES) != hipSuccess || per_cu < 1) { fprintf(stderr, "kernel_launch: occupancy query says %d\n", per_cu); per_cu = 1; }
        (void)hipGetLastError();
        grid = cus;
        if (grid != 256) fprintf(stderr, "kernel_launch: %d CUs; built for 256\n", grid);
    }
    if (grid < 0) return;
    if (hipMemsetAsync(d_ws, 0, 16384, stream) != hipSuccess) { fprintf(stderr, "kernel_launch: memset failed\n"); return; }
    Args a{};
    for (int i = 0; i < 16; ++i) a.in[i] = (const float*)d_in[i];
    a.out = (float*)d_out; a.ws = (unsigned char*)d_ws;
#if MK_N_LAUNCHES == 1
    a.ph_lo = 0; a.ph_hi = N_PHASES;
    void* kargs[] = {&a};
    hipError_t e = hipLaunchCooperativeKernel((const void*)fwd_megakernel, dim3(grid), dim3(NWAVES * 64), kargs, LDS_BYTES, stream);
    if (e != hipSuccess) fprintf(stderr, "kernel_launch: cooperative launch failed: %s (grid %d)\n", hipGetErrorString(e), grid);
#else
    for (int li = 0; li < N_PHASES; ++li) { a.ph_lo = li; a.ph_hi = li + 1; hipLaunchKernelGGL(fwd_megakernel, dim3(grid), dim3(NWAVES * 64), LDS_BYTES, stream, a); }
#endif
}
```

```cpp
#include <hip/hip_runtime.h>
#include <hip/hip_cooperative_groups.h>
#include <cstdio>
#include <cstdint>
namespace cg = cooperative_groups;

#ifndef MK_N_LAUNCHES
#define MK_N_LAUNCHES 1
#endif
constexpr int N_PHASES = 9;

#define LAS __attribute__((address_space(3)))
typedef unsigned short bf16_t;
typedef short bf16x8 __attribute__((ext_vector_type(8)));
typedef short s16x4 __attribute__((ext_vector_type(4)));
typedef float f32x4 __attribute__((ext_vector_type(4)));
typedef float f32x2 __attribute__((ext_vector_type(2)));
typedef float f32x16 __attribute__((ext_vector_type(16)));
typedef unsigned u32x4 __attribute__((ext_vector_type(4)));
typedef unsigned u32x2 __attribute__((ext_vector_type(2)));
typedef __bf16 bf16x2_t __attribute__((ext_vector_type(2)));

constexpr int BATCH = 16, SEQ = 2048, DM = 1024, M = BATCH * SEQ, NH = 8, HD = 64, DFF = 4096, DPLE = 256;
constexpr int NIN_SRC = 5128, NQKV = 3072, NGATE = 2048, NIN = NQKV + NGATE;
constexpr float EPS = 1e-6f;
constexpr float LOG2E = 1.4426950408889634f;
constexpr float C2 = 0.125f * LOG2E;

constexpr size_t MiB = 1u << 20;
constexpr size_t WS_WIN = 2 * MiB, WS_WBF = 12 * MiB, WS_WBS = 13 * MiB, WS_WOUT = 14 * MiB, WS_WUP = 16 * MiB, WS_WDN = 24 * MiB, WS_WPG = 32 * MiB, WS_WPLE = 34 * MiB;
constexpr size_t WS_LOGF = 36 * MiB, WS_CC = 37 * MiB, WS_SSQ1 = 38 * MiB, WS_SSQ2 = 40 * MiB;
constexpr size_t WS_PB = 42 * MiB, WS_BUFA = 58 * MiB, WS_BUFB = 122 * MiB, WS_QKV = 186 * MiB, WS_SG = 378 * MiB, WS_H = 186 * MiB, WS_E = 442 * MiB, WS_END = 506 * MiB;

__device__ __forceinline__ unsigned cvt_pk_bf16(float lo, float hi) { f32x2 v = {lo, hi}; bf16x2_t b = __builtin_convertvector(v, bf16x2_t); return __builtin_bit_cast(unsigned, b); }
__device__ __forceinline__ float bf_lo(unsigned w) { return __uint_as_float(w << 16); }
__device__ __forceinline__ float bf_hi(unsigned w) { return __uint_as_float(w & 0xffff0000u); }
__device__ __forceinline__ float fast_sigmoid(float v) { return __builtin_amdgcn_rcpf(1.0f + __builtin_amdgcn_exp2f(-v * LOG2E)); }

__device__ __forceinline__ const char* uni_ptr(const char* p) { const unsigned long long v = (unsigned long long)p; const unsigned lo = __builtin_amdgcn_readfirstlane((unsigned)v), hi = __builtin_amdgcn_readfirstlane((unsigned)(v >> 32)); return (const char*)(((unsigned long long)hi << 32) | lo); }
namespace pg8 {
constexpr int BM = 256, BK = 64, HALF = 128, HTB = HALF * BK * 2, STAGE_BYTES = 8 * HTB, NXCD = 8, WGM = 8;
__host__ __device__ __forceinline__ int lds_byte(int r, int c) { const int st = (r >> 4) * 2 + (c >> 5), rr = r & 15, cc = c & 31, ob = rr * 64 + cc * 2; return st * 1024 + (ob ^ (((ob >> 9) & 1) << 5)); }
__host__ __device__ __forceinline__ void stage_rc(int b, int& R, int& C) { const int st = b / 1024, sb = b % 1024, swz = sb ^ (((sb >> 9) & 1) << 5); R = (st >> 1) * 16 + swz / 64; C = (st & 1) * 32 + (swz % 64) / 2; }
__host__ __device__ __forceinline__ int perm32(int rho) { const int n = rho >> 4, i = rho & 15; return 8 * (i >> 2) + 4 * n + (i & 3); }

struct Unit { int pm, pn; const char* A; const char* B; int chain; };
struct Gemm { int lda, ldb, K; };

struct TileOrder {
    int nM, nN, nwg, G, c;
    __device__ void init(int Mrows, int N, int G_, int c_) { nM = Mrows / BM; nN = N / BM; nwg = nM * nN; G = G_; c = c_; }
    __device__ bool tile(int i, int& pm, int& pn) const {
        const long L = (long)i * G + c; if (L >= nwg) return false;
        int wgid = (int)L; { const int q = nwg / NXCD, r = nwg % NXCD, xcd = wgid % NXCD, off = wgid / NXCD; wgid = (xcd < r ? xcd * (q + 1) : r * (q + 1) + (xcd - r) * q) + off; }
        const int nig = WGM * nN, gid = wgid / nig, fm = gid * WGM, gsz = (nM - fm) < WGM ? (nM - fm) : WGM;
        pm = fm + ((wgid % nig) % gsz); pn = (wgid % nig) / gsz; return true;
    }
};
struct PlainSched {
    TileOrder T; const char* A; const char* B; size_t astep, bstep;
    __device__ bool next(int i, Unit& u) const { int pm, pn; if (!T.tile(i, pm, pn)) return false; u.pm = pm; u.pn = pn; u.A = A + (size_t)pm * astep; u.B = B + (size_t)pn * bstep; u.chain = 0; return true; }
};
struct PairSched {
    TileOrder T; const char* A0; const char* A1; const char* B0; const char* B1; size_t astep, bstep;
    __device__ bool next(int i, Unit& u) const { int pm, pn; if (!T.tile(i >> 1, pm, pn)) return false; const int s = i & 1; u.pm = pm; u.pn = pn;
        u.A = (s ? A1 : A0) + (size_t)pm * astep; u.B = (s ? B1 : B0) + (size_t)pn * bstep; u.chain = s ? 0 : 1; return true; }
};

typedef f32x4 Acc[2][2][4][2];

struct EpiQKVG {
    static constexpr bool PERM = true, PREF = false;
    bf16_t* QKV; bf16_t* SG; const float* bgate;
    __device__ __forceinline__ void operator()(Acc& acc, const Unit& u, int wr, int wc, int fr, int fq, LAS float* tab, int tid) const {
        const int row0 = u.pm * BM + wr * 64 + fr;
        if (u.pn < 12) {
            const float sc = (u.pn < 2 || (u.pn >= 6 && u.pn < 8)) ? C2 : 1.0f;
            const int col0 = u.pn * BM + wc * 32 + 8 * fq;
#pragma unroll
            for (int ai = 0; ai < 2; ++ai)
#pragma unroll
                for (int m = 0; m < 4; ++m) { bf16_t* rowp = QKV + (size_t)(row0 + ai * HALF + m * 16) * NQKV + col0;
#pragma unroll
                    for (int bj = 0; bj < 2; ++bj) { const f32x4 v0 = acc[ai][bj][m][0] * sc, v1 = acc[ai][bj][m][1] * sc;
                        u32x4 w; w.x = cvt_pk_bf16(v0[0], v0[1]); w.y = cvt_pk_bf16(v0[2], v0[3]); w.z = cvt_pk_bf16(v1[0], v1[1]); w.w = cvt_pk_bf16(v1[2], v1[3]);
                        *(u32x4*)(rowp + bj * HALF) = w; } }
        } else {
            const int col0 = (u.pn - 12) * BM + wc * 32 + 8 * fq;
            f32x4 bv[2][2];
#pragma unroll
            for (int bj = 0; bj < 2; ++bj)
#pragma unroll
                for (int n = 0; n < 2; ++n) bv[bj][n] = *(const f32x4*)(bgate + col0 + bj * HALF + 4 * n);
#pragma unroll
            for (int ai = 0; ai < 2; ++ai)
#pragma unroll
                for (int m = 0; m < 4; ++m) { bf16_t* rowp = SG + (size_t)(row0 + ai * HALF + m * 16) * NGATE + col0;
#pragma unroll
                    for (int bj = 0; bj < 2; ++bj) { const f32x4 a0 = acc[ai][bj][m][0] + bv[bj][0], a1 = acc[ai][bj][m][1] + bv[bj][1];
                        u32x4 w; w.x = cvt_pk_bf16(fast_sigmoid(a0[0]), fast_sigmoid(a0[1])); w.y = cvt_pk_bf16(fast_sigmoid(a0[2]), fast_sigmoid(a0[3]));
                        w.z = cvt_pk_bf16(fast_sigmoid(a1[0]), fast_sigmoid(a1[1])); w.w = cvt_pk_bf16(fast_sigmoid(a1[2]), fast_sigmoid(a1[3]));
                        *(u32x4*)(rowp + bj * HALF) = w; } }
        }
    }
};
struct EpiBf16 {
    static constexpr bool PERM = true, PREF = false;
    bf16_t* O; int ldc;
    __device__ __forceinline__ void operator()(Acc& acc, const Unit& u, int wr, int wc, int fr, int fq, LAS float* tab, int tid) const {
        const int row0 = u.pm * BM + wr * 64 + fr, col0 = u.pn * BM + wc * 32 + 8 * fq;
#pragma unroll
        for (int ai = 0; ai < 2; ++ai)
#pragma unroll
            for (int m = 0; m < 4; ++m) { bf16_t* rowp = O + (size_t)(row0 + ai * HALF + m * 16) * ldc + col0;
#pragma unroll
                for (int bj = 0; bj < 2; ++bj) { const f32x4 v0 = acc[ai][bj][m][0], v1 = acc[ai][bj][m][1];
                    u32x4 w; w.x = cvt_pk_bf16(v0[0], v0[1]); w.y = cvt_pk_bf16(v0[2], v0[3]); w.z = cvt_pk_bf16(v1[0], v1[1]); w.w = cvt_pk_bf16(v1[2], v1[3]);
                    *(u32x4*)(rowp + bj * HALF) = w; } }
    }
};
__device__ __forceinline__ f32x4 bf4_lo(const u32x4 w) { return (f32x4){bf_lo(w.x), bf_hi(w.x), bf_lo(w.y), bf_hi(w.y)}; }
__device__ __forceinline__ f32x4 bf4_hi(const u32x4 w) { return (f32x4){bf_lo(w.z), bf_hi(w.z), bf_lo(w.w), bf_hi(w.w)}; }
__device__ __forceinline__ u32x4 pack8(const f32x4 v0, const f32x4 v1) { u32x4 w; w.x = cvt_pk_bf16(v0[0], v0[1]); w.y = cvt_pk_bf16(v0[2], v0[3]); w.z = cvt_pk_bf16(v1[0], v1[1]); w.w = cvt_pk_bf16(v1[2], v1[3]); return w; }
struct EpiBranch {
    static constexpr bool PERM = true, PREF = false;
    const bf16_t* SG; bf16_t* MG;
    __device__ __forceinline__ void operator()(Acc& acc, const Unit& u, int wr, int wc, int fr, int fq, LAS float* tab, int tid) const {
        const int row0 = u.pm * BM + wr * 64 + fr, col0 = u.pn * BM + wc * 32 + 8 * fq;
#pragma unroll
        for (int ai = 0; ai < 2; ++ai) {
            u32x4 ga[4][2], gb[4][2];
#pragma unroll
            for (int m = 0; m < 4; ++m)
#pragma unroll
                for (int bj = 0; bj < 2; ++bj) { const bf16_t* p = SG + (size_t)(row0 + ai * HALF + m * 16) * NGATE + col0 + bj * HALF; gb[m][bj] = *(const u32x4*)(p + DM); if (u.chain) ga[m][bj] = *(const u32x4*)p; }
#pragma unroll
            for (int m = 0; m < 4; ++m)
#pragma unroll
                for (int bj = 0; bj < 2; ++bj) { const f32x4 b0 = bf4_lo(gb[m][bj]), b1 = bf4_hi(gb[m][bj]);
                    if (u.chain) { const f32x4 a0 = bf4_lo(ga[m][bj]), a1 = bf4_hi(ga[m][bj]);
#pragma unroll
                        for (int e = 0; e < 4; ++e) { acc[ai][bj][m][0][e] *= a0[e] * __builtin_amdgcn_rcpf(fmaxf(b0[e], 1e-30f)); acc[ai][bj][m][1][e] *= a1[e] * __builtin_amdgcn_rcpf(fmaxf(b1[e], 1e-30f)); }
                    } else *(u32x4*)(MG + (size_t)(row0 + ai * HALF + m * 16) * DM + col0 + bj * HALF) = pack8(acc[ai][bj][m][0] * b0, acc[ai][bj][m][1] * b1); }
            asm volatile("" ::: "memory");
        }
    }
};
__device__ __forceinline__ void ssq_publish(LAS float* tab, float* ssq, const Unit& u, int tid) {
    asm volatile("s_waitcnt lgkmcnt(0)" ::: "memory"); __builtin_amdgcn_s_barrier(); asm volatile("" ::: "memory");
    if (tid < 256) { const f32x4 t = *(const LAS f32x4*)(tab + tid * 4); ssq[(size_t)(u.pm * BM + tid) * 4 + u.pn] = (t[0] + t[1]) + (t[2] + t[3]); }
}
struct EpiRes4 {
    static constexpr bool PERM = true, PREF = false;
    const float* base; bf16_t* xb; float* ssq;
    __device__ __forceinline__ void operator()(Acc& acc, const Unit& u, int wr, int wc, int fr, int fq, LAS float* tab, int tid) const {
        const int row0 = u.pm * BM + wr * 64 + fr, col0 = u.pn * BM + wc * 32 + 8 * fq;
#pragma unroll
        for (int ai = 0; ai < 2; ++ai) {
            f32x4 bs[4][2][2];
#pragma unroll
            for (int m = 0; m < 4; ++m)
#pragma unroll
                for (int bj = 0; bj < 2; ++bj)
#pragma unroll
                    for (int n = 0; n < 2; ++n) bs[m][bj][n] = *(const f32x4*)(base + (size_t)(row0 + ai * HALF + m * 16) * DM + col0 + bj * HALF + 4 * n);
#pragma unroll
            for (int m = 0; m < 4; ++m) { float s = 0.f;
#pragma unroll
                for (int bj = 0; bj < 2; ++bj) { const f32x4 x0 = bs[m][bj][0] + acc[ai][bj][m][0], x1 = bs[m][bj][1] + acc[ai][bj][m][1];
                    s += ((x0[0] * x0[0] + x0[1] * x0[1]) + (x0[2] * x0[2] + x0[3] * x0[3])) + ((x1[0] * x1[0] + x1[1] * x1[1]) + (x1[2] * x1[2] + x1[3] * x1[3]));
                    *(u32x4*)(xb + (size_t)(row0 + ai * HALF + m * 16) * DM + col0 + bj * HALF) = pack8(x0, x1); }
                s += __shfl_xor(s, 16); s += __shfl_xor(s, 32);
                if (fq == 0) tab[(ai * HALF + wr * 64 + m * 16 + fr) * 4 + wc] = s; }
            asm volatile("" ::: "memory");
        }
        ssq_publish(tab, ssq, u, tid);
    }
};
struct EpiRes6 {
    static constexpr bool PERM = true, PREF = false;
    const bf16_t* xin; bf16_t* xb; float* ssq;
    __device__ __forceinline__ void operator()(Acc& acc, const Unit& u, int wr, int wc, int fr, int fq, LAS float* tab, int tid) const {
        const int row0 = u.pm * BM + wr * 64 + fr, col0 = u.pn * BM + wc * 32 + 8 * fq;
        u32x4 xi[2][4][2];
#pragma unroll
        for (int ai = 0; ai < 2; ++ai)
#pragma unroll
            for (int m = 0; m < 4; ++m)
#pragma unroll
                for (int bj = 0; bj < 2; ++bj) xi[ai][m][bj] = *(const u32x4*)(xin + (size_t)(row0 + ai * HALF + m * 16) * DM + col0 + bj * HALF);
#pragma unroll
        for (int ai = 0; ai < 2; ++ai)
#pragma unroll
            for (int m = 0; m < 4; ++m) { float s = 0.f;
#pragma unroll
                for (int bj = 0; bj < 2; ++bj) { const f32x4 x0 = bf4_lo(xi[ai][m][bj]) + acc[ai][bj][m][0], x1 = bf4_hi(xi[ai][m][bj]) + acc[ai][bj][m][1];
                    s += ((x0[0] * x0[0] + x0[1] * x0[1]) + (x0[2] * x0[2] + x0[3] * x0[3])) + ((x1[0] * x1[0] + x1[1] * x1[1]) + (x1[2] * x1[2] + x1[3] * x1[3]));
                    *(u32x4*)(xb + (size_t)(row0 + ai * HALF + m * 16) * DM + col0 + bj * HALF) = pack8(x0, x1); }
                s += __shfl_xor(s, 16); s += __shfl_xor(s, 32);
                if (fq == 0) tab[(ai * HALF + wr * 64 + m * 16 + fr) * 4 + wc] = s; }
        ssq_publish(tab, ssq, u, tid);
    }
};
__device__ __forceinline__ float rstd_of(const f32x4 q) { return __builtin_amdgcn_rsqf(((q[0] + q[1]) + (q[2] + q[3])) * (1.0f / DM) + EPS); }
struct EpiUp {
    static constexpr bool PERM = true, PREF = true;
    bf16_t* H; const float* ssq;
    __device__ __forceinline__ void prefetch(const Unit& u, LAS unsigned char* tabb, int tid, int wid) const {
        if (tid < 256) __builtin_amdgcn_global_load_lds((const unsigned*)(ssq + (size_t)(u.pm * BM + tid) * 4), (LAS unsigned*)(tabb + wid * 1024), 16, 0, 0);
    }
    __device__ __forceinline__ void operator()(Acc& acc, const Unit& u, int wr, int wc, int fr, int fq, LAS float* tab, int tid) const {
        const int row0 = u.pm * BM + wr * 64 + fr, col0 = u.pn * BM + wc * 32 + 8 * fq;
        f32x4 sq[2][4];
        { const unsigned ta = (unsigned)(uintptr_t)tab + (unsigned)(wr * 64 + fr) * 16u;
#pragma unroll
          for (int ai = 0; ai < 2; ++ai)
#pragma unroll
              for (int m = 0; m < 4; ++m) asm volatile("ds_read_b128 %0, %1 offset:%c2" : "=&v"(sq[ai][m]) : "v"(ta), "i"((ai * HALF + m * 16) * 16) : "memory");
          asm volatile("s_waitcnt lgkmcnt(0)" ::: "memory"); __builtin_amdgcn_sched_barrier(0); }
#pragma unroll
        for (int ai = 0; ai < 2; ++ai)
#pragma unroll
            for (int m = 0; m < 4; ++m) { const float r = rstd_of(sq[ai][m]); bf16_t* rowp = H + (size_t)(row0 + ai * HALF + m * 16) * DFF + col0;
#pragma unroll
                for (int bj = 0; bj < 2; ++bj) { f32x4 v0 = acc[ai][bj][m][0] * r, v1 = acc[ai][bj][m][1] * r;
#pragma unroll
                    for (int e = 0; e < 4; ++e) { const float a = fmaxf(v0[e], 0.f), b = fmaxf(v1[e], 0.f); v0[e] = a * a; v1[e] = b * b; }
                    *(u32x4*)(rowp + bj * HALF) = pack8(v0, v1); } }
    }
};
struct EpiPle {
    static constexpr bool PERM = true, PREF = false;
    const bf16_t* xin; bf16_t* xb; const bf16_t* E; const float* ssq;
    __device__ __forceinline__ void operator()(Acc& acc, const Unit& u, int wr, int wc, int fr, int fq, LAS float* tab, int tid) const {
        const int row0 = u.pm * BM + wr * 64 + fr, col0 = u.pn * BM + wc * 32 + 8 * fq;
#pragma unroll
        for (int ai = 0; ai < 2; ++ai)
#pragma unroll
            for (int mh = 0; mh < 2; ++mh) {
                u32x4 xi[2][2], ei[2][2]; f32x4 sq[2];
#pragma unroll
                for (int mm = 0; mm < 2; ++mm) { const int row = row0 + ai * HALF + (2 * mh + mm) * 16; sq[mm] = *(const f32x4*)(ssq + (size_t)row * 4);
#pragma unroll
                    for (int bj = 0; bj < 2; ++bj) { const size_t off = (size_t)row * DM + col0 + bj * HALF; xi[mm][bj] = *(const u32x4*)(xin + off); ei[mm][bj] = *(const u32x4*)(E + off); } }
#pragma unroll
                for (int mm = 0; mm < 2; ++mm) { const int m = 2 * mh + mm; const float r = rstd_of(sq[mm]);
#pragma unroll
                    for (int bj = 0; bj < 2; ++bj) { const f32x4 a0 = acc[ai][bj][m][0] * r, a1 = acc[ai][bj][m][1] * r, e0 = bf4_lo(ei[mm][bj]), e1 = bf4_hi(ei[mm][bj]); f32x4 o0 = bf4_lo(xi[mm][bj]), o1 = bf4_hi(xi[mm][bj]);
#pragma unroll
                        for (int e = 0; e < 4; ++e) { o0[e] += fast_sigmoid(a0[e]) * e0[e]; o1[e] += fast_sigmoid(a1[e]) * e1[e]; }
                        *(u32x4*)(xb + (size_t)(row0 + ai * HALF + m * 16) * DM + col0 + bj * HALF) = pack8(o0, o1); } }
                asm volatile("" ::: "memory");
            }
    }
};

template <class Epi, class Sched>
__device__ __forceinline__ void gemm_phase(LAS unsigned char* lds, const Gemm g, const Sched& S, const Epi& E) {
    const int tid = threadIdx.x, wid = __builtin_amdgcn_readfirstlane(tid >> 6), lane = tid & 63, wr = wid >> 2, wc = wid & 3, fr = lane & 15, fq = lane >> 4;
    const int K = g.K, nt = K / BK;
    unsigned voffA[2], voffB[2];
#pragma unroll
    for (int i = 0; i < 2; ++i) { int R, C; stage_rc(tid * 16 + i * 8192, R, C); const int Rb = Epi::PERM ? ((R & ~31) + perm32(R & 31)) : R;
        voffA[i] = (unsigned)(R * g.lda + C) * 2u; voffB[i] = (unsigned)(Rb * g.ldb + C) * 2u; }
    const size_t kstep = (size_t)(BK * 2);
    const size_t hA = (size_t)HALF * g.lda * 2, hB = (size_t)HALF * g.ldb * 2;
    const unsigned ldsw = (unsigned)wid * 1024u;
    const int aoff = lds_byte(wr * 64 + fr, fq * 8), boff = lds_byte(wc * 32 + fr, fq * 8);
#define PG8_SA(b, h) (((b) * 2 + (h)) * HTB)
#define PG8_SB(b, h) ((4 + (b) * 2 + (h)) * HTB)
#define PG8_STAGE(bufoff, gbase, voff) do { _Pragma("unroll") for (int _i = 0; _i < 2; ++_i) \
        __builtin_amdgcn_global_load_lds((const unsigned*)((const char*)(gbase) + (voff)[_i]), (LAS unsigned*)(lds + (bufoff) + ldsw + _i * 8192), 16, 0, 0); } while (0)
#define PG8_LDA(dst, b, h) do { _Pragma("unroll") for (int m = 0; m < 4; ++m) _Pragma("unroll") for (int k = 0; k < 2; ++k) dst[m][k] = *(const LAS bf16x8*)(lds + PG8_SA(b, h) + aoff + m * 2048 + k * 1024); } while (0)
#define PG8_LDB(dst, b, h) do { _Pragma("unroll") for (int n = 0; n < 2; ++n) _Pragma("unroll") for (int k = 0; k < 2; ++k) dst[n][k] = *(const LAS bf16x8*)(lds + PG8_SB(b, h) + boff + n * 2048 + k * 1024); } while (0)
#define PG8_MMA(ai, bj, At, Bt) do { __builtin_amdgcn_s_setprio(1); _Pragma("unroll") for (int m = 0; m < 4; ++m) _Pragma("unroll") for (int n = 0; n < 2; ++n) _Pragma("unroll") for (int k = 0; k < 2; ++k) \
        acc[ai][bj][m][n] = __builtin_amdgcn_mfma_f32_16x16x32_bf16(Bt[n][k], At[m][k], acc[ai][bj][m][n], 0, 0, 0); __builtin_amdgcn_s_setprio(0); } while (0)
#define PG8_WAIT_V(n) asm volatile("s_waitcnt vmcnt(" #n ")" ::: "memory")
#define PG8_WAIT_L(n) asm volatile("s_waitcnt lgkmcnt(" #n ")" ::: "memory")
#define PG8_BAR __builtin_amdgcn_s_barrier()
#define PG8_SCHED __builtin_amdgcn_sched_barrier(0)
#define PG8_ZERO() do { _Pragma("unroll") for (int a = 0; a < 2; ++a) _Pragma("unroll") for (int b = 0; b < 2; ++b) _Pragma("unroll") for (int m = 0; m < 4; ++m) _Pragma("unroll") for (int n = 0; n < 2; ++n) acc[a][b][m][n] = (f32x4){0.f, 0.f, 0.f, 0.f}; } while (0)
    Unit cur, nxt; int ui = 0;
    if (!S.next(0, cur)) return;
    Acc acc;
    PG8_ZERO();
    bf16x8 At[4][2], B0[2][2], B1[2][2];
    const char* cA = uni_ptr(cur.A); const char* cB = uni_ptr(cur.B);
    if constexpr (Epi::PREF) E.prefetch(cur, lds + STAGE_BYTES + 64, tid, wid);
    PG8_STAGE(PG8_SB(0, 0), cB, voffB); PG8_STAGE(PG8_SB(0, 1), cB + hB, voffB); PG8_STAGE(PG8_SA(0, 0), cA, voffA); PG8_STAGE(PG8_SA(0, 1), cA + hA, voffA);
    if (wr == 1) PG8_BAR;
    PG8_WAIT_V(2); PG8_BAR;
    PG8_STAGE(PG8_SB(1, 0), cB + kstep, voffB); PG8_STAGE(PG8_SA(1, 0), cA + kstep, voffA); PG8_STAGE(PG8_SB(1, 1), cB + hB + kstep, voffB);
    PG8_WAIT_V(6); PG8_BAR;
    for (;;) {
        const bool has_next = S.next(ui + 1, nxt);
        const char* nA = uni_ptr(has_next ? nxt.A : cA); const char* nB = uni_ptr(has_next ? nxt.B : cB);
#pragma nounroll
        for (int t = 0; t < nt; t += 2) {
            const bool last = (t == nt - 2);
            const char* a1 = cA + (size_t)(t + 1) * kstep;
            const char* a2 = last ? nA : cA + (size_t)(t + 2) * kstep; const char* b2 = last ? nB : cB + (size_t)(t + 2) * kstep;
            const char* a3 = a2 + kstep; const char* b3 = b2 + kstep;
            PG8_LDB(B0, 0, 0); PG8_LDB(B1, 0, 1); PG8_SCHED; PG8_LDA(At, 0, 0); PG8_STAGE(PG8_SA(1, 1), a1 + hA, voffA);
            PG8_WAIT_V(8); PG8_WAIT_L(0); PG8_BAR; PG8_MMA(0, 0, At, B0); PG8_MMA(0, 1, At, B1); PG8_BAR; PG8_SCHED;
            PG8_LDA(At, 0, 1); PG8_STAGE(PG8_SB(0, 0), b2, voffB); PG8_STAGE(PG8_SB(0, 1), b2 + hB, voffB); PG8_STAGE(PG8_SA(0, 0), a2, voffA);
            PG8_WAIT_V(8); PG8_WAIT_L(0); PG8_BAR; PG8_MMA(1, 0, At, B0); PG8_MMA(1, 1, At, B1); PG8_BAR; PG8_SCHED;
            PG8_LDB(B0, 1, 0); PG8_LDB(B1, 1, 1); PG8_SCHED; PG8_LDA(At, 1, 0); PG8_STAGE(PG8_SA(0, 1), a2 + hA, voffA);
            PG8_WAIT_V(8); PG8_WAIT_L(0); PG8_BAR; PG8_MMA(0, 0, At, B0); PG8_MMA(0, 1, At, B1); PG8_BAR; PG8_SCHED;
            PG8_LDA(At, 1, 1); PG8_STAGE(PG8_SB(1, 0), b3, voffB); PG8_STAGE(PG8_SB(1, 1), b3 + hB, voffB); PG8_STAGE(PG8_SA(1, 0), a3, voffA);
            PG8_WAIT_V(8); PG8_WAIT_L(0); PG8_BAR; PG8_MMA(1, 0, At, B0); PG8_MMA(1, 1, At, B1); PG8_BAR; PG8_SCHED;
        }
        if (wr == 0) PG8_BAR;
        E(acc, cur, wr, wc, fr, fq, (LAS float*)(lds + STAGE_BYTES + 64 + (ui & 1) * 4096), tid);
        if (!has_next) break;
        if constexpr (Epi::PREF) E.prefetch(nxt, lds + STAGE_BYTES + 64 + ((ui + 1) & 1) * 4096, tid, wid);
        if (!cur.chain) PG8_ZERO();
        cur = nxt; cA = nA; cB = nB; ++ui;
        if (wr == 1) PG8_BAR;
    }
    PG8_WAIT_V(0);
    PG8_BAR;
#undef PG8_SA
#undef PG8_SB
#undef PG8_STAGE
#undef PG8_LDA
#undef PG8_LDB
#undef PG8_MMA
#undef PG8_WAIT_V
#undef PG8_WAIT_L
#undef PG8_BAR
#undef PG8_SCHED
#undef PG8_ZERO
}
}

namespace att {
constexpr int PITCH = NQKV, OPITCH = DM;
constexpr int SLOT = 16384, L_K = 0, L_V = 8192;
constexpr int FX_NSLOT = 4, SB_NSLOT = 7;
constexpr int L_CB = FX_NSLOT * SLOT;
constexpr int L_OST = SB_NSLOT * SLOT;
constexpr int L_FLAG = 147456 + 64, L_WS = 147456 + 192;
static_assert(L_CB + 2 * SEQ * 4 <= L_OST && SB_NSLOT * SLOT <= L_OST && L_OST + 8 * 4096 <= 147456, "attention LDS map");
constexpr float SB_THR = -160.0f;
__device__ __forceinline__ int crow(int r, int hi) { return (r & 3) + 8 * (r >> 2) + 4 * hi; }
__device__ __forceinline__ void swap_halves(float v, float& lo, float& hi_) { auto rr = __builtin_amdgcn_permlane32_swap(__float_as_uint(v), __float_as_uint(v), false, false); lo = __uint_as_float(rr[0]); hi_ = __uint_as_float(rr[1]); }

struct AU { int b, h, qb, kind; };
struct Geo {
    const bf16_t* ksrc; const bf16_t* vsrc; const bf16_t* Qw; int wdst, nT, T_last, qw, qabs;
    __device__ __forceinline__ void init(const AU& u, const bf16_t* QKV, int lane, int wid) {
        const size_t rowbase = (size_t)u.b * SEQ; const int colq = u.kind * 1536 + u.h * HD; const int q0 = u.qb * 256;
        qw = q0 + wid * 32; qabs = qw + (lane & 31);
        ksrc = QKV + rowbase * PITCH + colq + 512 + (size_t)lane * PITCH + wid * 8;
        vsrc = QKV + rowbase * PITCH + colq + 1024 + (size_t)(16 * (wid & 3) + (lane >> 2)) * PITCH + (wid >> 2) * 32 + (lane & 3) * 8;
        Qw = QKV + (rowbase + qw) * PITCH + colq + (size_t)(lane & 31) * PITCH + (lane >> 5) * 8;
        wdst = wid * 1024; nT = u.qb * 4 + 4; T_last = nT - 1;
    }
};
#define ATT_DMA(G, tile, slotidx) do { const int t_ = (tile); LAS unsigned char* sl_ = lds + (slotidx) * SLOT + (G).wdst; \
        __builtin_amdgcn_global_load_lds((const unsigned*)((G).ksrc + (size_t)t_ * 64 * PITCH), (LAS unsigned*)(sl_ + L_K), 16, 0, 0); \
        __builtin_amdgcn_global_load_lds((const unsigned*)((G).vsrc + (size_t)t_ * 64 * PITCH), (LAS unsigned*)(sl_ + L_V), 16, 0, 0); } while (0)
#define ATT_VREAD(slot) do { const unsigned vb = (unsigned)(uintptr_t)((slot) + L_V + ((lane >> 4) & 1) * 32 + (lane & 3) * 8 + (4 * hi + ((lane & 15) >> 2)) * 64); \
        _Pragma("unroll") for (int i = 0; i < 8; ++i) { \
            asm volatile("ds_read_b64_tr_b16 %0, %1 offset:%c2" : "=&v"(vlo[i]) : "v"(vb), "i"((i >> 2) * 4096 + (i & 3) * 1024) : "memory"); \
            asm volatile("ds_read_b64_tr_b16 %0, %1 offset:%c2" : "=&v"(vhi[i]) : "v"(vb), "i"((i >> 2) * 4096 + (i & 3) * 1024 + 512) : "memory"); } } while (0)
#define ATT_PV() do { u32x4 pw[4]; \
        pw[0] = (u32x4){cvt_pk_bf16(p0[0], p0[1]), cvt_pk_bf16(p0[2], p0[3]), cvt_pk_bf16(p0[4], p0[5]), cvt_pk_bf16(p0[6], p0[7])}; \
        pw[1] = (u32x4){cvt_pk_bf16(p0[8], p0[9]), cvt_pk_bf16(p0[10], p0[11]), cvt_pk_bf16(p0[12], p0[13]), cvt_pk_bf16(p0[14], p0[15])}; \
        pw[2] = (u32x4){cvt_pk_bf16(p1[0], p1[1]), cvt_pk_bf16(p1[2], p1[3]), cvt_pk_bf16(p1[4], p1[5]), cvt_pk_bf16(p1[6], p1[7])}; \
        pw[3] = (u32x4){cvt_pk_bf16(p1[8], p1[9]), cvt_pk_bf16(p1[10], p1[11]), cvt_pk_bf16(p1[12], p1[13]), cvt_pk_bf16(p1[14], p1[15])}; \
        asm volatile("s_waitcnt lgkmcnt(0)" ::: "memory"); __builtin_amdgcn_sched_barrier(0); \
        _Pragma("unroll") for (int ks = 0; ks < 4; ++ks) _Pragma("unroll") for (int d0 = 0; d0 < 2; ++d0) { const int i = d0 * 4 + ks; \
            const bf16x8 vf = {vlo[i][0], vlo[i][1], vlo[i][2], vlo[i][3], vhi[i][0], vhi[i][1], vhi[i][2], vhi[i][3]}; \
            o[d0] = __builtin_amdgcn_mfma_f32_32x32x16_bf16(__builtin_bit_cast(bf16x8, pw[ks]), vf, o[d0], 0, 0, 0); } } while (0)

__device__ __forceinline__ void unit_prologue(const AU& u, const bf16_t* QKV, const float* cc, LAS unsigned char* lds, bf16x8 (&qr)[4], f32x4& c4, float& cref) {
    const int tid = threadIdx.x, lane = tid & 63; const int wid = __builtin_amdgcn_readfirstlane(tid >> 6);
    Geo g; g.init(u, QKV, lane, wid);
    if (u.kind == 0) { ATT_DMA(g, g.T_last, 0); ATT_DMA(g, g.T_last - 1, 1); ATT_DMA(g, g.T_last - 2, 2); }
    else { ATT_DMA(g, g.T_last, 0); ATT_DMA(g, g.T_last - 1, 1); ATT_DMA(g, g.T_last - 2, 2); ATT_DMA(g, g.T_last - 3, 3); if (g.nT > 4) { ATT_DMA(g, g.T_last - 4, 4); ATT_DMA(g, g.T_last - 5, 5); } }
#pragma unroll
    for (int d0 = 0; d0 < 4; ++d0) qr[d0] = *(const bf16x8*)(g.Qw + d0 * 16);
    if (u.kind == 0) { const float* ccb = cc + (size_t)(u.b * NH + u.h) * SEQ; cref = ccb[u.qb * 256 + 255]; c4 = *((const f32x4*)ccb + tid); }
}
__device__ __forceinline__ void unit_prologue_finish(const AU& u, LAS unsigned char* lds, bf16x8 (&qr)[4], const f32x4 c4, const float cref, int cbuf) {
    if (u.kind == 0) *((LAS f32x4*)(lds + L_CB + cbuf * SEQ * 4) + threadIdx.x) = cref - c4;
#pragma unroll
    for (int d0 = 0; d0 < 4; ++d0) { const u32x4 w = __builtin_bit_cast(u32x4, qr[d0]); u32x4 y;
        asm volatile("v_mov_b32 %0, %1" : "=&v"(y.x) : "v"(w.x)); asm volatile("v_mov_b32 %0, %1" : "=&v"(y.y) : "v"(w.y)); asm volatile("v_mov_b32 %0, %1" : "=&v"(y.z) : "v"(w.z)); asm volatile("v_mov_b32 %0, %1" : "=&v"(y.w) : "v"(w.w));
        qr[d0] = __builtin_bit_cast(bf16x8, y); }
}

__device__ __forceinline__ void fox_loop(const AU& u, const bf16_t* QKV, LAS unsigned char* lds, const bf16x8 (&qr)[4], int cbuf, f32x16 (&o)[2], float& inv) {
    const int tid = threadIdx.x, lane = tid & 63, r32 = lane & 31, hi = lane >> 5; const int wid = __builtin_amdgcn_readfirstlane(tid >> 6);
    Geo g; g.init(u, QKV, lane, wid);
    const int nIter = g.nT, T_last = g.T_last, td = g.qw >> 6, qabs = g.qabs;
    LAS float* wsf = (LAS float*)(lds + L_WS) + wid * 64;
    const LAS float* cbl = (const LAS float*)(lds + L_CB + cbuf * SEQ * 4);
    o[0] = (f32x16){}; o[1] = (f32x16){};
    float mrun = -INFINITY, lrun = 0.f;
    for (int it = 0; it < nIter; ++it) {
        const int t = T_last - it; const int ahead = nIter - 1 - it;
        if (ahead >= 2) asm volatile("s_waitcnt vmcnt(4) lgkmcnt(0)" ::: "memory"); else if (ahead == 1) asm volatile("s_waitcnt vmcnt(2) lgkmcnt(0)" ::: "memory"); else asm volatile("s_waitcnt vmcnt(0) lgkmcnt(0)" ::: "memory");
        __builtin_amdgcn_s_barrier(); asm volatile("" ::: "memory");
        if (it + 3 < nIter) ATT_DMA(g, T_last - (it + 3), (it + 3) & (FX_NSLOT - 1));
        if (t <= td) {
            const LAS unsigned char* slot = lds + (it & (FX_NSLOT - 1)) * SLOT;
            f32x16 p0, p1; f32x4 cq[8]; bf16x8 kf[8];
            { const unsigned ca = (unsigned)(uintptr_t)(cbl + t * 64 + 4 * hi), ka = (unsigned)(uintptr_t)(slot + L_K + hi * 1024 + r32 * 16);
#pragma unroll
              for (int gq = 0; gq < 4; ++gq) { asm volatile("ds_read_b128 %0, %1 offset:%c2" : "=&v"(cq[gq]) : "v"(ca), "i"(32 * gq) : "memory"); asm volatile("ds_read_b128 %0, %1 offset:%c2" : "=&v"(cq[4 + gq]) : "v"(ca), "i"(128 + 32 * gq) : "memory"); }
#pragma unroll
              for (int d0 = 0; d0 < 4; ++d0) { asm volatile("ds_read_b128 %0, %1 offset:%c2" : "=&v"(kf[2 * d0]) : "v"(ka), "i"(d0 * 2048) : "memory"); asm volatile("ds_read_b128 %0, %1 offset:%c2" : "=&v"(kf[2 * d0 + 1]) : "v"(ka), "i"(d0 * 2048 + 512) : "memory"); } }
            s16x4 vlo[8], vhi[8];
            ATT_VREAD(slot);
            asm volatile("s_waitcnt lgkmcnt(15)" ::: "memory"); __builtin_amdgcn_sched_barrier(0);
#pragma unroll
            for (int gq = 0; gq < 4; ++gq)
#pragma unroll
                for (int i = 0; i < 4; ++i) { p0[4 * gq + i] = cq[gq][i]; p1[4 * gq + i] = cq[4 + gq][i]; }
#pragma unroll
            for (int d0 = 0; d0 < 4; ++d0) { p0 = __builtin_amdgcn_mfma_f32_32x32x16_bf16(kf[2 * d0], qr[d0], p0, 0, 0, 0); p1 = __builtin_amdgcn_mfma_f32_32x32x16_bf16(kf[2 * d0 + 1], qr[d0], p1, 0, 0, 0); }
            if (t == td) { asm volatile("" ::: "memory"); const int kv0 = t * 64 + 4 * hi;
#pragma unroll
                for (int r = 0; r < 16; ++r) { const int kv = kv0 + (r & 3) + 8 * (r >> 2); if (kv > qabs) p0[r] = -INFINITY; if (kv + 32 > qabs) p1[r] = -INFINITY; } }
            float rm = fmaxf(p0[0], p1[0]);
#pragma unroll
            for (int r = 1; r < 16; ++r) rm = fmaxf(rm, fmaxf(p0[r], p1[r]));
            { float a, c; swap_halves(rm, a, c); rm = fmaxf(a, c); }
            if (__any(rm > mrun + 8.0f)) {
                const float mnew = fmaxf(mrun, rm); const float f = __builtin_amdgcn_exp2f(mrun - mnew); mrun = mnew; lrun *= f;
                if (hi == 0) wsf[r32] = f;
                asm volatile("s_waitcnt lgkmcnt(0)" ::: "memory");
#pragma unroll
                for (int r = 0; r < 16; ++r) { const float fr_ = wsf[crow(r, hi)]; o[0][r] *= fr_; o[1][r] *= fr_; }
                asm volatile("s_waitcnt lgkmcnt(0)" ::: "memory");
            }
            float ls = 0.f;
#pragma unroll
            for (int r = 0; r < 16; ++r) { p0[r] = __builtin_amdgcn_exp2f(p0[r] - mrun); p1[r] = __builtin_amdgcn_exp2f(p1[r] - mrun); ls += p0[r] + p1[r]; }
            lrun += ls;
            ATT_PV();
        }
    }
    { float a, c; swap_halves(lrun, a, c); inv = 1.0f / (a + c); }
    asm volatile("s_waitcnt lgkmcnt(0)" ::: "memory");
    __builtin_amdgcn_s_barrier(); asm volatile("" ::: "memory");
}

__device__ __forceinline__ void sb_loop(const AU& u, const bf16_t* QKV, LAS unsigned char* lds, const bf16x8 (&qr)[4], f32x16 (&o)[2]) {
    const int tid = threadIdx.x, lane = tid & 63, r32 = lane & 31, hi = lane >> 5; const int wid = __builtin_amdgcn_readfirstlane(tid >> 6);
    Geo g; g.init(u, QKV, lane, wid);
    const int nT = g.nT, T_last = g.T_last, dw = 3 - (wid >> 1), qabs = g.qabs;
    LAS unsigned* flags = (LAS unsigned*)(lds + L_FLAG);
    o[0] = (f32x16){}; o[1] = (f32x16){};
    float R = 0.f; bool mydone = false;
    for (int s = 0; s < nT; ++s) {
        { const int issued = (s + 5 < nT - 1) ? s + 5 : nT - 1, need = (s + 3 < nT - 1) ? s + 3 : nT - 1; const int cnt = issued - need;
          if (cnt >= 2) asm volatile("s_waitcnt vmcnt(4) lgkmcnt(0)" ::: "memory"); else if (cnt == 1) asm volatile("s_waitcnt vmcnt(2) lgkmcnt(0)" ::: "memory"); else asm volatile("s_waitcnt vmcnt(0) lgkmcnt(0)" ::: "memory"); }
        __builtin_amdgcn_s_barrier(); asm volatile("" ::: "memory");
        if (s > 0) { u32x4 fa, fb; const unsigned fad = (unsigned)(uintptr_t)(flags + ((s - 1) & 1) * 8);
            asm volatile("ds_read_b128 %0, %1" : "=&v"(fa) : "v"(fad) : "memory"); asm volatile("ds_read_b128 %0, %1 offset:16" : "=&v"(fb) : "v"(fad) : "memory");
            asm volatile("s_waitcnt lgkmcnt(0)" ::: "memory"); __builtin_amdgcn_sched_barrier(0);
            if ((fa.x & fa.y & fa.z & fa.w & fb.x & fb.y & fb.z & fb.w) != 0u) break; }
        if (s + 6 < nT) ATT_DMA(g, T_last - (s + 6), (s + 6) % SB_NSLOT);
        const int uu = s + dw;
        if (uu >= nT) mydone = true;
        if (!mydone) {
            const int t = T_last - uu; const LAS unsigned char* slot = lds + (uu % SB_NSLOT) * SLOT;
            f32x16 p0 = (f32x16){}, p1 = (f32x16){}; bf16x8 kf[8];
            { const unsigned ka = (unsigned)(uintptr_t)(slot + L_K + hi * 1024 + r32 * 16);
#pragma unroll
              for (int d0 = 0; d0 < 4; ++d0) { asm volatile("ds_read_b128 %0, %1 offset:%c2" : "=&v"(kf[2 * d0]) : "v"(ka), "i"(d0 * 2048) : "memory"); asm volatile("ds_read_b128 %0, %1 offset:%c2" : "=&v"(kf[2 * d0 + 1]) : "v"(ka), "i"(d0 * 2048 + 512) : "memory"); } }
            asm volatile("s_waitcnt lgkmcnt(0)" ::: "memory"); __builtin_amdgcn_sched_barrier(0);
#pragma unroll
            for (int d0 = 0; d0 < 4; ++d0) { p0 = __builtin_amdgcn_mfma_f32_32x32x16_bf16(kf[2 * d0], qr[d0], p0, 0, 0, 0); p1 = __builtin_amdgcn_mfma_f32_32x32x16_bf16(kf[2 * d0 + 1], qr[d0], p1, 0, 0, 0); }
            const bool diag = (s == 0); const int kv0 = t * 64 + 4 * hi;
            f32x16 l0, l1;
#pragma unroll
            for (int r = 0; r < 16; ++r) {
                { const float z = p0[r]; const float tt = __builtin_amdgcn_logf(1.0f + __builtin_amdgcn_exp2f(-fabsf(z))); l0[r] = -(fmaxf(z, 0.f) + tt); }
                { const float z = p1[r]; const float tt = __builtin_amdgcn_logf(1.0f + __builtin_amdgcn_exp2f(-fabsf(z))); l1[r] = -(fmaxf(z, 0.f) + tt); }
            }
            if (diag) {   asm volatile("" ::: "memory");
#pragma unroll
                for (int r = 0; r < 16; ++r) { const int kv = kv0 + (r & 3) + 8 * (r >> 2); if (!(kv < qabs)) l0[r] = 0.f; if (!(kv + 32 < qabs)) l1[r] = 0.f; }
            }
            float G[8], Gp[8];
#pragma unroll
            for (int gq = 0; gq < 4; ++gq) { G[gq] = (l0[4 * gq] + l0[4 * gq + 1]) + (l0[4 * gq + 2] + l0[4 * gq + 3]); G[4 + gq] = (l1[4 * gq] + l1[4 * gq + 1]) + (l1[4 * gq + 2] + l1[4 * gq + 3]); }
#pragma unroll
            for (int c = 0; c < 8; ++c) { float a, d; swap_halves(G[c], a, d); Gp[c] = hi ? a : d; }
            float cs = R;
#pragma unroll
            for (int c = 7; c >= 0; --c) {
                const float ex = cs + (hi ? 0.f : Gp[c]);
                const int gq = c & 3;
                if (c >= 4) { float s3 = l1[4 * gq + 3] + ex, s2 = l1[4 * gq + 2] + s3, s1 = l1[4 * gq + 1] + s2, s0 = l1[4 * gq] + s1; l1[4 * gq + 3] = s3; l1[4 * gq + 2] = s2; l1[4 * gq + 1] = s1; l1[4 * gq] = s0; }
                else        { float s3 = l0[4 * gq + 3] + ex, s2 = l0[4 * gq + 2] + s3, s1 = l0[4 * gq + 1] + s2, s0 = l0[4 * gq] + s1; l0[4 * gq + 3] = s3; l0[4 * gq + 2] = s2; l0[4 * gq + 1] = s1; l0[4 * gq] = s0; }
                cs += G[c] + Gp[c];
            }
            s16x4 vlo[8], vhi[8];
            ATT_VREAD(slot);
#pragma unroll
            for (int r = 0; r < 16; ++r) { p0[r] = __builtin_amdgcn_exp2f(p0[r] + l0[r]); p1[r] = __builtin_amdgcn_exp2f(p1[r] + l1[r]); }
            if (diag) {   asm volatile("" ::: "memory");
#pragma unroll
                for (int r = 0; r < 16; ++r) { const int kv = kv0 + (r & 3) + 8 * (r >> 2); if (!(kv < qabs)) p0[r] = 0.f; if (!(kv + 32 < qabs)) p1[r] = 0.f; }
            }
            R = cs;
            mydone = __all(R < SB_THR);
            ATT_PV();
        }
        if (lane == 0) flags[(s & 1) * 8 + wid] = mydone ? 1u : 0u;
    }
    asm volatile("s_waitcnt lgkmcnt(0)" ::: "memory");
    __builtin_amdgcn_s_barrier(); asm volatile("" ::: "memory");
}

__device__ __forceinline__ void unit_epilogue(const AU& u, bf16_t* O, LAS unsigned char* lds, const f32x16 (&o)[2], float inv) {
    const int tid = threadIdx.x, lane = tid & 63, r32 = lane & 31, hi = lane >> 5; const int wid = __builtin_amdgcn_readfirstlane(tid >> 6);
    LAS float* wsf = (LAS float*)(lds + L_WS) + wid * 64;
    if (hi == 0) wsf[32 + r32] = inv;
    asm volatile("s_waitcnt lgkmcnt(0)" ::: "memory");
    LAS bf16_t* stg = (LAS bf16_t*)(lds + L_OST) + wid * 2048;
#pragma unroll
    for (int r = 0; r < 16; ++r) { const int orow = crow(r, hi); const float rl = wsf[32 + orow]; const unsigned w = cvt_pk_bf16(o[0][r] * rl, o[1][r] * rl);
        stg[orow * 64 + r32] = (bf16_t)(w & 0xffffu); stg[orow * 64 + 32 + r32] = (bf16_t)(w >> 16); }
    asm volatile("s_waitcnt lgkmcnt(0)" ::: "memory");
    bf16_t* Ow = O + ((size_t)u.b * SEQ + u.qb * 256 + wid * 32) * OPITCH + u.kind * 512 + u.h * HD;
#pragma unroll
    for (int i = 0; i < 4; ++i) { const int row = i * 8 + (lane >> 3), ch = lane & 7; const u32x4 v = *(const LAS u32x4*)(stg + row * 64 + ch * 8); *(u32x4*)(Ow + (size_t)row * OPITCH + ch * 8) = v; }
    asm volatile("s_waitcnt lgkmcnt(0)" ::: "memory");
}
#undef ATT_DMA
#undef ATT_VREAD
#undef ATT_PV
}

#define XB_TMO      128
#define XB_XCNT(j)  (256  + 64 * (j))
#define XB_XSUB(j)  (1280 + 64 * (j))
#define XB_XGEN(j)  (2304 + 64 * (j))
#define XB_TOP      3328
#define XB_TOPGEN   3392
#define XCD_BAR_WORDS 3456
#define XB_SPIN_CAP (1u << 18)
__device__ __forceinline__ unsigned xb_ld(unsigned* p)              { return __hip_atomic_load(p, __ATOMIC_RELAXED, __HIP_MEMORY_SCOPE_AGENT); }
__device__ __forceinline__ unsigned xb_add(unsigned* p, unsigned v) { return __hip_atomic_fetch_add(p, v, __ATOMIC_RELAXED, __HIP_MEMORY_SCOPE_AGENT); }
__device__ __forceinline__ unsigned xb_xcc_id() { return (unsigned)__builtin_amdgcn_s_getreg((3 << 11) | 20) & 0xFu; }
#define XB_SPIN(cond, bar) do { unsigned _sp = 0; while (cond) { __builtin_amdgcn_s_sleep(1); \
    if ((++_sp & 255u) == 0u) { if (xb_ld(&(bar)[XB_TMO])) break; if (_sp > XB_SPIN_CAP) { atomicAdd(&(bar)[XB_TMO], 1u); break; } } } } while (0)
struct XcdBarrier { unsigned* bar; unsigned x; volatile LAS unsigned* st; };
__device__ __forceinline__ XcdBarrier xcd_barrier_post(unsigned* bar, volatile LAS unsigned* st) {
    XcdBarrier b; b.bar = bar; b.x = xb_xcc_id(); b.st = st;
    if (threadIdx.x == 0) (void)xb_add(&bar[XB_XCNT(b.x)], 1u);
    return b;
}
__device__ __forceinline__ void xcd_barrier_complete(unsigned* bar, unsigned x, unsigned& nloc, unsigned& nx) {
    const unsigned G = gridDim.x * gridDim.y * gridDim.z;
    unsigned sum, cnt, mine, sp = 0u;
    for (;;) {
        sum = 0u; cnt = 0u; mine = 0u;
#pragma unroll
        for (unsigned j = 0; j < 16; ++j) { const unsigned c = xb_ld(&bar[XB_XCNT(j)]); sum += c; cnt += (c > 0u) ? 1u : 0u; mine = (j == x) ? c : mine; }
        if (sum == G) break;
        __builtin_amdgcn_s_sleep(1);
        if ((++sp & 255u) == 0u) { if (xb_ld(&bar[XB_TMO])) break; if (sp > XB_SPIN_CAP) { atomicAdd(&bar[XB_TMO], 1u); break; } }
    }
    nloc = mine > 0u ? mine : 1u; nx = cnt > 0u ? cnt : 1u;
}
__device__ __forceinline__ void xcd_barrier(const XcdBarrier& b) {
    asm volatile("s_waitcnt vmcnt(0)" ::: "memory");
    __syncthreads();
    if (threadIdx.x == 0) {
        unsigned* bar = b.bar;
        __builtin_amdgcn_s_waitcnt(0);
        unsigned nloc = b.st[0], nx = b.st[1];
        if (nloc == 0u) { xcd_barrier_complete(bar, b.x, nloc, nx); b.st[0] = nloc; b.st[1] = nx; }
        const unsigned old = xb_add(&bar[XB_XSUB(b.x)], 1u);
        const unsigned gen = old / nloc;
        if (old + 1u == (gen + 1u) * nloc) {
            __builtin_amdgcn_fence(__ATOMIC_RELEASE, "agent");
            asm volatile("s_waitcnt vmcnt(0)" ::: "memory");
            const unsigned og = xb_add(&bar[XB_TOP], 1u);
            const unsigned tg = og / nx;
            if (og + 1u == (tg + 1u) * nx) xb_add(&bar[XB_TOPGEN], 1u);
            else XB_SPIN(xb_ld(&bar[XB_TOPGEN]) == tg, bar);
            __builtin_amdgcn_fence(__ATOMIC_ACQUIRE, "agent");
            xb_add(&bar[XB_XGEN(b.x)], 1u);
            asm volatile("s_waitcnt vmcnt(0)" ::: "memory");
        } else {
            XB_SPIN(xb_ld(&bar[XB_XGEN(b.x)]) == gen, bar);
            __builtin_amdgcn_fence(__ATOMIC_ACQUIRE, "agent");
            asm volatile("s_waitcnt vmcnt(0)" ::: "memory");
        }
    }
    __syncthreads();
}

constexpr int NWAVES = 8;
constexpr int RING_BYTES = 131072, LDS_BYTES = 151552;

__device__ __forceinline__ float wave_sum(float v) {
#pragma unroll
    for (int o = 1; o < 64; o <<= 1) v += __shfl_xor(v, o);
    return v;
}
__device__ __forceinline__ void tr_item(const float* W, int ldw, int col0, int K, bf16_t* WT, int row_off, LAS float* scr, int kb, int nb, int lane, const float* gs) {
    const int k0 = 64 * kb, n0 = 32 * nb;
    float wv[32];
#pragma unroll
    for (int i = 0; i < 32; ++i) { const int kk = 2 * i + (lane >> 5); wv[i] = W[(size_t)(k0 + kk) * ldw + col0 + n0 + (lane & 31)]; }
    if (gs) {
#pragma unroll
        for (int i = 0; i < 32; ++i) wv[i] *= gs[k0 + 2 * i + (lane >> 5)];
    }
#pragma unroll
    for (int i = 0; i < 32; ++i) { const int kk = 2 * i + (lane >> 5); scr[kk * 33 + (lane & 31)] = wv[i]; }
    asm volatile("s_waitcnt lgkmcnt(0)" ::: "memory");
    const int c = lane & 7;
#pragma unroll
    for (int j = 0; j < 4; ++j) { const int n = (lane >> 3) + 8 * j; const LAS float* s = scr + (8 * c) * 33 + n;
        u32x4 o; o.x = cvt_pk_bf16(s[0 * 33], s[1 * 33]); o.y = cvt_pk_bf16(s[2 * 33], s[3 * 33]); o.z = cvt_pk_bf16(s[4 * 33], s[5 * 33]); o.w = cvt_pk_bf16(s[6 * 33], s[7 * 33]);
        *(u32x4*)(WT + (size_t)(row_off + n0 + n) * K + k0 + 8 * c) = o; }
    asm volatile("s_waitcnt lgkmcnt(0)" ::: "memory");
}

struct Args { const float* in[16]; float* out; unsigned char* ws; int ph_lo, ph_hi; };

__global__ void __launch_bounds__(NWAVES * 64, 2) fwd_megakernel(Args args) {
    __builtin_assume(__builtin_amdgcn_workitem_id_y() == 0); __builtin_assume(__builtin_amdgcn_workitem_id_z() == 0);
    extern __shared__ __attribute__((aligned(16))) unsigned char lds_raw[];
    LAS unsigned char* lds = (LAS unsigned char*)lds_raw;
    const int tid = threadIdx.x, lane = tid & 63, wave = __builtin_amdgcn_readfirstlane(tid >> 6);
    const int G = gridDim.x, bx = blockIdx.x, vcu = (G % 8 == 0) ? (bx % 8) * (G / 8) + bx / 8 : bx;
    const int gw = vcu * NWAVES + wave, NGW = G * NWAVES;
    unsigned char* ws = args.ws;
    const float* x = args.in[0]; const float* p_in = args.in[1]; const float* g_mix = args.in[2]; const float* w_in = args.in[3]; const float* b_forget = args.in[4]; const float* b_gate = args.in[5];
    const float* w_bf = args.in[6]; const float* w_bs = args.in[7]; const float* w_out = args.in[8]; const float* g_mlp = args.in[9]; const float* w_up = args.in[10]; const float* w_dn = args.in[11];
    const float* g_ple = args.in[12]; const float* w_pg = args.in[13]; const float* w_ple = args.in[14]; const float* g_final = args.in[15];
    float* out = args.out;
    bf16_t* Win_t = (bf16_t*)(ws + WS_WIN); bf16_t* Wbf_t = (bf16_t*)(ws + WS_WBF); bf16_t* Wbs_t = (bf16_t*)(ws + WS_WBS); bf16_t* Wout_t = (bf16_t*)(ws + WS_WOUT);
    bf16_t* Wup_t = (bf16_t*)(ws + WS_WUP); bf16_t* Wdn_t = (bf16_t*)(ws + WS_WDN); bf16_t* Wpg_t = (bf16_t*)(ws + WS_WPG); bf16_t* Wple_t = (bf16_t*)(ws + WS_WPLE);
    float* LOGF = (float*)(ws + WS_LOGF); float* CC = (float*)(ws + WS_CC); float* SSQ1 = (float*)(ws + WS_SSQ1); float* SSQ2 = (float*)(ws + WS_SSQ2);
    bf16_t* PB = (bf16_t*)(ws + WS_PB); bf16_t* BUFA = (bf16_t*)(ws + WS_BUFA); bf16_t* BUFB = (bf16_t*)(ws + WS_BUFB); bf16_t* QKV = (bf16_t*)(ws + WS_QKV); bf16_t* SG = (bf16_t*)(ws + WS_SG);
    bf16_t* HB = (bf16_t*)(ws + WS_H); bf16_t* EB = (bf16_t*)(ws + WS_E);
    const int lo = args.ph_lo, hi = args.ph_hi;
#define IN(k) (lo <= (k) && (k) < hi)
    volatile LAS unsigned* bst = (volatile LAS unsigned*)(lds + LDS_BYTES - 64);
    if (tid < 2) bst[tid] = 0u;
    __syncthreads();
    XcdBarrier xbar; xbar.bar = (unsigned*)ws; xbar.x = 0; xbar.st = bst;
    if (hi - lo > 1) xbar = xcd_barrier_post((unsigned*)ws, bst);
#define SEAM(k) do { if (IN(k) && IN((k) + 1)) { if (hi > N_PHASES) cg::this_grid().sync(); else xcd_barrier(xbar); } } while (0)

    if (IN(0)) {
        LAS float* scr = (LAS float*)(lds + wave * 8448);
        LAS f32x4* wtab = (LAS f32x4*)(lds + 69632);
        {
            constexpr int NSEG = 9;
            int base = 0;
            for (int it = gw; ; it += NGW) {
                int r = it; const float* W; int ldw, col0, K, nblk, row_off; bf16_t* WT; const float* gs = nullptr;
                if (r < 16 * 48) { W = w_in; ldw = NIN_SRC; col0 = 0; K = DM; nblk = 48; WT = Win_t; row_off = 0; }
                else if ((r -= 16 * 48) < 16 * 112) { W = w_in; ldw = NIN_SRC; col0 = 1544; K = DM; nblk = 112; WT = Win_t; row_off = 1536; }
                else if ((r -= 16 * 112) < 8 * 32) { W = w_bf; ldw = DM; col0 = 0; K = 512; nblk = 32; WT = Wbf_t; row_off = 0; }
                else if ((r -= 8 * 32) < 8 * 32) { W = w_bs; ldw = DM; col0 = 0; K = 512; nblk = 32; WT = Wbs_t; row_off = 0; }
                else if ((r -= 8 * 32) < 16 * 32) { W = w_out; ldw = DM; col0 = 0; K = DM; nblk = 32; WT = Wout_t; row_off = 0; }
                else if ((r -= 16 * 32) < 16 * 128) { W = w_up; ldw = DFF; col0 = 0; K = DM; nblk = 128; WT = Wup_t; row_off = 0; gs = g_mlp; }
                else if ((r -= 16 * 128) < 64 * 32) { W = w_dn; ldw = DM; col0 = 0; K = DFF; nblk = 32; WT = Wdn_t; row_off = 0; }
                else if ((r -= 64 * 32) < 16 * 32) { W = w_pg; ldw = DM; col0 = 0; K = DM; nblk = 32; WT = Wpg_t; row_off = 0; gs = g_ple; }
                else if ((r -= 16 * 32) < 4 * 32) { W = w_ple; ldw = DM; col0 = 0; K = DPLE; nblk = 32; WT = Wple_t; row_off = 0; }
                else break;
                tr_item(W, ldw, col0, K, WT, row_off, scr, r / nblk, r % nblk, lane, gs);
                (void)base; (void)NSEG;
            }
        }
        {
            f32x4 gm[4];
#pragma unroll
            for (int j = 0; j < 4; ++j) gm[j] = *((const f32x4*)g_mix + lane + 64 * j);
#pragma unroll
            for (int q = 0; q < 2; ++q) { const int k = tid + 512 * q; const float gk = g_mix[k]; const float* wp = w_in + (size_t)k * NIN_SRC + 1536;
                const int ln = (k & 255) >> 2, e = k & 3, j = k >> 8;
                wtab[((j * 4 + e) * 2 + 0) * 64 + ln] = *(const f32x4*)wp * gk; wtab[((j * 4 + e) * 2 + 1) * 64 + ln] = *(const f32x4*)(wp + 4) * gk; }
            __syncthreads();
            const float bfv = b_forget[lane & 7];
            for (int m0 = gw; m0 < M; m0 += 2 * NGW) {
                f32x4 va[2][4];
#pragma unroll
                for (int q = 0; q < 2; ++q)
#pragma unroll
                    for (int j = 0; j < 4; ++j) va[q][j] = *((const f32x4*)(x + (size_t)(m0 + q * NGW) * DM) + lane + 64 * j);
#pragma unroll
                for (int q = 0; q < 2; ++q) {
                    const int m = m0 + q * NGW;
                    f32x4 v[4]; float s = 0.f;
#pragma unroll
                    for (int j = 0; j < 4; ++j) { v[j] = va[q][j]; s += (v[j][0] * v[j][0] + v[j][1] * v[j][1]) + (v[j][2] * v[j][2] + v[j][3] * v[j][3]); }
                    const float rstd = __builtin_amdgcn_rsqf(wave_sum(s) * (1.0f / DM) + EPS);
                    f32x4 f0 = {0.f, 0.f, 0.f, 0.f}, f1 = {0.f, 0.f, 0.f, 0.f};
#pragma unroll
                    for (int j = 0; j < 4; ++j)
#pragma unroll
                        for (int e = 0; e < 4; ++e) { f0 += wtab[((j * 4 + e) * 2 + 0) * 64 + lane] * v[j][e]; f1 += wtab[((j * 4 + e) * 2 + 1) * 64 + lane] * v[j][e]; }
                    unsigned long long* o8 = (unsigned long long*)(BUFA + (size_t)m * DM) + lane;
#pragma unroll
                    for (int j = 0; j < 4; ++j) { const f32x4 y = v[j] * gm[j] * rstd; o8[64 * j] = (unsigned long long)cvt_pk_bf16(y[0], y[1]) | ((unsigned long long)cvt_pk_bf16(y[2], y[3]) << 32); }
                    float fl[8];
#pragma unroll
                    for (int e = 0; e < 4; ++e) { fl[e] = wave_sum(f0[e]); fl[4 + e] = wave_sum(f1[e]); }
                    float mine = fl[0];
#pragma unroll
                    for (int e = 1; e < 8; ++e) mine = ((lane & 7) == e) ? fl[e] : mine;
                    const float y2 = (mine * rstd + bfv) * LOG2E;
                    const float lf = -(fmaxf(-y2, 0.f) + __builtin_amdgcn_logf(1.0f + __builtin_amdgcn_exp2f(-fabsf(y2))));
                    if (lane < 8) LOGF[(size_t)((m / SEQ) * NH + lane) * SEQ + (m % SEQ)] = lf;
                }
            }
        }
        {
            const size_t n8 = (size_t)M * DPLE / 8;
            for (size_t i = (size_t)bx * 512 + tid; i < n8; i += (size_t)G * 512) { const f32x4 a = *((const f32x4*)p_in + 2 * i), c = *((const f32x4*)p_in + 2 * i + 1);
                u32x4 w; w.x = cvt_pk_bf16(a[0], a[1]); w.y = cvt_pk_bf16(a[2], a[3]); w.z = cvt_pk_bf16(c[0], c[1]); w.w = cvt_pk_bf16(c[2], c[3]); *((u32x4*)PB + i) = w; }
        }
    }
    SEAM(0);

    if (IN(1)) {
        if (gw < BATCH * NH) {
            const float* src = LOGF + (size_t)gw * SEQ + lane * 32; float* dst = CC + (size_t)gw * SEQ + lane * 32;
            f32x4 v[8]; float run = 0.f;
#pragma unroll
            for (int j = 0; j < 8; ++j) { v[j] = *((const f32x4*)src + j);
#pragma unroll
                for (int e = 0; e < 4; ++e) { run += v[j][e]; v[j][e] = run; } }
            float incl = run;
#pragma unroll
            for (int o = 1; o < 64; o <<= 1) { const float tv = __shfl_up(incl, o); if (lane >= o) incl += tv; }
            const float excl = incl - run;
#pragma unroll
            for (int j = 0; j < 8; ++j) *((f32x4*)dst + j) = v[j] + excl;
        }
        pg8::Gemm g{DM, DM, DM};
        pg8::PlainSched S; S.T.init(M, NIN, G, bx); S.A = (const char*)BUFA; S.B = (const char*)Win_t; S.astep = (size_t)256 * DM * 2; S.bstep = (size_t)256 * DM * 2;
        pg8::EpiQKVG E{QKV, SG, b_gate};
        pg8::gemm_phase<pg8::EpiQKVG, pg8::PlainSched>(lds, g, S, E);
    }
    SEAM(1);

    if (IN(2)) {
        unsigned* qhead = (unsigned*)ws + 4096 + 64 * (bx & 7);
        volatile LAS unsigned* qslot = (volatile LAS unsigned*)(lds + LDS_BYTES - 32);
        const int grp = bx & 7;
#define ATT_UNIT(k) att::AU{(grp * 16 + (int)((k) & 15u)) / NH, (grp * 16 + (int)((k) & 15u)) % NH, 7 - (int)(((k) & 127u) >> 4), (int)((k) >> 7)}
#define ATT_NEXT() do { if (tid == 0) qslot[0] = knext_r; asm volatile("s_waitcnt lgkmcnt(0)" ::: "memory"); __builtin_amdgcn_s_barrier(); asm volatile("" ::: "memory"); knext = qslot[0]; \
                        asm volatile("s_waitcnt lgkmcnt(0)" ::: "memory"); __builtin_amdgcn_s_barrier(); asm volatile("" ::: "memory"); } while (0)
        unsigned knext_r = 0u, knext, kcur, knxt;
        if (tid == 0) knext_r = atomicAdd(qhead, 1u);
        ATT_NEXT(); kcur = knext;
        if (tid == 0) knext_r = atomicAdd(qhead, 1u);
        ATT_NEXT(); knxt = knext;
        if (kcur < 256u) {
            bf16x8 qr[4]; f32x16 o[2]; float inv = 1.0f; f32x4 c4 = {0.f, 0.f, 0.f, 0.f}; float cref = 0.f;
            att::AU cur = ATT_UNIT(kcur);
            att::unit_prologue(cur, QKV, CC, lds, qr, c4, cref);
            att::unit_prologue_finish(cur, lds, qr, c4, cref, 0);
            for (int i = 0;; ++i) {
                if (cur.kind == 0) att::fox_loop(cur, QKV, lds, qr, i & 1, o, inv); else { att::sb_loop(cur, QKV, lds, qr, o); inv = 1.0f; }
                const bool more = knxt < 256u;
                const att::AU nxt = ATT_UNIT(more ? knxt : 0u);
                if (more) att::unit_prologue(nxt, QKV, CC, lds, qr, c4, cref);
                if (more && tid == 0) knext_r = atomicAdd(qhead, 1u);
                att::unit_epilogue(cur, BUFB, lds, o, inv);
                if (!more) break;
                ATT_NEXT(); knxt = knext;
                att::unit_prologue_finish(nxt, lds, qr, c4, cref, (i + 1) & 1);
                cur = nxt;
            }
        }
#undef ATT_UNIT
#undef ATT_NEXT
    }
    SEAM(2);

    if (IN(3)) {
        pg8::Gemm g{DM, 512, 512};
        pg8::PairSched S; S.T.init(M, DM, G, bx); S.A0 = (const char*)BUFB; S.A1 = (const char*)(BUFB + 512); S.B0 = (const char*)Wbf_t; S.B1 = (const char*)Wbs_t; S.astep = (size_t)256 * DM * 2; S.bstep = (size_t)256 * 512 * 2;
        pg8::EpiBranch E{SG, BUFA};
        pg8::gemm_phase<pg8::EpiBranch, pg8::PairSched>(lds, g, S, E);
    }
    SEAM(3);

    if (IN(4)) {
        {
            pg8::Gemm g{DM, DM, DM};
            pg8::PlainSched S; S.T.init(M, DM, G, bx); S.A = (const char*)BUFA; S.B = (const char*)Wout_t; S.astep = (size_t)256 * DM * 2; S.bstep = (size_t)256 * DM * 2;
            pg8::EpiRes4 E{x, BUFB, SSQ1};
            pg8::gemm_phase<pg8::EpiRes4, pg8::PlainSched>(lds, g, S, E);
        }
        {
            pg8::Gemm g{DPLE, DPLE, DPLE};
            pg8::PlainSched S; S.T.init(M, DM, G, bx); S.A = (const char*)PB; S.B = (const char*)Wple_t; S.astep = (size_t)256 * DPLE * 2; S.bstep = (size_t)256 * DPLE * 2;
            pg8::EpiBf16 E{EB, DM};
            pg8::gemm_phase<pg8::EpiBf16, pg8::PlainSched>(lds, g, S, E);
        }
    }
    SEAM(4);

    if (IN(5)) {
        pg8::Gemm g{DM, DM, DM};
        pg8::PlainSched S; S.T.init(M, DFF, G, bx); S.A = (const char*)BUFB; S.B = (const char*)Wup_t; S.astep = (size_t)256 * DM * 2; S.bstep = (size_t)256 * DM * 2;
        pg8::EpiUp E{HB, SSQ1};
        pg8::gemm_phase<pg8::EpiUp, pg8::PlainSched>(lds, g, S, E);
    }
    SEAM(5);

    if (IN(6)) {
        pg8::Gemm g{DFF, DFF, DFF};
        pg8::PlainSched S; S.T.init(M, DM, G, bx); S.A = (const char*)HB; S.B = (const char*)Wdn_t; S.astep = (size_t)256 * DFF * 2; S.bstep = (size_t)256 * DFF * 2;
        pg8::EpiRes6 E{BUFB, BUFA, SSQ2};
        pg8::gemm_phase<pg8::EpiRes6, pg8::PlainSched>(lds, g, S, E);
    }
    SEAM(6);

    if (IN(7)) {
        pg8::Gemm g{DM, DM, DM};
        pg8::PlainSched S; S.T.init(M, DM, G, bx); S.A = (const char*)BUFA; S.B = (const char*)Wpg_t; S.astep = (size_t)256 * DM * 2; S.bstep = (size_t)256 * DM * 2;
        pg8::EpiPle E{BUFA, BUFB, EB, SSQ2};
        pg8::gemm_phase<pg8::EpiPle, pg8::PlainSched>(lds, g, S, E);
    }
    SEAM(7);

    if (IN(8)) {
        f32x4 gf[4];
#pragma unroll
        for (int j = 0; j < 2; ++j) { gf[2 * j] = *((const f32x4*)g_final + 2 * lane + 128 * j); gf[2 * j + 1] = *((const f32x4*)g_final + 2 * lane + 128 * j + 1); }
        for (int m = gw; m < M; m += 2 * NGW) {
            u32x4 w[2][2];
#pragma unroll
            for (int q = 0; q < 2; ++q)
#pragma unroll
                for (int j = 0; j < 2; ++j) w[q][j] = *((const u32x4*)(BUFB + (size_t)(m + q * NGW) * DM) + lane + 64 * j);
#pragma unroll
            for (int q = 0; q < 2; ++q) {
                f32x4 v[4]; float s = 0.f;
#pragma unroll
                for (int j = 0; j < 2; ++j) { v[2 * j] = pg8::bf4_lo(w[q][j]); v[2 * j + 1] = pg8::bf4_hi(w[q][j]); }
#pragma unroll
                for (int j = 0; j < 4; ++j) s += (v[j][0] * v[j][0] + v[j][1] * v[j][1]) + (v[j][2] * v[j][2] + v[j][3] * v[j][3]);
                const float rstd = __builtin_amdgcn_rsqf(wave_sum(s) * (1.0f / DM) + EPS);
                f32x4* orow = (f32x4*)(out + (size_t)(m + q * NGW) * DM);
#pragma unroll
                for (int j = 0; j < 2; ++j) { orow[2 * lane + 128 * j] = v[2 * j] * gf[2 * j] * rstd; orow[2 * lane + 128 * j + 1] = v[2 * j + 1] * gf[2 * j + 1] * rstd; }
            }
        }
    }
#undef IN
#undef SEAM
}

extern "C" void kernel_launch(void* const* d_in, const int* in_sizes, int n_in, void* d_out, int out_size, void* d_ws, size_t ws_size, hipStream_t stream) {
    static int grid = 0;
    if (grid == 0) {
        if (n_in != 16 || in_sizes[0] != M * DM || out_size != M * DM || ws_size < WS_END) { fprintf(stderr, "kernel_launch: unexpected shapes (n_in %d, in0 %d, out %d, ws %zu); nothing launched\n", n_in, n_in > 0 ? in_sizes[0] : -1, out_size, ws_size); grid = -1; return; }
        int dev = 0, cus = 0, per_cu = 0;
        if (hipGetDevice(&dev) != hipSuccess || hipDeviceGetAttribute(&cus, hipDeviceAttributeMultiprocessorCount, dev) != hipSuccess) { grid = -1; return; }
        if (hipFuncSetAttribute((const void*)fwd_megakernel, hipFuncAttributeMaxDynamicSharedMemorySize, LDS_BYTES) != hipSuccess) { fprintf(stderr, "kernel_launch: hipFuncSetAttribute failed\n"); grid = -1; return; }
        if (hipOccupancyMaxActiveBlocksPerMultiprocessor(&per_cu, (const void*)fwd_megakernel, NWAVES * 64, LDS_BYTES) != hipSuccess || per_cu < 1) { fprintf(stderr, "kernel_launch: occupancy query says %d\n", per_cu); per_cu = 1; }
        (void)hipGetLastError();
        grid = cus;
        if (grid != 256) fprintf(stderr, "kernel_launch: %d CUs; built for 256\n", grid);
    }
    if (grid < 0) return;
    if (hipMemsetAsync(d_ws, 0, 32768, stream) != hipSuccess) { fprintf(stderr, "kernel_launch: memset failed\n"); return; }
    Args a{};
    for (int i = 0; i < 16; ++i) a.in[i] = (const float*)d_in[i];
    a.out = (float*)d_out; a.ws = (unsigned char*)d_ws;
#if MK_N_LAUNCHES == 1
    a.ph_lo = 0; a.ph_hi = N_PHASES;
    void* kargs[] = {&a};
    hipError_t e = hipLaunchCooperativeKernel((const void*)fwd_megakernel, dim3(grid), dim3(NWAVES * 64), kargs, LDS_BYTES, stream);
    if (e != hipSuccess) fprintf(stderr, "kernel_launch: cooperative launch failed: %s (grid %d)\n", hipGetErrorString(e), grid);
#else
    for (int li = 0; li < N_PHASES; ++li) { a.ph_lo = li; a.ph_hi = li + 1; hipLaunchKernelGGL(fwd_megakernel, dim3(grid), dim3(NWAVES * 64), LDS_BYTES, stream, a); }
#endif
}
```
